# Optimizing an MI355X kernel written in HIP

```python
import jax
import jax.numpy as jnp
from jax import lax
import numpy as np

D_MODEL = 1024
BATCH = 32
SEQ = 256
DEPTH = 4
DEC_BATCH = 8
DEC_SEQ = 2048
PAST_LEN = 256

GRID_W = 64
HEAD_DIM = 64
ATT_HEADS = 8
ATT_KV = 2
WIN_HEADS = 8
WIN_KV = 2
WINDOW = 128
HG_HEADS = 4
HG_DK = 128
HG_DV = 128
BRANCH_W = 512
N_BRANCH = 3
D_FF = 2816
Q_BLOCK = 128
CHUNK = 32
ROPE_THETA = 10000.0
EPS = 1e-6
NEG_INF = -1e30
TINY = 1e-30
N_MOD = 9
ATT_Q_W = ATT_HEADS * HEAD_DIM
ATT_KV_W = ATT_KV * HEAD_DIM
WIN_Q_W = WIN_HEADS * HEAD_DIM
WIN_KV_W = WIN_KV * HEAD_DIM
HG_W = HG_HEADS * HG_DK
IN_SECTIONS = (ATT_Q_W, ATT_KV_W, ATT_KV_W, WIN_Q_W, WIN_KV_W, WIN_KV_W,
               HG_W, HG_W, HG_W, HG_W, HG_W, D_MODEL, D_MODEL, D_MODEL)
IN_W = ATT_Q_W + 2 * ATT_KV_W + WIN_Q_W + 2 * WIN_KV_W + 5 * HG_W + 3 * D_MODEL

kernel_name = 'hybrid_diffusion_prefix_trunk_step'


def _rmsnorm(x, g):
    xf = x.astype(jnp.float32)
    y = xf * lax.rsqrt(jnp.mean(xf * xf, axis=-1, keepdims=True) + EPS)
    return (y * g.astype(jnp.float32)).astype(x.dtype)


def _swiglu(h, w_gu, w_down):
    gu = h @ w_gu
    return (jax.nn.silu(gu[..., :D_FF]) * gu[..., D_FF:]) @ w_down


def _rot(x, cos, sin):
    n = cos.shape[-1]
    x1, x2 = x[..., :n], x[..., n:]
    return jnp.concatenate([x1 * cos - x2 * sin, x1 * sin + x2 * cos], axis=-1)


def _rope_2d(x, rope):
    cos_r, sin_r, cos_c, sin_c = rope
    shape = (x.shape[1],) + (1,) * (x.ndim - 3) + (cos_r.shape[-1],)
    cast = lambda t: t.reshape(shape).astype(x.dtype)
    half = HEAD_DIM // 2
    return jnp.concatenate([_rot(x[..., :half], cast(cos_r), cast(sin_r)),
                            _rot(x[..., half:], cast(cos_c), cast(sin_c))], axis=-1)


def _attend(q, k, v, mask, sink):
    s = jnp.einsum('bqgrd,bkgd->bgrqk', q, k).astype(jnp.float32) * (HEAD_DIM ** -0.5)
    if mask is not None:
        s = jnp.where(mask, s, NEG_INF)
    if sink is None:
        p = jax.nn.softmax(s, axis=-1)
    else:
        sk = sink.astype(jnp.float32)[None, :, :, None, None]
        m = jnp.maximum(jnp.max(s, axis=-1, keepdims=True), sk)
        e = jnp.exp(s - m)
        p = e / (jnp.sum(e, axis=-1, keepdims=True) + jnp.exp(sk - m))
    return jnp.einsum('bgrqk,bkgd->bqgrd', p.astype(v.dtype), v)


def _dense_blocked(q, k, v, sink):
    b, s, g, r, d = q.shape
    nb = s // Q_BLOCK
    qb = jnp.moveaxis(q.reshape(b, nb, Q_BLOCK, g, r, d), 1, 0)
    ob = lax.map(lambda qi: _attend(qi, k, v, None, sink), qb)
    return jnp.moveaxis(ob, 0, 1).reshape(b, s, g, r, d)


def _window_blocked(q, k, v, k_ctx, v_ctx, sink):
    b, s, g, r, d = q.shape
    nb = s // Q_BLOCK
    n_ctx = k_ctx.shape[1]

    def bands(t):
        tp = jnp.pad(t, ((0, 0), (Q_BLOCK, Q_BLOCK), (0, 0), (0, 0))).reshape(b, nb + 2, Q_BLOCK, g, d)
        band = jnp.concatenate([tp[:, :-2], tp[:, 1:-1], tp[:, 2:]], axis=2)
        return jnp.moveaxis(band, 1, 0)

    qb = jnp.moveaxis(q.reshape(b, nb, Q_BLOCK, g, r, d), 1, 0)
    q_off = jnp.arange(Q_BLOCK)
    k_off = jnp.arange(3 * Q_BLOCK) - Q_BLOCK
    ctx_ok = jnp.ones((Q_BLOCK, n_ctx), dtype=bool)

    def step(args):
        qi, ki, vi, i = args
        t = i * Q_BLOCK + q_off
        src = i * Q_BLOCK + k_off
        band_ok = ((jnp.abs(t[:, None] - src[None, :]) <= WINDOW)
                   & (src >= 0)[None, :] & (src < s)[None, :])
        mask = jnp.concatenate([ctx_ok, band_ok], axis=1)
        return _attend(qi, jnp.concatenate([k_ctx, ki], axis=1),
                       jnp.concatenate([v_ctx, vi], axis=1), mask, sink)

    ob = lax.map(step, (qb, bands(k), bands(v), jnp.arange(nb)))
    return jnp.moveaxis(ob, 0, 1).reshape(b, s, g, r, d)


def _gla_scan(q, k, v, logf, s0):
    b, s, h, _ = q.shape
    n = s // CHUNK

    def chunks(t):
        return t.reshape(b, n, CHUNK, h, t.shape[-1]).transpose(1, 0, 3, 2, 4)

    causal = jnp.tril(jnp.ones((CHUNK, CHUNK), dtype=bool))[:, :, None]

    def step(state, xs):
        qc, kc, vc, gc = xs
        bcum = lax.cumsum(gc, axis=2)
        decay = jnp.exp(jnp.where(causal, bcum[:, :, :, None, :] - bcum[:, :, None, :, :], NEG_INF))
        scores = jnp.einsum('bhtd,bhsd,bhtsd->bhts', qc, kc, decay)
        out = (jnp.einsum('bhts,bhsv->bhtv', scores, vc)
               + jnp.einsum('bhtd,bhdv->bhtv', qc * jnp.exp(bcum), state))
        blast = bcum[:, :, -1:, :]
        new_state = (jnp.exp(blast)[:, :, 0, :, None] * state
                     + jnp.einsum('bhsd,bhsv->bhdv', kc * jnp.exp(blast - bcum), vc))
        return new_state, out

    s_fin, oc = lax.scan(step, s0.astype(jnp.float32), (chunks(q), chunks(k), chunks(v), chunks(logf)))
    return oc.transpose(1, 0, 3, 2, 4).reshape(b, s, h, v.shape[-1]), s_fin


def _hgrn(q, z_fwd, z_bwd, i, g, lb, norm_g, s0):
    b, s, _ = q.shape
    heads = lambda t, d: t.astype(jnp.float32).reshape(b, s, HG_HEADS, d)
    qh = heads(jax.nn.silu(q), HG_DK)
    vh = heads(i, HG_DV)

    def gates(z, lbd):
        zf = z.astype(jnp.float32)
        f = lbd + (1.0 - lbd) * jax.nn.sigmoid(zf)
        logf = jnp.log(jnp.maximum(f, TINY))
        key = (1.0 - lbd) * jax.nn.sigmoid(-zf)
        return heads(key, HG_DK), heads(logf, HG_DK)

    k_f, g_f = gates(z_fwd, lb[0])
    k_b, g_b = gates(z_bwd, lb[1])
    rev = lambda t: jnp.flip(t, axis=1)
    o_f, s_f = _gla_scan(qh, k_f, vh, g_f, s0[:, 0])
    o_b, s_b = _gla_scan(rev(qh), rev(k_b), rev(vh), rev(g_b), s0[:, 1])
    o = _rmsnorm(o_f + rev(o_b), norm_g) * jax.nn.silu(heads(g, HG_DV))
    return o.reshape(b, s, HG_HEADS * HG_DV).astype(q.dtype), jnp.stack([s_f, s_b], axis=1)


def _split_cols(t):
    out, start = [], 0
    for w in IN_SECTIONS:
        out.append(t[..., start:start + w])
        start += w
    return out


def _mixer(h, lw, rope, ctx):
    b, s, _ = h.shape
    (aq, ak, av, wq, wk, wv, hq, hf_fwd, hf_bwd, hi, hg, ga, gb, gc) = _split_cols(h @ lw['w_in'])
    aq = _rmsnorm(aq.reshape(b, s, ATT_KV, ATT_HEADS // ATT_KV, HEAD_DIM), lw['q_norm_g'])
    ak = _rmsnorm(ak.reshape(b, s, ATT_KV, HEAD_DIM), lw['k_norm_g'])
    av = av.reshape(b, s, ATT_KV, HEAD_DIM)
    wq = wq.reshape(b, s, WIN_KV, WIN_HEADS // WIN_KV, HEAD_DIM)
    wk = wk.reshape(b, s, WIN_KV, HEAD_DIM)
    wv = wv.reshape(b, s, WIN_KV, HEAD_DIM)
    sink = lw['sink'].reshape(WIN_KV, WIN_HEADS // WIN_KV)
    if ctx is None:
        o_att = _dense_blocked(aq, ak, av, None)
        o_win = _dense_blocked(wq, wk, wv, sink)
        s0 = jnp.zeros((b, 2, HG_HEADS, HG_DK, HG_DV), jnp.float32)
    else:
        ck_att, cv_att, ck_win, cv_win, s0 = ctx
        aq, ak = _rope_2d(aq, rope), _rope_2d(ak, rope)
        wq, wk = _rope_2d(wq, rope), _rope_2d(wk, rope)
        o_att = _dense_blocked(aq, jnp.concatenate([ck_att, ak], axis=1),
                               jnp.concatenate([cv_att, av], axis=1), None)
        o_win = _window_blocked(wq, wk, wv, ck_win, cv_win, sink)
    o_hg, s_fin = _hgrn(hq, hf_fwd, hf_bwd, hi, hg, lw['lb'], lw['hg_norm_g'], s0)
    wb = lw['w_branch']
    merged = (jax.nn.sigmoid(ga) * (o_att.reshape(b, s, BRANCH_W) @ wb[0])
              + jax.nn.sigmoid(gb) * (o_hg @ wb[1])
              + jax.nn.sigmoid(gc) * (o_win.reshape(b, s, BRANCH_W) @ wb[2]))
    y = merged @ lw['w_out']
    new_ctx = (ak, av, wk, wv, s_fin) if ctx is None else None
    return y, new_ctx


def _layer(x, cond, lw, rope, ctx):
    mod = (jax.nn.silu(cond) @ lw['w_mod'] + lw['b_mod']).reshape(cond.shape[0], 1, N_MOD, D_MODEL)

    def pre(j, t):
        return _rmsnorm(t, lw['norm_g'][j]) * (1.0 + mod[:, :, 3 * j + 1]) + mod[:, :, 3 * j]

    x = x + 0.5 * mod[:, :, 2] * _swiglu(pre(0, x), lw['ffn_in'][0], lw['ffn_out'][0])
    y, new_ctx = _mixer(pre(1, x), lw, rope, ctx)
    x = x + mod[:, :, 5] * y
    x = x + 0.5 * mod[:, :, 8] * _swiglu(pre(2, x), lw['ffn_in'][1], lw['ffn_out'][1])
    return x, new_ctx


def setup_inputs(seed: int = 0) -> dict:
    key = jax.random.key(seed)
    ks = jax.random.split(key, 22)
    nrm = lambda k, shape, scale: jax.random.normal(k, shape, jnp.float32) * scale
    return {
        'x_prompt': nrm(ks[0], (BATCH, SEQ, D_MODEL), 1.0),
        'x_sample': nrm(ks[1], (DEC_BATCH, DEC_SEQ, D_MODEL), 1.0),
        'cache_k_attn': nrm(ks[2], (DEC_BATCH, DEPTH, PAST_LEN, ATT_KV, HEAD_DIM), 1.0),
        'cache_v_attn': nrm(ks[3], (DEC_BATCH, DEPTH, PAST_LEN, ATT_KV, HEAD_DIM), 1.0),
        'cache_k_win': nrm(ks[4], (DEC_BATCH, DEPTH, PAST_LEN, WIN_KV, HEAD_DIM), 1.0),
        'cache_v_win': nrm(ks[5], (DEC_BATCH, DEPTH, PAST_LEN, WIN_KV, HEAD_DIM), 1.0),
        'state_hgrn': nrm(ks[6], (DEC_BATCH, DEPTH, 2, HG_HEADS, HG_DK, HG_DV), 0.5),
        'c': nrm(ks[7], (DEC_BATCH, D_MODEL), 1.0),
        'c_ctx': nrm(ks[8], (D_MODEL,), 1.0),
        'w_mod': nrm(ks[9], (DEPTH, D_MODEL, N_MOD * D_MODEL), D_MODEL ** -0.5),
        'b_mod': nrm(ks[10], (DEPTH, N_MOD * D_MODEL), 0.01),
        'norm_g': 1.0 + nrm(ks[11], (DEPTH, 3, D_MODEL), 0.01),
        'w_ffn_in': nrm(ks[12], (DEPTH, 2, D_MODEL, 2 * D_FF), D_MODEL ** -0.5),
        'w_ffn_out': nrm(ks[13], (DEPTH, 2, D_FF, D_MODEL), D_FF ** -0.5),
        'w_in': nrm(ks[14], (DEPTH, D_MODEL, IN_W), D_MODEL ** -0.5),
        'qk_norm_g': 1.0 + nrm(ks[15], (DEPTH, 2, HEAD_DIM), 0.01),
        'lower_bounds': nrm(ks[16], (DEPTH, 2, HG_W), 0.1),
        'hg_norm_g': 1.0 + nrm(ks[17], (DEPTH, HG_DV), 0.01),
        'sink_logit': nrm(ks[18], (DEPTH, WIN_HEADS), 0.5),
        'w_branch': nrm(ks[19], (DEPTH, N_BRANCH, BRANCH_W, D_MODEL), BRANCH_W ** -0.5),
        'w_out': nrm(ks[20], (DEPTH, D_MODEL, D_MODEL), D_MODEL ** -0.5),
        'final_norm_g': 1.0 + nrm(ks[21], (D_MODEL,), 0.01),
    }


def reference(x_prompt, x_sample, cache_k_attn, cache_v_attn, cache_k_win, cache_v_win, state_hgrn,
              c, c_ctx, w_mod, b_mod, norm_g, w_ffn_in, w_ffn_out, w_in, qk_norm_g, lower_bounds,
              hg_norm_g, sink_logit, w_branch, w_out, final_norm_g):
    lb_soft = jax.nn.softmax(lower_bounds.astype(jnp.float32), axis=0)
    lb_all = jnp.cumsum(lb_soft, axis=0) - lb_soft[0]
    layers = [dict(w_mod=w_mod[l], b_mod=b_mod[l], norm_g=norm_g[l], ffn_in=w_ffn_in[l],
                   ffn_out=w_ffn_out[l], w_in=w_in[l], q_norm_g=qk_norm_g[l, 0],
                   k_norm_g=qk_norm_g[l, 1], sink=sink_logit[l], lb=lb_all[l],
                   hg_norm_g=hg_norm_g[l], w_branch=w_branch[l], w_out=w_out[l])
              for l in range(DEPTH)]

    xp = x_prompt
    cond_ctx = c_ctx[None, :]
    ctx_out = []
    for l in range(DEPTH):
        xp, cx = _layer(xp, cond_ctx, layers[l], None, None)
        ctx_out.append(cx)
    y_prompt = _rmsnorm(xp, final_norm_g)
    new_k_attn = jnp.stack([cx[0] for cx in ctx_out], axis=1)
    new_v_attn = jnp.stack([cx[1] for cx in ctx_out], axis=1)
    new_k_win = jnp.stack([cx[2] for cx in ctx_out], axis=1)
    new_v_win = jnp.stack([cx[3] for cx in ctx_out], axis=1)
    new_state_hgrn = jnp.stack([cx[4] for cx in ctx_out], axis=1)

    n_lat = x_sample.shape[1]
    rows = n_lat // GRID_W
    row = jnp.repeat(jnp.arange(rows, dtype=jnp.float32), GRID_W)
    col = jnp.tile(jnp.arange(GRID_W, dtype=jnp.float32), rows)
    axis_dim = HEAD_DIM // 2
    inv = ROPE_THETA ** (-jnp.arange(0, axis_dim, 2, dtype=jnp.float32) / axis_dim)
    ang_r = row[:, None] * inv
    ang_c = col[:, None] * inv
    rope = (jnp.cos(ang_r), jnp.sin(ang_r), jnp.cos(ang_c), jnp.sin(ang_c))
    xs = x_sample
    for l in range(DEPTH):
        ctx = (cache_k_attn[:, l], cache_v_attn[:, l], cache_k_win[:, l], cache_v_win[:, l], state_hgrn[:, l])
        xs, _ = _layer(xs, c, layers[l], rope, ctx)
    y_sample = _rmsnorm(xs, final_norm_g)
    return (y_prompt, y_sample, new_k_attn, new_v_attn, new_k_win, new_v_win, new_state_hgrn)
```

```cpp
#include <hip/hip_runtime.h>
#include <hip/hip_cooperative_groups.h>
#include <cstdio>
#include <cstdint>
namespace cg = cooperative_groups;

#define DI __device__ __forceinline__
typedef unsigned short bf16_t;
typedef short bf16x8 __attribute__((ext_vector_type(8)));
typedef short s16x4 __attribute__((ext_vector_type(4)));
typedef float f32x2 __attribute__((ext_vector_type(2)));
typedef float f32x4 __attribute__((ext_vector_type(4)));
typedef float f32x16 __attribute__((ext_vector_type(16)));
typedef unsigned u32x2 __attribute__((ext_vector_type(2)));
typedef unsigned u32x4 __attribute__((ext_vector_type(4)));
typedef __bf16 bf16x2n __attribute__((ext_vector_type(2)));

DI int otid() { int t = threadIdx.x; asm volatile("" : "+v"(t)); return t; }
DI int obid() { int b = blockIdx.x; asm volatile("" : "+s"(b)); return b; }
DI unsigned pk2(float lo, float hi) { f32x2 v = {lo, hi}; return __builtin_bit_cast(unsigned, __builtin_convertvector(v, bf16x2n)); }
DI float bflo(unsigned u) { return __uint_as_float(u << 16); }
DI float bfhi(unsigned u) { return __uint_as_float(u & 0xffff0000u); }
DI float bf2f(bf16_t b) { return __uint_as_float(((unsigned)b) << 16); }
DI bf16_t f2bf(float f) { return (bf16_t)(pk2(f, 0.f) & 0xffffu); }
DI float sigmoidf_(float x) { return __builtin_amdgcn_rcpf(1.f + __expf(-x)); }
DI float wave_sum(float v) {
#pragma unroll
    for (int o = 1; o < 64; o <<= 1) v += __shfl_xor(v, o);
    return v;
}
#define MFMA32(a, b, c) __builtin_amdgcn_mfma_f32_32x32x16_bf16((a), (b), (c), 0, 0, 0)
DI bf16x8 pack8(float a0, float a1, float a2, float a3, float a4, float a5, float a6, float a7) {
    u32x4 p; p.x = pk2(a0, a1); p.y = pk2(a2, a3); p.z = pk2(a4, a5); p.w = pk2(a6, a7); return __builtin_bit_cast(bf16x8, p);
}
DI bf16x8 cat44(s16x4 lo, s16x4 hi) { return __builtin_shufflevector(lo, hi, 0, 1, 2, 3, 4, 5, 6, 7); }

constexpr int DM = 1024, DEPTH = 4, TC = 8192, TL = 16384, T = 24576, DFF = 2816, INW = 7168, NMODW = 9216;
constexpr int C_AQ = 0, C_AK = 512, C_AV = 640, C_WQ = 768, C_WK = 1280, C_WV = 1408, C_HQ = 1536, C_HFF = 2048, C_HFB = 2560, C_HI = 3072, C_HG = 3584, C_GA = 4096;
constexpr float EPS = 1e-6f, LOG2E = 1.4426950408889634f;
constexpr size_t O_X = 0, O_NKA = 25165824, O_NVA = 29360128, O_NKW = 33554432, O_NVW = 37748736, O_NST = 41943040;
constexpr size_t al256(size_t x) { return (x + 255) & ~(size_t)255; }
constexpr size_t WS_CTL = 0;
constexpr size_t WS_MOD = 4096;
constexpr size_t WS_LB = WS_MOD + al256((size_t)DEPTH * 9 * NMODW * 4);
constexpr size_t WS_ROPE = WS_LB + 16384;
constexpr size_t WS_WFI = WS_ROPE + 8192;
constexpr size_t WS_WFO = WS_WFI + (size_t)2 * 5632 * 1024 * 2;
constexpr size_t WS_WIN = WS_WFO + (size_t)2 * 1024 * 2816 * 2;
constexpr size_t WS_WBR = WS_WIN + (size_t)7168 * 1024 * 2;
constexpr size_t WS_WOUT = WS_WBR + (size_t)3 * 1024 * 512 * 2;
constexpr size_t WS_HB = WS_WOUT + (size_t)1024 * 1024 * 2;
constexpr size_t WS_PROJ = WS_HB + (size_t)T * 1024 * 2;
constexpr size_t WS_OATT = WS_PROJ + (size_t)T * INW * 2;
constexpr size_t WS_OHG = WS_OATT + (size_t)T * 512 * 2;
constexpr size_t WS_OWIN = WS_OHG + (size_t)T * 512 * 2;
constexpr size_t WS_OF = WS_OWIN + (size_t)T * 512 * 2;
constexpr size_t WS_KAL = WS_OF + (size_t)2 * T * 512 * 4;
constexpr size_t SZ_KL = (size_t)8 * 2 * 2304 * 64 * 2, SZ_KC = (size_t)32 * 2 * 256 * 64 * 2;
constexpr size_t WS_VAL = WS_KAL + SZ_KL;
constexpr size_t WS_KWL = WS_VAL + SZ_KL;
constexpr size_t WS_VWL = WS_KWL + SZ_KL;
constexpr size_t WS_KAC = WS_VWL + SZ_KL;
constexpr size_t WS_VAC = WS_KAC + SZ_KC;
constexpr size_t WS_KWC = WS_VAC + SZ_KC;
constexpr size_t WS_VWC = WS_KWC + SZ_KC;
constexpr size_t WS_END = WS_VWC + SZ_KC;
constexpr int LDS_BYTES = 160 * 1024, LDS_MISC = 159 * 1024;
constexpr int NPH = 1 + 13 * DEPTH + 1;

struct Args { const float* in[22]; float* out; unsigned char* ws; int ph_lo, ph_hi; };

namespace pg8 {
#define PG8_LAS __attribute__((address_space(3)))
typedef unsigned short bf16_t;
typedef short bf16x8 __attribute__((ext_vector_type(8)));
typedef float f32x4 __attribute__((ext_vector_type(4)));
typedef unsigned u32x4 __attribute__((ext_vector_type(4)));
constexpr int BM = 256, BK = 64, HALF = 128, HTB = HALF * BK * 2  , STAGE_BYTES = 8 * HTB, NXCD = 8, WGM = 8;

__host__ __device__ __forceinline__ int lds_byte(int r, int c) { const int st = (r >> 4) * 2 + (c >> 5), rr = r & 15, cc = c & 31, ob = rr * 64 + cc * 2; return st * 1024 + (ob ^ (((ob >> 9) & 1) << 5)); }
__host__ __device__ __forceinline__ void stage_rc(int b, int& R, int& C) { const int st = b / 1024, sb = b % 1024, swz = sb ^ (((sb >> 9) & 1) << 5); R = (st >> 1) * 16 + swz / 64; C = (st & 1) * 32 + (swz % 64) / 2; }
__host__ __device__ __forceinline__ int perm32(int rho) { const int n = rho >> 4, i = rho & 15; return 8 * (i >> 2) + 4 * n + (i & 3); }

struct Unit { int pm, pn; };
struct Gemm { const bf16_t* A; const bf16_t* Bt; int M, N, K; };

struct StaticOrder {
    int nM, nN, nwg, G, c;
    __host__ __device__ void init(int M, int N, int G_, int c_) { nM = M / BM; nN = N / BM; nwg = nM * nN; G = G_; c = c_; }
    __host__ __device__ bool next(int i, Unit& u) const {
        const long L = (long)i * G + c; if (L >= nwg) return false;
        int wgid = (int)L; { const int q = nwg / NXCD, r = nwg % NXCD, xcd = wgid % NXCD, off = wgid / NXCD; wgid = (xcd < r ? xcd * (q + 1) : r * (q + 1) + (xcd - r) * q) + off; }
        const int nig = WGM * nN, gid = wgid / nig, fm = gid * WGM, gsz = (nM - fm) < WGM ? (nM - fm) : WGM;
        u.pm = fm + ((wgid % nig) % gsz); u.pn = (wgid % nig) / gsz; return true;
    }
    __device__ __forceinline__ void a_ready(const Unit&) const {}
    __device__ __forceinline__ void done(const Unit&) const {}
};
struct EpiBf16P {
    static constexpr bool PERM = true, AFTER_DRAIN = false;
    bf16_t* O; int ldc;
    __device__ __forceinline__ void operator()(const f32x4 (&acc)[2][2][4][2], const Unit& u, int wr, int wc, int fr, int fq) const {
        const int row0 = u.pm * BM + wr * 64 + fr, col0 = u.pn * BM + wc * 32 + 8 * fq;
#pragma unroll
        for (int ai = 0; ai < 2; ++ai)
#pragma unroll
            for (int m = 0; m < 4; ++m) { bf16_t* rowp = O + (size_t)(row0 + ai * HALF + m * 16) * ldc + col0;
#pragma unroll
                for (int bj = 0; bj < 2; ++bj) { const f32x4 v0 = acc[ai][bj][m][0], v1 = acc[ai][bj][m][1];
                    u32x4 w; w.x = pk2(v0[0], v0[1]); w.y = pk2(v0[2], v0[3]); w.z = pk2(v1[0], v1[1]); w.w = pk2(v1[2], v1[3]);
                    *(u32x4*)(rowp + bj * HALF) = w; } }
    }
};
struct EpiSwiglu {
    static constexpr bool PERM = true, AFTER_DRAIN = false;
    bf16_t* O;
    __device__ __forceinline__ void operator()(const f32x4 (&acc)[2][2][4][2], const Unit& u, int wr, int wc, int fr, int fq) const {
        const int row0 = u.pm * BM + wr * 64 + fr, col0 = u.pn * HALF + wc * 32 + 8 * fq;
#pragma unroll
        for (int ai = 0; ai < 2; ++ai)
#pragma unroll
            for (int m = 0; m < 4; ++m) { bf16_t* rowp = O + (size_t)(row0 + ai * HALF + m * 16) * DFF + col0;
                float r[8];
#pragma unroll
                for (int n = 0; n < 2; ++n)
#pragma unroll
                    for (int j = 0; j < 4; ++j) { const float g = acc[ai][0][m][n][j], up = acc[ai][1][m][n][j]; r[4 * n + j] = g * __builtin_amdgcn_rcpf(1.f + __expf(-g)) * up; }
                u32x4 w; w.x = pk2(r[0], r[1]); w.y = pk2(r[2], r[3]); w.z = pk2(r[4], r[5]); w.w = pk2(r[6], r[7]);
                *(u32x4*)rowp = w; }
    }
};
struct EpiResid {
    static constexpr bool PERM = false, AFTER_DRAIN = false;
    const float* xa; const float* xb; float* out; const float* mod; float coef;
    __device__ __forceinline__ void operator()(const f32x4 (&acc)[2][2][4][2], const Unit& u, int wr, int wc, int fr, int fq) const {
        const int row0 = u.pm * BM + wr * 64 + fr, col0 = u.pn * BM + wc * 32 + 4 * fq;
#pragma unroll
        for (int ai = 0; ai < 2; ++ai)
#pragma unroll
            for (int m = 0; m < 4; ++m) { const int row = row0 + ai * HALF + m * 16; const int cond = row < TC ? 8 : ((row - TC) >> 11);
                const float* bp = row < TC ? xa + (size_t)row * DM : xb + (size_t)(row - TC) * DM; const float* mp = mod + (size_t)cond * NMODW; float* op = out + (size_t)row * DM;
#pragma unroll
                for (int bj = 0; bj < 2; ++bj)
#pragma unroll
                    for (int n = 0; n < 2; ++n) { const int c = col0 + bj * HALF + n * 16; const f32x4 b = *(const f32x4*)(bp + c), g = *(const f32x4*)(mp + c);
                        *(f32x4*)(op + c) = b + coef * g * acc[ai][bj][m][n]; } }
    }
};
struct EpiBranch {
    static constexpr bool PERM = false, AFTER_DRAIN = false;
    const bf16_t* gate; float* acc32; bf16_t* outbf; int mode;
    __device__ __forceinline__ void operator()(const f32x4 (&acc)[2][2][4][2], const Unit& u, int wr, int wc, int fr, int fq) const {
        const int row0 = u.pm * BM + wr * 64 + fr, col0 = u.pn * BM + wc * 32 + 4 * fq;
#pragma unroll
        for (int ai = 0; ai < 2; ++ai)
#pragma unroll
            for (int m = 0; m < 4; ++m) { const int row = row0 + ai * HALF + m * 16;
#pragma unroll
                for (int bj = 0; bj < 2; ++bj)
#pragma unroll
                    for (int n = 0; n < 2; ++n) { const int c = col0 + bj * HALF + n * 16;
                        const u32x2 gv = *(const u32x2*)(gate + (size_t)row * INW + c);
                        f32x4 g; g[0] = sigmoidf_(bflo(gv.x)); g[1] = sigmoidf_(bfhi(gv.x)); g[2] = sigmoidf_(bflo(gv.y)); g[3] = sigmoidf_(bfhi(gv.y));
                        f32x4 v = g * acc[ai][bj][m][n];
                        float* ap = acc32 + (size_t)row * DM + c;
                        if (mode == 0) { *(f32x4*)ap = v; }
                        else if (mode == 1) { v += *(const f32x4*)ap; *(f32x4*)ap = v; }
                        else { v += *(const f32x4*)ap; u32x2 w; w.x = pk2(v[0], v[1]); w.y = pk2(v[2], v[3]); *(u32x2*)(outbf + (size_t)row * DM + c) = w; } } }
    }
};

template <class Epi, class Sched, bool STAMP = false>
__device__ __forceinline__ void gemm_phase(PG8_LAS unsigned char* lds, const Gemm g, const Sched& S, const Epi& E, unsigned long long* stamps) {
    const int tid = otid(), wid = __builtin_amdgcn_readfirstlane(tid >> 6), lane = tid & 63, wr = wid >> 2, wc = wid & 3, fr = lane & 15, fq = lane >> 4;
    const int K = g.K, nt = K / BK;
    int ts_lo = 0, ts_hi = 0, nts = 0; const unsigned long long rt_entry = STAMP ? (unsigned long long)wall_clock64() : 0ull;
#define PG8_STAMP() do { if (STAMP && wid == 0 && nts < 64) { const unsigned long long _c = (unsigned long long)clock64(); \
        ts_lo = (lane == nts) ? (int)(unsigned)_c : ts_lo; ts_hi = (lane == nts) ? (int)(unsigned)(_c >> 32) : ts_hi; ++nts; } } while (0)
    PG8_STAMP();
    unsigned voffA[2], voffB[2];
#pragma unroll
    for (int i = 0; i < 2; ++i) { int R, C; stage_rc(tid * 16 + i * 8192, R, C); const int Rb = Epi::PERM ? ((R & ~31) + perm32(R & 31)) : R;
        voffA[i] = (unsigned)(R * K + C) * 2u; voffB[i] = (unsigned)(Rb * K + C) * 2u; }
    const size_t kstep = (size_t)(BK * 2);
    const size_t hstep = (size_t)HALF * K * 2;
    const size_t tstep = 2 * hstep;
    const unsigned ldsw = (unsigned)wid * 1024u;
    const int aoff = lds_byte(wr * 64 + fr, fq * 8), boff = lds_byte(wc * 32 + fr, fq * 8);
#define PG8_SA(b, h) (((b) * 2 + (h)) * HTB)
#define PG8_SB(b, h) ((4 + (b) * 2 + (h)) * HTB)
#define PG8_STAGE(bufoff, gbase, voff) do { _Pragma("unroll") for (int _i = 0; _i < 2; ++_i) \
        __builtin_amdgcn_global_load_lds((const unsigned*)((const char*)(gbase) + (voff)[_i]), (PG8_LAS unsigned*)(lds + (bufoff) + ldsw + _i * 8192), 16, 0, 0); } while (0)
#define PG8_LDA(dst, b, h) do { _Pragma("unroll") for (int m = 0; m < 4; ++m) _Pragma("unroll") for (int k = 0; k < 2; ++k) dst[m][k] = *(const PG8_LAS bf16x8*)(lds + PG8_SA(b, h) + aoff + m * 2048 + k * 1024); } while (0)
#define PG8_LDB(dst, b, h) do { _Pragma("unroll") for (int n = 0; n < 2; ++n) _Pragma("unroll") for (int k = 0; k < 2; ++k) dst[n][k] = *(const PG8_LAS bf16x8*)(lds + PG8_SB(b, h) + boff + n * 2048 + k * 1024); } while (0)
#define PG8_MMA(ai, bj, At, Bt) do { __builtin_amdgcn_s_setprio(1); _Pragma("unroll") for (int m = 0; m < 4; ++m) _Pragma("unroll") for (int n = 0; n < 2; ++n) _Pragma("unroll") for (int k = 0; k < 2; ++k) \
        acc[ai][bj][m][n] = __builtin_amdgcn_mfma_f32_16x16x32_bf16(Bt[n][k], At[m][k], acc[ai][bj][m][n], 0, 0, 0); __builtin_amdgcn_s_setprio(0); } while (0)
#define PG8_WAIT_V(n) asm volatile("s_waitcnt vmcnt(" #n ")" ::: "memory")
#define PG8_WAIT_L(n) asm volatile("s_waitcnt lgkmcnt(" #n ")" ::: "memory")
#define PG8_BAR __builtin_amdgcn_s_barrier()
#define PG8_SCHED __builtin_amdgcn_sched_barrier(0)
    Unit cur, nxt; int ui = 0;
    if (!S.next(0, cur)) return;
    f32x4 acc[2][2][4][2];
#pragma unroll
    for (int a = 0; a < 2; ++a)
#pragma unroll
        for (int b = 0; b < 2; ++b)
#pragma unroll
            for (int m = 0; m < 4; ++m)
#pragma unroll
                for (int n = 0; n < 2; ++n) acc[a][b][m][n] = (f32x4){0.f, 0.f, 0.f, 0.f};
    bf16x8 At[4][2], B0[2][2], B1[2][2];
    const char* cA = (const char*)g.A + (size_t)cur.pm * tstep; const char* cB = (const char*)g.Bt + (size_t)cur.pn * tstep;
    S.a_ready(cur);
    PG8_STAGE(PG8_SB(0, 0), cB, voffB); PG8_STAGE(PG8_SA(0, 0), cA, voffA); PG8_STAGE(PG8_SB(0, 1), cB + hstep, voffB); PG8_STAGE(PG8_SA(0, 1), cA + hstep, voffA);
    if (wr == 1) PG8_BAR;
    PG8_WAIT_V(4); PG8_BAR;
    PG8_STAGE(PG8_SB(1, 0), cB + kstep, voffB); PG8_STAGE(PG8_SA(1, 0), cA + kstep, voffA); PG8_STAGE(PG8_SB(1, 1), cB + hstep + kstep, voffB);
    PG8_WAIT_V(6); PG8_BAR;
    PG8_STAMP();
    for (;;) {
        const bool has_next = S.next(ui + 1, nxt);
        const char* nA = has_next ? (const char*)g.A + (size_t)nxt.pm * tstep : cA; const char* nB = has_next ? (const char*)g.Bt + (size_t)nxt.pn * tstep : cB;
        for (int t = 0; t < nt; t += 2) {
            const bool last = (t == nt - 2);
            const char* a1 = cA + (size_t)(t + 1) * kstep;
            const char* a2 = last ? nA : cA + (size_t)(t + 2) * kstep; const char* b2 = last ? nB : cB + (size_t)(t + 2) * kstep;
            const char* a3 = a2 + kstep; const char* b3 = b2 + kstep;
            if (last && has_next) S.a_ready(nxt);
            PG8_LDB(B0, 0, 0); PG8_SCHED; PG8_LDA(At, 0, 0); PG8_STAGE(PG8_SA(1, 1), a1 + hstep, voffA);
            PG8_WAIT_L(8); PG8_BAR; PG8_WAIT_L(0); PG8_MMA(0, 0, At, B0); PG8_BAR; PG8_SCHED;
            PG8_LDB(B1, 0, 1); PG8_STAGE(PG8_SB(0, 0), b2, voffB);
            PG8_BAR; PG8_WAIT_L(0); PG8_MMA(0, 1, At, B1); PG8_BAR;
            PG8_LDA(At, 0, 1); PG8_STAGE(PG8_SA(0, 0), a2, voffA);
            PG8_BAR; PG8_WAIT_L(0); PG8_MMA(1, 0, At, B0); PG8_BAR; PG8_SCHED;
            PG8_STAGE(PG8_SB(0, 1), b2 + hstep, voffB);
            PG8_WAIT_V(6); PG8_BAR; PG8_MMA(1, 1, At, B1); PG8_BAR;
            PG8_LDB(B0, 1, 0); PG8_SCHED; PG8_LDA(At, 1, 0); PG8_STAGE(PG8_SA(0, 1), a2 + hstep, voffA);
            PG8_WAIT_L(8); PG8_BAR; PG8_WAIT_L(0); PG8_MMA(0, 0, At, B0); PG8_BAR; PG8_SCHED;
            PG8_LDB(B1, 1, 1); PG8_STAGE(PG8_SB(1, 0), b3, voffB);
            PG8_BAR; PG8_WAIT_L(0); PG8_MMA(0, 1, At, B1); PG8_BAR;
            PG8_LDA(At, 1, 1); PG8_STAGE(PG8_SA(1, 0), a3, voffA);
            PG8_BAR; PG8_WAIT_L(0); PG8_MMA(1, 0, At, B0); PG8_BAR; PG8_SCHED;
            PG8_STAGE(PG8_SB(1, 1), b3 + hstep, voffB);
            PG8_WAIT_V(6); PG8_BAR; PG8_MMA(1, 1, At, B1); PG8_BAR;
        }
        PG8_STAMP();
        if constexpr (!Epi::AFTER_DRAIN) { E(acc, cur, wr, wc, fr, fq); S.done(cur); }
        PG8_STAMP();
        if (!has_next) break;
#pragma unroll
        for (int a = 0; a < 2; ++a)
#pragma unroll
            for (int b = 0; b < 2; ++b)
#pragma unroll
                for (int m = 0; m < 4; ++m)
#pragma unroll
                    for (int n = 0; n < 2; ++n) acc[a][b][m][n] = (f32x4){0.f, 0.f, 0.f, 0.f};
        cur = nxt; cA = nA; cB = nB; ++ui;
    }
    PG8_WAIT_V(0);
    if (wr == 0) PG8_BAR;
    PG8_BAR;
    if constexpr (Epi::AFTER_DRAIN) { E.fused(acc, cur, wr, wc, fr, fq, lds, wid, lane); S.done(cur); }
    PG8_STAMP();
    if (STAMP && wid == 0) { stamps[lane] = lane < nts ? (((unsigned long long)(unsigned)ts_hi << 32) | (unsigned)ts_lo) : 0ull;
        if (lane == 62) stamps[62] = rt_entry; if (lane == 63) stamps[63] = (unsigned long long)wall_clock64(); }
#undef PG8_STAMP
#undef PG8_SA
#undef PG8_SB
#undef PG8_STAGE
#undef PG8_LDA
#undef PG8_LDB
#undef PG8_MMA
#undef PG8_WAIT_V
#undef PG8_WAIT_L
#undef PG8_BAR
#undef PG8_SCHED
}
}
DI int crow(int i, int h) { return (i & 3) + 8 * (i >> 2) + 4 * h; }
#define LDS_WAIT() asm volatile("s_waitcnt lgkmcnt(0)" ::: "memory")


DI void phase_p0(const Args& a, unsigned char* lds) {
    float* s = (float*)lds; float* red = (float*)(lds + 36864);
    const int tid = otid(), lane = tid & 63, w = tid >> 6;
    float* MOD = (float*)(a.ws + WS_MOD);
    if ((int)blockIdx.x < 144) {
        const float* c = a.in[7]; const float* cctx = a.in[8];
        for (int i = tid; i < 9 * 1024; i += 512) { const int ci = i >> 10, k = i & 1023; const float v = ci < 8 ? c[ci * 1024 + k] : cctx[k]; s[i] = v * sigmoidf_(v); }
        __syncthreads();
        for (int item = blockIdx.x; item < 144; item += gridDim.x) {
            const int l = item / 36, cc = item % 36;
            const float* W = a.in[9] + (size_t)l * 1024 * NMODW + cc * 256 + 4 * lane;
            f32x4 acc[9];
#pragma unroll
            for (int ci = 0; ci < 9; ++ci) acc[ci] = (f32x4){0.f, 0.f, 0.f, 0.f};
#pragma unroll 2
            for (int k4 = 0; k4 < 32; ++k4) {
                const int k = w * 128 + k4 * 4;
                const f32x4 w0 = *(const f32x4*)(W + (size_t)(k + 0) * NMODW), w1 = *(const f32x4*)(W + (size_t)(k + 1) * NMODW),
                            w2 = *(const f32x4*)(W + (size_t)(k + 2) * NMODW), w3 = *(const f32x4*)(W + (size_t)(k + 3) * NMODW);
#pragma unroll
                for (int ci = 0; ci < 9; ++ci) { const f32x4 sv = *(const f32x4*)(s + ci * 1024 + k); acc[ci] += sv[0] * w0 + sv[1] * w1 + sv[2] * w2 + sv[3] * w3; }
            }
#pragma unroll
            for (int ci = 0; ci < 9; ++ci) *(f32x4*)(red + ((w * 9 + ci) * 256 + 4 * lane)) = acc[ci];
            __syncthreads();
            for (int i = tid; i < 9 * 256; i += 512) { const int ci = i >> 8, col = i & 255; float v = 0.f;
#pragma unroll
                for (int ww = 0; ww < 8; ++ww) v += red[(ww * 9 + ci) * 256 + col];
                v += a.in[10][l * NMODW + cc * 256 + col];
                MOD[((size_t)l * 9 + ci) * NMODW + cc * 256 + col] = v; }
            __syncthreads();
        }
    }
    if (blockIdx.x == gridDim.x - 1) {
        float* LB = (float*)(a.ws + WS_LB); const float* lbin = a.in[16];
        for (int e = tid; e < 1024; e += 512) {
            const float x0 = lbin[e], x1 = lbin[1024 + e], x2 = lbin[2048 + e], x3 = lbin[3072 + e];
            const float mx = fmaxf(fmaxf(x0, x1), fmaxf(x2, x3));
            const float e0 = __expf(x0 - mx), e1 = __expf(x1 - mx), e2 = __expf(x2 - mx), e3 = __expf(x3 - mx); const float inv = 1.f / (e0 + e1 + e2 + e3);
            LB[e] = 0.f; LB[1024 + e] = e1 * inv; LB[2048 + e] = (e1 + e2) * inv; LB[3072 + e] = (e1 + e2 + e3) * inv;
        }
        float* cosT = (float*)(a.ws + WS_ROPE); float* sinT = cosT + 1024;
        for (int e = tid; e < 1024; e += 512) { const int pos = e >> 4, i = e & 15; const float inv = exp2f(-(float)i * (13.287712379549449f / 16.f)); const float ang = (float)pos * inv;
            cosT[e] = cosf(ang); sinT[e] = sinf(ang); }
    }
}

DI void transpose_item(const float* W, int ldw, int srccol0, int k0, bf16_t* WT, int K, int dstrow0, float* scr, int lane) {
#pragma unroll 8
    for (int i = 0; i < 32; ++i) { const int kk = 2 * i + (lane >> 5); scr[kk * 33 + (lane & 31)] = W[(size_t)(k0 + kk) * ldw + srccol0 + (lane & 31)]; }
    LDS_WAIT();
    const int c = lane & 7;
#pragma unroll
    for (int j = 0; j < 4; ++j) { const int n = (lane >> 3) + 8 * j; const float* sp = scr + (8 * c) * 33 + n;
        u32x4 o; o.x = pk2(sp[0 * 33], sp[1 * 33]); o.y = pk2(sp[2 * 33], sp[3 * 33]); o.z = pk2(sp[4 * 33], sp[5 * 33]); o.w = pk2(sp[6 * 33], sp[7 * 33]);
        *(u32x4*)(WT + (size_t)(dstrow0 + n) * K + k0 + 8 * c) = o; }
    LDS_WAIT();
}
DI void phase_wconv(const Args& a, unsigned char* lds, int l) {
    const int tid = otid(), lane = tid & 63, w = tid >> 6;
    float* scr = (float*)(lds + w * 8448);
    const int gw = obid() * 8 + w, NGW = gridDim.x * 8;
    for (int it = gw; it < 13312; it += NGW) {
        int r = it;
        if (r < 5632) { const int j = r / 2816; r -= j * 2816; const int kb = r / 176, nb = r % 176, n0 = 32 * nb, pn = n0 >> 8, loc = n0 & 255;
            const int src = (loc >> 7) * DFF + 128 * pn + (loc & 127);
            transpose_item(a.in[12] + (size_t)(l * 2 + j) * 1024 * 5632, 5632, src, 64 * kb, (bf16_t*)(a.ws + WS_WFI) + (size_t)j * 5632 * 1024, 1024, n0, scr, lane); continue; }
        r -= 5632;
        if (r < 2816) { const int j = r / 1408; r -= j * 1408; const int kb = r / 32, nb = r % 32;
            transpose_item(a.in[13] + (size_t)(l * 2 + j) * DFF * 1024, 1024, 32 * nb, 64 * kb, (bf16_t*)(a.ws + WS_WFO) + (size_t)j * 1024 * DFF, DFF, 32 * nb, scr, lane); continue; }
        r -= 2816;
        if (r < 3584) { const int kb = r / 224, nb = r % 224;
            transpose_item(a.in[14] + (size_t)l * 1024 * INW, INW, 32 * nb, 64 * kb, (bf16_t*)(a.ws + WS_WIN), 1024, 32 * nb, scr, lane); continue; }
        r -= 3584;
        if (r < 768) { const int k = r / 256; r -= k * 256; const int kb = r / 32, nb = r % 32;
            transpose_item(a.in[19] + (size_t)(l * 3 + k) * 512 * 1024, 1024, 32 * nb, 64 * kb, (bf16_t*)(a.ws + WS_WBR) + (size_t)k * 1024 * 512, 512, 32 * nb, scr, lane); continue; }
        r -= 768;
        { const int kb = r / 32, nb = r % 32;
            transpose_item(a.in[20] + (size_t)l * 1024 * 1024, 1024, 32 * nb, 64 * kb, (bf16_t*)(a.ws + WS_WOUT), 1024, 32 * nb, scr, lane); }
    }
}

DI void phase_norm(const Args& a, int l, int j, bool first) {
    const int tid = otid(), lane = tid & 63, w = tid >> 6;
    const int gw = obid() * 8 + w, NGW = gridDim.x * 8;
    const float* g = a.in[11] + (size_t)(l * 3 + j) * DM; const float* MOD = (const float*)(a.ws + WS_MOD) + (size_t)l * 9 * NMODW;
    bf16_t* HB = (bf16_t*)(a.ws + WS_HB);
    f32x4 gg[4];
#pragma unroll
    for (int jj = 0; jj < 4; ++jj) gg[jj] = *(const f32x4*)(g + 4 * lane + 256 * jj);
    for (int row = gw; row < T; row += NGW) {
        const float* xr = first ? (row < TC ? a.in[0] + (size_t)row * DM : a.in[1] + (size_t)(row - TC) * DM) : a.out + (size_t)row * DM;
        const int cond = row < TC ? 8 : ((row - TC) >> 11);
        const float* shift = MOD + (size_t)cond * NMODW + 3 * j * DM; const float* scale = shift + DM;
        f32x4 v[4]; float ss = 0.f;
#pragma unroll
        for (int jj = 0; jj < 4; ++jj) { v[jj] = *(const f32x4*)(xr + 4 * lane + 256 * jj); ss += (v[jj][0] * v[jj][0] + v[jj][1] * v[jj][1]) + (v[jj][2] * v[jj][2] + v[jj][3] * v[jj][3]); }
        const float rstd = rsqrtf(wave_sum(ss) * (1.f / DM) + EPS);
#pragma unroll
        for (int jj = 0; jj < 4; ++jj) { const f32x4 sc = *(const f32x4*)(scale + 4 * lane + 256 * jj), sh = *(const f32x4*)(shift + 4 * lane + 256 * jj);
            const f32x4 y = v[jj] * rstd * gg[jj] * (1.f + sc) + sh;
            u32x2 o; o.x = pk2(y[0], y[1]); o.y = pk2(y[2], y[3]);
            *(u32x2*)(HB + (size_t)row * DM + 4 * lane + 256 * jj) = o; }
    }
}
DI void phase_final(const Args& a) {
    const int tid = otid(), lane = tid & 63, w = tid >> 6;
    const int gw = obid() * 8 + w, NGW = gridDim.x * 8;
    const float* g = a.in[21];
    f32x4 gg[4];
#pragma unroll
    for (int jj = 0; jj < 4; ++jj) gg[jj] = *(const f32x4*)(g + 4 * lane + 256 * jj);
    for (int row = gw; row < T; row += NGW) {
        float* xr = a.out + (size_t)row * DM;
        f32x4 v[4]; float ss = 0.f;
#pragma unroll
        for (int jj = 0; jj < 4; ++jj) { v[jj] = *(const f32x4*)(xr + 4 * lane + 256 * jj); ss += (v[jj][0] * v[jj][0] + v[jj][1] * v[jj][1]) + (v[jj][2] * v[jj][2] + v[jj][3] * v[jj][3]); }
        const float rstd = rsqrtf(wave_sum(ss) * (1.f / DM) + EPS);
#pragma unroll
        for (int jj = 0; jj < 4; ++jj) *(f32x4*)(xr + 4 * lane + 256 * jj) = v[jj] * rstd * gg[jj];
    }
}

DI void phase_prep(const Args& a, int l) {
    const int tid = otid(), lane = tid & 63, w = tid >> 6;
    const int gw = obid() * 8 + w, NGW = gridDim.x * 8;
    bf16_t* PROJ = (bf16_t*)(a.ws + WS_PROJ);
    const float* cosT = (const float*)(a.ws + WS_ROPE); const float* sinT = cosT + 1024;
    const float qg = a.in[15][(l * 2 + 0) * 64 + lane], kg = a.in[15][(l * 2 + 1) * 64 + lane];
    bf16_t* KAL = (bf16_t*)(a.ws + WS_KAL); bf16_t* VAL = (bf16_t*)(a.ws + WS_VAL); bf16_t* KWL = (bf16_t*)(a.ws + WS_KWL); bf16_t* VWL = (bf16_t*)(a.ws + WS_VWL);
    bf16_t* KAC = (bf16_t*)(a.ws + WS_KAC); bf16_t* VAC = (bf16_t*)(a.ws + WS_VAC); bf16_t* KWC = (bf16_t*)(a.ws + WS_KWC); bf16_t* VWC = (bf16_t*)(a.ws + WS_VWC);
    for (int r = gw; r < T + 2048; r += NGW) {
        if (r < T) {
            const bool lat = r >= TC; int b, t;
            if (lat) { b = (r - TC) >> 11; t = (r - TC) & 2047; } else { b = r >> 8; t = r & 255; }
            float cs = 1.f, sn = 0.f;
            if (lat) { const int pos = (lane & 32) ? (t & 63) : (t >> 6); cs = cosT[pos * 16 + (lane & 15)]; sn = sinT[pos * 16 + (lane & 15)]; if (!(lane & 16)) sn = -sn; }
            bf16_t* pr = PROJ + (size_t)r * INW;
#pragma unroll
            for (int h = 0; h < 8; ++h) {
                const float x = bf2f(pr[C_AQ + 64 * h + lane]); const float ss = wave_sum(x * x);
                float y = x * rsqrtf(ss * (1.f / 64.f) + EPS) * qg;
                if (lat) { const float p = __shfl_xor(y, 16); y = y * cs + p * sn; }
                pr[C_AQ + 64 * h + lane] = f2bf(y * 0.125f);
            }
#pragma unroll
            for (int h = 0; h < 8; ++h) {
                float y = bf2f(pr[C_WQ + 64 * h + lane]);
                if (lat) { const float p = __shfl_xor(y, 16); y = y * cs + p * sn; }
                pr[C_WQ + 64 * h + lane] = f2bf(y * 0.125f);
            }
#pragma unroll
            for (int g2 = 0; g2 < 2; ++g2) {
                const float x = bf2f(pr[C_AK + 64 * g2 + lane]); const float ss = wave_sum(x * x);
                float y = x * rsqrtf(ss * (1.f / 64.f) + EPS) * kg;
                if (lat) { const float p = __shfl_xor(y, 16); y = y * cs + p * sn; }
                const bf16_t vbits = pr[C_AV + 64 * g2 + lane];
                float yw = bf2f(pr[C_WK + 64 * g2 + lane]);
                if (lat) { const float p = __shfl_xor(yw, 16); yw = yw * cs + p * sn; }
                const bf16_t wvbits = pr[C_WV + 64 * g2 + lane];
                if (lat) {
                    KAL[((size_t)(b * 2 + g2) * 2304 + 256 + t) * 64 + lane] = f2bf(y);
                    VAL[((size_t)(b * 2 + g2) * 64 + lane) * 2304 + 256 + t] = vbits;
                    KWL[((size_t)(b * 2 + g2) * 2304 + 256 + t) * 64 + lane] = f2bf(yw);
                    VWL[((size_t)(b * 2 + g2) * 64 + lane) * 2304 + 256 + t] = wvbits;
                } else {
                    KAC[((size_t)(b * 2 + g2) * 256 + t) * 64 + lane] = f2bf(y);
                    VAC[((size_t)(b * 2 + g2) * 64 + lane) * 256 + t] = vbits;
                    KWC[((size_t)(b * 2 + g2) * 256 + t) * 64 + lane] = f2bf(yw);
                    VWC[((size_t)(b * 2 + g2) * 64 + lane) * 256 + t] = wvbits;
                    const size_t oi = ((((size_t)b * DEPTH + l) * 256 + t) * 2 + g2) * 64 + lane;
                    a.out[O_NKA + oi] = y; a.out[O_NVA + oi] = bf2f(vbits); a.out[O_NKW + oi] = yw; a.out[O_NVW + oi] = bf2f(wvbits);
                }
            }
        } else {
            const int idx = r - T, b = idx >> 8, p = idx & 255;
#pragma unroll
            for (int g2 = 0; g2 < 2; ++g2) {
                const size_t ci = ((((size_t)b * DEPTH + l) * 256 + p) * 2 + g2) * 64 + lane;
                KAL[((size_t)(b * 2 + g2) * 2304 + p) * 64 + lane] = f2bf(a.in[2][ci]);
                VAL[((size_t)(b * 2 + g2) * 64 + lane) * 2304 + p] = f2bf(a.in[3][ci]);
                KWL[((size_t)(b * 2 + g2) * 2304 + p) * 64 + lane] = f2bf(a.in[4][ci]);
                VWL[((size_t)(b * 2 + g2) * 64 + lane) * 2304 + p] = f2bf(a.in[5][ci]);
            }
        }
    }
}

DI void attn_item(unsigned char* lds, const bf16_t* qp, bf16_t* op, const bf16_t* Kb, const bf16_t* VTb, int nk, int nA, int lo, int hi, bool win, int tq, bool has_sink, float sink2) {
    const int tid = otid(), lane = tid & 63, h = lane >> 5, c = lane & 31;
    const int ntile = nA + (hi - lo);
    bf16_t* Kst0 = (bf16_t*)lds; bf16_t* Vst0 = (bf16_t*)(lds + 9216);
    bf16x8 qf[4];
#pragma unroll
    for (int s = 0; s < 4; ++s) qf[s] = *(const bf16x8*)(qp + 16 * s + 8 * h);
    f32x16 O0, O1;
#pragma unroll
    for (int i = 0; i < 16; ++i) { O0[i] = 0.f; O1[i] = 0.f; }
    float m = has_sink ? sink2 : -1e30f; float lsum = (has_sink && h == 0) ? 1.f : 0.f;
    const int lrow = tid >> 3, lch = tid & 7;
    u32x4 kreg, vreg;
    { const int k0 = (0 < nA ? 0 : 4 + lo) * 64; kreg = *(const u32x4*)(Kb + (size_t)(k0 + lrow) * 64 + 8 * lch); vreg = *(const u32x4*)(VTb + (size_t)lrow * nk + k0 + 8 * lch); }
    *(u32x4*)(Kst0 + lrow * 72 + 8 * lch) = kreg; *(u32x4*)(Vst0 + lrow * 72 + 8 * lch) = vreg;
    __syncthreads();
    for (int i = 0; i < ntile; ++i) {
        const int cur = i & 1;
        const int k0 = (i < nA ? i : 4 + lo + (i - nA)) * 64;
        if (i + 1 < ntile) { const int k1 = (i + 1 < nA ? i + 1 : 4 + lo + (i + 1 - nA)) * 64;
            kreg = *(const u32x4*)(Kb + (size_t)(k1 + lrow) * 64 + 8 * lch); vreg = *(const u32x4*)(VTb + (size_t)lrow * nk + k1 + 8 * lch); }
        const bf16_t* Kc = Kst0 + cur * 9216; const bf16_t* Vc = Vst0 + cur * 9216;
        f32x16 st0, st1;
#pragma unroll
        for (int ii = 0; ii < 16; ++ii) { st0[ii] = 0.f; st1[ii] = 0.f; }
#pragma unroll
        for (int s = 0; s < 4; ++s) {
            const bf16x8 a0 = *(const bf16x8*)(Kc + c * 72 + 16 * s + 8 * h), a1 = *(const bf16x8*)(Kc + (32 + c) * 72 + 16 * s + 8 * h);
            st0 = MFMA32(a0, qf[s], st0); st1 = MFMA32(a1, qf[s], st1);
        }
        const bool domask = win && (i >= nA);
        float mx = -1e30f;
#pragma unroll
        for (int ii = 0; ii < 16; ++ii) {
            float v0 = st0[ii] * LOG2E, v1 = st1[ii] * LOG2E;
            if (domask) { const int d0 = tq - (k0 - 256 + crow(ii, h)); if (d0 > 128 || d0 < -128) v0 = -1e30f; const int d1 = d0 - 32; if (d1 > 128 || d1 < -128) v1 = -1e30f; }
            st0[ii] = v0; st1[ii] = v1; mx = fmaxf(mx, fmaxf(v0, v1));
        }
        mx = fmaxf(mx, __shfl_xor(mx, 32));
        const float mnew = fmaxf(m, mx); const float alpha = __builtin_amdgcn_exp2f(m - mnew); m = mnew;
        float ps = 0.f;
#pragma unroll
        for (int ii = 0; ii < 16; ++ii) { const float p0 = __builtin_amdgcn_exp2f(st0[ii] - mnew), p1 = __builtin_amdgcn_exp2f(st1[ii] - mnew); st0[ii] = p0; st1[ii] = p1; ps += p0 + p1; }
        lsum = lsum * alpha + ps;
#pragma unroll
        for (int ii = 0; ii < 16; ++ii) { O0[ii] *= alpha; O1[ii] *= alpha; }
#pragma unroll
        for (int s2 = 0; s2 < 2; ++s2) {
            const bf16x8 pb0 = pack8(st0[8 * s2], st0[8 * s2 + 1], st0[8 * s2 + 2], st0[8 * s2 + 3], st0[8 * s2 + 4], st0[8 * s2 + 5], st0[8 * s2 + 6], st0[8 * s2 + 7]);
            const bf16x8 pb1 = pack8(st1[8 * s2], st1[8 * s2 + 1], st1[8 * s2 + 2], st1[8 * s2 + 3], st1[8 * s2 + 4], st1[8 * s2 + 5], st1[8 * s2 + 6], st1[8 * s2 + 7]);
            {   const bf16_t* v0p = Vc + c * 72 + 16 * s2 + 4 * h; const bf16_t* v1p = Vc + (32 + c) * 72 + 16 * s2 + 4 * h;
                const bf16x8 a00 = cat44(*(const s16x4*)(v0p), *(const s16x4*)(v0p + 8)), a10 = cat44(*(const s16x4*)(v1p), *(const s16x4*)(v1p + 8));
                const bf16x8 a01 = cat44(*(const s16x4*)(v0p + 32), *(const s16x4*)(v0p + 40)), a11 = cat44(*(const s16x4*)(v1p + 32), *(const s16x4*)(v1p + 40));
                O0 = MFMA32(a00, pb0, O0); O1 = MFMA32(a10, pb0, O1); O0 = MFMA32(a01, pb1, O0); O1 = MFMA32(a11, pb1, O1); }
        }
        if (i + 1 < ntile) { *(u32x4*)(Kst0 + (cur ^ 1) * 9216 + lrow * 72 + 8 * lch) = kreg; *(u32x4*)(Vst0 + (cur ^ 1) * 9216 + lrow * 72 + 8 * lch) = vreg; }
        __syncthreads();
    }
    lsum += __shfl_xor(lsum, 32);
    const float inv = 1.f / lsum;
#pragma unroll
    for (int g4 = 0; g4 < 4; ++g4) {
        u32x2 w0, w1;
        w0.x = pk2(O0[4 * g4] * inv, O0[4 * g4 + 1] * inv); w0.y = pk2(O0[4 * g4 + 2] * inv, O0[4 * g4 + 3] * inv);
        w1.x = pk2(O1[4 * g4] * inv, O1[4 * g4 + 1] * inv); w1.y = pk2(O1[4 * g4 + 2] * inv, O1[4 * g4 + 3] * inv);
        *(u32x2*)(op + 8 * g4 + 4 * h) = w0; *(u32x2*)(op + 32 + 8 * g4 + 4 * h) = w1;
    }
}

DI void hgrn_item(const Args& a, unsigned char* lds, int l, int seq, int hd) {
    const int tid = otid(), lane = tid & 63, w = tid >> 6, dir = w >> 2, wd = w & 3, tg = tid & 255, h = lane >> 5, c = lane & 31;
    const bool lat = seq < 8; const int b = lat ? seq : seq - 8; const int L = lat ? 2048 : 256; const int nch = L >> 5; const int seqbase = lat ? TC + b * 2048 : b * 256;
    unsigned char* base = lds + dir * 73728;
    bf16_t* RQ = (bf16_t*)base; bf16_t* RZ = (bf16_t*)(base + 8704); bf16_t* RV = (bf16_t*)(base + 17408);
    bf16_t* QS = (bf16_t*)(base + 26112); bf16_t* KS = (bf16_t*)(base + 34816); bf16_t* QB = (bf16_t*)(base + 43520);
    bf16_t* KLT = (bf16_t*)(base + 52224); bf16_t* VT = (bf16_t*)(base + 62464); float* DEC = (float*)(base + 72704);
    const bf16_t* PROJ = (const bf16_t*)(a.ws + WS_PROJ);
    float* OF = (float*)(a.ws + WS_OF);
    const int cq = C_HQ + 128 * hd, cz = (dir ? C_HFB : C_HFF) + 128 * hd, cv = C_HI + 128 * hd;
    f32x16 S[4];
    if (lat) { const float* sp = a.in[6] + ((((size_t)(b * DEPTH + l) * 2 + dir) * 4 + hd) * 128) * 128;
#pragma unroll
        for (int dt = 0; dt < 4; ++dt)
#pragma unroll
            for (int ii = 0; ii < 16; ++ii) S[dt][ii] = sp[(size_t)(32 * dt + crow(ii, h)) * 128 + 32 * wd + c];
    } else {
#pragma unroll
        for (int dt = 0; dt < 4; ++dt)
#pragma unroll
            for (int ii = 0; ii < 16; ++ii) S[dt][ii] = 0.f;
    }
    const int dmy = 32 * wd + c;
    const float lbv = ((const float*)(a.ws + WS_LB))[(l * 2 + dir) * 512 + 128 * hd + dmy];
    const float omlb = 1.f - lbv;
    u32x4 rq[2], rz[2], rv[2];
#define HG_GLOAD(ch) do { _Pragma("unroll") for (int i_ = 0; i_ < 2; ++i_) { const int idx_ = tg + 256 * i_, t_ = idx_ >> 4, cn_ = idx_ & 15, p_ = 32 * (ch) + t_, pos_ = dir ? L - 1 - p_ : p_; \
        const bf16_t* rp_ = PROJ + (size_t)(seqbase + pos_) * INW + 8 * cn_; rq[i_] = *(const u32x4*)(rp_ + cq); rz[i_] = *(const u32x4*)(rp_ + cz); rv[i_] = *(const u32x4*)(rp_ + cv); } } while (0)
    HG_GLOAD(0);
    for (int ch = 0; ch < nch; ++ch) {
#pragma unroll
        for (int i = 0; i < 2; ++i) { const int idx = tg + 256 * i, t = idx >> 4, cn = idx & 15;
            *(u32x4*)(RQ + t * 136 + 8 * cn) = rq[i]; *(u32x4*)(RZ + t * 136 + 8 * cn) = rz[i]; *(u32x4*)(RV + t * 136 + 8 * cn) = rv[i]; }
        __syncthreads();
        if (ch + 1 < nch) HG_GLOAD(ch + 1);
        {
            float qv[16], kv[16], gv[16]; float tot = 0.f;
#pragma unroll
            for (int tt = 0; tt < 16; ++tt) { const int t = 16 * h + tt; const float qr = bf2f(RQ[t * 136 + dmy]), z = bf2f(RZ[t * 136 + dmy]);
                const float sg = sigmoidf_(z); const float f = lbv + omlb * sg; const float g = __logf(fmaxf(f, 1e-30f));
                kv[tt] = omlb * (1.f - sg); qv[tt] = qr * sigmoidf_(qr); gv[tt] = g; tot += g; }
            const float other = __shfl_xor(tot, 32); const float tot0 = h ? other : tot, tot1 = h ? tot : other;
            float e[16];
            if (h == 0) { float run = 0.f;
#pragma unroll
                for (int tt = 15; tt >= 0; --tt) { e[tt] = run; run -= gv[tt]; }
            } else { float run = 0.f;
#pragma unroll
                for (int tt = 0; tt < 16; ++tt) { run += gv[tt]; e[tt] = run; } }
            float kl[16];
#pragma unroll
            for (int tt = 0; tt < 16; ++tt) { const int t = 16 * h + tt; const float ex = __expf(e[tt]), exn = __expf(-e[tt]);
                QS[t * 136 + dmy] = f2bf(qv[tt] * ex); KS[t * 136 + dmy] = f2bf(kv[tt] * exn); QB[t * 136 + dmy] = f2bf(qv[tt] * __expf(e[tt] + tot0)); kl[tt] = kv[tt] * __expf(tot1 - e[tt]); }
            *(bf16x8*)(KLT + dmy * 40 + 16 * h) = pack8(kl[0], kl[1], kl[2], kl[3], kl[4], kl[5], kl[6], kl[7]);
            *(bf16x8*)(KLT + dmy * 40 + 16 * h + 8) = pack8(kl[8], kl[9], kl[10], kl[11], kl[12], kl[13], kl[14], kl[15]);
            if (h == 0) DEC[dmy] = __expf(tot0 + tot1);
            bf16x8 v0, v1;
#pragma unroll
            for (int tt = 0; tt < 8; ++tt) { v0[tt] = (short)RV[(16 * h + tt) * 136 + dmy]; v1[tt] = (short)RV[(16 * h + 8 + tt) * 136 + dmy]; }
            *(bf16x8*)(VT + dmy * 40 + 16 * h) = v0; *(bf16x8*)(VT + dmy * 40 + 16 * h + 8) = v1;
        }
        __syncthreads();
        f32x16 st;
#pragma unroll
        for (int ii = 0; ii < 16; ++ii) st[ii] = 0.f;
#pragma unroll
        for (int s = 0; s < 8; ++s) { const bf16x8 ak = *(const bf16x8*)(KS + c * 136 + 16 * s + 8 * h), bq = *(const bf16x8*)(QS + c * 136 + 16 * s + 8 * h); st = MFMA32(ak, bq, st); }
#pragma unroll
        for (int ii = 0; ii < 16; ++ii) if (crow(ii, h) > c) st[ii] = 0.f;
        f32x16 o;
#pragma unroll
        for (int ii = 0; ii < 16; ++ii) o[ii] = 0.f;
#pragma unroll
        for (int s2 = 0; s2 < 2; ++s2) {
            const bf16x8 pb = pack8(st[8 * s2], st[8 * s2 + 1], st[8 * s2 + 2], st[8 * s2 + 3], st[8 * s2 + 4], st[8 * s2 + 5], st[8 * s2 + 6], st[8 * s2 + 7]);
            const bf16_t* vp = VT + dmy * 40 + 16 * s2 + 4 * h;
            o = MFMA32(cat44(*(const s16x4*)vp, *(const s16x4*)(vp + 8)), pb, o);
        }
#pragma unroll
        for (int dt = 0; dt < 4; ++dt)
#pragma unroll
            for (int s2 = 0; s2 < 2; ++s2) {
                const bf16x8 xs = pack8(S[dt][8 * s2], S[dt][8 * s2 + 1], S[dt][8 * s2 + 2], S[dt][8 * s2 + 3], S[dt][8 * s2 + 4], S[dt][8 * s2 + 5], S[dt][8 * s2 + 6], S[dt][8 * s2 + 7]);
                const bf16_t* qb = QB + c * 136 + 32 * dt + 16 * s2 + 4 * h;
                o = MFMA32(xs, cat44(*(const s16x4*)qb, *(const s16x4*)(qb + 8)), o);
            }
        {   const int p = 32 * ch + c, pos = dir ? L - 1 - p : p;
            float* op = OF + ((size_t)dir * T + seqbase + pos) * 512 + 128 * hd + 32 * wd;
#pragma unroll
            for (int g4 = 0; g4 < 4; ++g4) { f32x4 v; v[0] = o[4 * g4]; v[1] = o[4 * g4 + 1]; v[2] = o[4 * g4 + 2]; v[3] = o[4 * g4 + 3]; *(f32x4*)(op + 8 * g4 + 4 * h) = v; } }
#pragma unroll
        for (int dt = 0; dt < 4; ++dt) {
#pragma unroll
            for (int g4 = 0; g4 < 4; ++g4) { const f32x4 dv4 = *(const f32x4*)(DEC + 32 * dt + 8 * g4 + 4 * h);
                S[dt][4 * g4] *= dv4[0]; S[dt][4 * g4 + 1] *= dv4[1]; S[dt][4 * g4 + 2] *= dv4[2]; S[dt][4 * g4 + 3] *= dv4[3]; }
#pragma unroll
            for (int s2 = 0; s2 < 2; ++s2) { const bf16x8 ak = *(const bf16x8*)(KLT + (32 * dt + c) * 40 + 16 * s2 + 8 * h), bv = *(const bf16x8*)(VT + dmy * 40 + 16 * s2 + 8 * h);
                S[dt] = MFMA32(ak, bv, S[dt]); }
        }
    }
#undef HG_GLOAD
    if (!lat) { float* sp = a.out + O_NST + ((((size_t)(b * DEPTH + l) * 2 + dir) * 4 + hd) * 128) * 128;
#pragma unroll
        for (int dt = 0; dt < 4; ++dt)
#pragma unroll
            for (int ii = 0; ii < 16; ++ii) sp[(size_t)(32 * dt + crow(ii, h)) * 128 + 32 * wd + c] = S[dt][ii];
    }
}

DI void phase_mixer(const Args& a, unsigned char* lds, int l) {
    unsigned* ctl = (unsigned*)(a.ws + WS_CTL) + 16 * l;
    volatile int* slot = (volatile int*)(lds + LDS_MISC);
    const int tid = otid(), lane = tid & 63, w = tid >> 6, c = lane & 31;
    bf16_t* PROJ = (bf16_t*)(a.ws + WS_PROJ);
    for (;;) {
        __syncthreads();
        if (tid == 0) *slot = (int)__hip_atomic_fetch_add(ctl, 1u, __ATOMIC_RELAXED, __HIP_MEMORY_SCOPE_AGENT);
        __syncthreads();
        const int it = *slot;
        if (it >= 1696) break;
#ifndef NO_HG
        if (it < 32) { hgrn_item(a, lds, l, it >> 2, it & 3); continue; }
        if (it >= 544 && it < 672) { const int idx = it - 544; hgrn_item(a, lds, l, 8 + (idx >> 2), idx & 3); continue; }
#endif
        int idx, kind;
        if (it < 544) { idx = it - 32; kind = 0; } else if (it < 1184) { idx = it - 672; kind = 1; } else if (it < 1440) { idx = it - 1184; kind = 2; } else { idx = it - 1440; kind = 3; }
        const bool lat = kind < 2, isw = kind & 1;
        int b, g, qb;
        if (lat) { b = idx >> 6; g = (idx >> 5) & 1; qb = idx & 31; } else { b = idx >> 3; g = (idx >> 2) & 1; qb = idx & 3; }
        const int r = w & 3, tq = 64 * qb + 32 * (w >> 2) + c;
        const int row = (lat ? TC + b * 2048 : b * 256) + tq;
        const bf16_t* qp = PROJ + (size_t)row * INW + (isw ? C_WQ : C_AQ) + (4 * g + r) * 64;
        bf16_t* op = (bf16_t*)(a.ws + (isw ? WS_OWIN : WS_OATT)) + (size_t)row * 512 + (4 * g + r) * 64;
        const bf16_t* Kb; const bf16_t* VTb; int nk;
        if (lat) { nk = 2304; Kb = (const bf16_t*)(a.ws + (isw ? WS_KWL : WS_KAL)) + (size_t)(b * 2 + g) * 2304 * 64; VTb = (const bf16_t*)(a.ws + (isw ? WS_VWL : WS_VAL)) + (size_t)(b * 2 + g) * 64 * 2304; }
        else { nk = 256; Kb = (const bf16_t*)(a.ws + (isw ? WS_KWC : WS_KAC)) + (size_t)(b * 2 + g) * 256 * 64; VTb = (const bf16_t*)(a.ws + (isw ? WS_VWC : WS_VAC)) + (size_t)(b * 2 + g) * 64 * 256; }
        int nA = 4, lo = 0, hi = 0; bool win = false;
        if (kind == 0) nA = 36;
        if (kind == 1) { lo = qb - 2 < 0 ? 0 : qb - 2; hi = qb + 3 > 32 ? 32 : qb + 3; win = true; }
        const float sink2 = isw ? a.in[18][l * 8 + 4 * g + r] * LOG2E : 0.f;
#ifndef NO_ATT
        attn_item(lds, qp, op, Kb, VTb, nk, nA, lo, hi, win, tq, isw, sink2);
#endif
    }
}

DI void phase_hgcomb(const Args& a, int l) {
    const int tid = otid(), lane = tid & 63, w = tid >> 6;
    const int gw = obid() * 8 + w, NGW = gridDim.x * 8;
    const float* OF = (const float*)(a.ws + WS_OF); const bf16_t* PROJ = (const bf16_t*)(a.ws + WS_PROJ); bf16_t* OHG = (bf16_t*)(a.ws + WS_OHG);
    const f32x2 gn = *(const f32x2*)(a.in[17] + l * 128 + 2 * lane);
    for (int it = gw; it < T * 4; it += NGW) {
        const int row = it >> 2, hd = it & 3;
        const f32x2 x0 = *(const f32x2*)(OF + (size_t)row * 512 + 128 * hd + 2 * lane), x1 = *(const f32x2*)(OF + ((size_t)T + row) * 512 + 128 * hd + 2 * lane);
        const float s0 = x0[0] + x1[0], s1 = x0[1] + x1[1];
        const float rstd = rsqrtf(wave_sum(s0 * s0 + s1 * s1) * (1.f / 128.f) + EPS);
        const unsigned gb = *(const unsigned*)(PROJ + (size_t)row * INW + C_HG + 128 * hd + 2 * lane);
        const float g0 = bflo(gb), g1 = bfhi(gb);
        *(unsigned*)(OHG + (size_t)row * 512 + 128 * hd + 2 * lane) = pk2(s0 * rstd * gn[0] * g0 * sigmoidf_(g0), s1 * rstd * gn[1] * g1 * sigmoidf_(g1));
    }
}

template <class Epi> DI void run_gemm(unsigned char* lds, const bf16_t* A, const bf16_t* Bt, int N, int K, const Epi& E) {
    pg8::Gemm g{A, Bt, T, N, K}; pg8::StaticOrder S; S.init(T, N, (int)gridDim.x, obid());
    pg8::gemm_phase<Epi, pg8::StaticOrder, false>((PG8_LAS unsigned char*)lds, g, S, E, nullptr);
}

__global__ void __launch_bounds__(512, 2) mk_fwd(Args a) {
    extern __shared__ __attribute__((aligned(16))) unsigned char lds[];
    cg::grid_group grid = cg::this_grid();
    bf16_t* HB = (bf16_t*)(a.ws + WS_HB); bf16_t* PROJ = (bf16_t*)(a.ws + WS_PROJ); bf16_t* ACT = PROJ;
    float* M32 = (float*)(a.ws + WS_OF);
    for (int ph = a.ph_lo; ph < a.ph_hi; ++ph) {
        if (ph > a.ph_lo) grid.sync();
#ifndef NO_P0
        if (ph == 0) { phase_p0(a, lds); continue; }
#endif
#ifndef NO_C0
        if (ph == NPH - 1) { phase_final(a); continue; }
#endif
        const int l = (ph - 1) / 13, k = (ph - 1) % 13;
        const float* MODL = (const float*)(a.ws + WS_MOD) + (size_t)l * 9 * NMODW;
        const float* xa = a.out; const float* xb = a.out + (size_t)TC * DM;
        const bf16_t* WFI = (const bf16_t*)(a.ws + WS_WFI); const bf16_t* WFO = (const bf16_t*)(a.ws + WS_WFO);
        if (k == 100) {}
#ifndef NO_C0
        else if (k == 0) { phase_wconv(a, lds, l); phase_norm(a, l, 0, l == 0); }
        else if (k == 3 || k == 10) { phase_norm(a, l, k == 3 ? 1 : 2, false); }
#endif
#ifndef NO_G_SW
        else if (k == 1 || k == 11) { run_gemm(lds, HB, k == 1 ? WFI : WFI + (size_t)5632 * 1024, 2 * DFF, DM, pg8::EpiSwiglu{ACT}); }
#endif
#ifndef NO_G_RES
        else if (k == 2 || k == 9 || k == 12) {
            if (k == 2 && l == 0) { xa = a.in[0]; xb = a.in[1]; }
            const bf16_t* A = k == 9 ? HB : ACT; const bf16_t* Bt = k == 9 ? (const bf16_t*)(a.ws + WS_WOUT) : (k == 2 ? WFO : WFO + (size_t)1024 * DFF);
            const int K = k == 9 ? DM : DFF; const int gi = k == 2 ? 2 : (k == 9 ? 5 : 8);
            run_gemm(lds, A, Bt, DM, K, pg8::EpiResid{xa, xb, a.out, MODL + gi * DM, k == 9 ? 1.0f : 0.5f});
        }
#endif
#ifndef NO_G_BF
        else if (k == 4) { run_gemm(lds, HB, (const bf16_t*)(a.ws + WS_WIN), INW, DM, pg8::EpiBf16P{PROJ, INW}); }
#endif
#ifndef NO_PREP
        else if (k == 5) { phase_prep(a, l); }
#endif
#ifndef NO_MIX
        else if (k == 6) { phase_mixer(a, lds, l); }
#endif
#ifndef NO_C0
        else if (k == 7) { phase_hgcomb(a, l); }
#endif
#ifndef NO_G_BR
        else if (k == 8) {
            const bf16_t* WBR = (const bf16_t*)(a.ws + WS_WBR);
            for (int kk = 0; kk < 3; ++kk) {
                const bf16_t* A = (const bf16_t*)(a.ws + (kk == 0 ? WS_OATT : (kk == 1 ? WS_OHG : WS_OWIN)));
                run_gemm(lds, A, WBR + (size_t)kk * 1024 * 512, DM, 512, pg8::EpiBranch{PROJ + C_GA + 1024 * kk, M32, HB, kk});
            }
        }
#endif
    }
}

#ifndef MK_PER_PHASE
#define MK_PER_PHASE 0
#endif
extern "C" void kernel_launch(void* const* d_in, const int* in_sizes, int n_in, void* d_out, int out_size, void* d_ws, size_t ws_size, hipStream_t stream) {
    static int grid = 0;
    if (!grid) {
        if (n_in != 22 || ws_size < WS_END) { fprintf(stderr, "kernel_launch: unexpected n_in %d or ws_size %zu < %zu\n", n_in, ws_size, (size_t)WS_END); grid = -1; return; }
        int dev = 0, cus = 0, per_cu = 0;
        hipGetDevice(&dev); hipDeviceGetAttribute(&cus, hipDeviceAttributeMultiprocessorCount, dev);
        if (hipFuncSetAttribute((const void*)mk_fwd, hipFuncAttributeMaxDynamicSharedMemorySize, LDS_BYTES) != hipSuccess) { fprintf(stderr, "kernel_launch: hipFuncSetAttribute failed\n"); grid = -1; return; }
        hipOccupancyMaxActiveBlocksPerMultiprocessor(&per_cu, mk_fwd, 512, LDS_BYTES);
        if (per_cu < 1) per_cu = 1;
        grid = cus * per_cu; if (grid > 256) grid = 256;
    }
    if (grid < 0) return;
    hipMemsetAsync((char*)d_ws + WS_CTL, 0, 4096, stream);
    Args a{};
    for (int i = 0; i < 22; ++i) a.in[i] = (const float*)d_in[i];
    a.out = (float*)d_out; a.ws = (unsigned char*)d_ws;
#if MK_PER_PHASE
    for (int ph = 0; ph < NPH; ++ph) { a.ph_lo = ph; a.ph_hi = ph + 1; hipLaunchKernelGGL(mk_fwd, dim3(grid), dim3(512), LDS_BYTES, stream, a); }
#else
    a.ph_lo = 0; a.ph_hi = NPH;
    void* args[] = {&a};
    hipError_t e = hipLaunchCooperativeKernel((void*)mk_fwd, dim3(grid), dim3(512), args, LDS_BYTES, stream);
    if (e != hipSuccess) fprintf(stderr, "cooperative launch failed: %s (grid %d)\n", hipGetErrorString(e), grid);
#endif
}
```

```cpp
#include <hip/hip_runtime.h>
#include <hip/hip_cooperative_groups.h>
#include <cstdio>
#include <cstdint>
namespace cg = cooperative_groups;

#ifndef PROBE_MASK
#define PROBE_MASK 0
#endif
#define DI __device__ __forceinline__
typedef unsigned short bf16_t;
typedef short bf16x8 __attribute__((ext_vector_type(8)));
typedef short s16x4 __attribute__((ext_vector_type(4)));
typedef float f32x2 __attribute__((ext_vector_type(2)));
typedef float f32x4 __attribute__((ext_vector_type(4)));
typedef float f32x16 __attribute__((ext_vector_type(16)));
typedef unsigned u32x2 __attribute__((ext_vector_type(2)));
typedef unsigned u32x4 __attribute__((ext_vector_type(4)));
typedef __bf16 bf16x2n __attribute__((ext_vector_type(2)));

DI int otid() { int t = threadIdx.x; asm volatile("" : "+v"(t)); return t; }
DI int obid() { int b = blockIdx.x; asm volatile("" : "+s"(b)); return b; }
DI unsigned pk2(float lo, float hi) { f32x2 v = {lo, hi}; return __builtin_bit_cast(unsigned, __builtin_convertvector(v, bf16x2n)); }
DI float bflo(unsigned u) { return __uint_as_float(u << 16); }
DI float bfhi(unsigned u) { return __uint_as_float(u & 0xffff0000u); }
DI float bf2f(bf16_t b) { return __uint_as_float(((unsigned)b) << 16); }
DI bf16_t f2bf(float f) { return (bf16_t)(pk2(f, 0.f) & 0xffffu); }
DI float sigmoidf_(float x) { return __builtin_amdgcn_rcpf(1.f + __expf(-x)); }
DI float wave_sum(float v) {
#pragma unroll
    for (int o = 1; o < 64; o <<= 1) v += __shfl_xor(v, o);
    return v;
}
#define MFMA32(a, b, c) __builtin_amdgcn_mfma_f32_32x32x16_bf16((a), (b), (c), 0, 0, 0)
DI bf16x8 pack8(float a0, float a1, float a2, float a3, float a4, float a5, float a6, float a7) {
    u32x4 p; p.x = pk2(a0, a1); p.y = pk2(a2, a3); p.z = pk2(a4, a5); p.w = pk2(a6, a7); return __builtin_bit_cast(bf16x8, p);
}
DI bf16x8 cat44(s16x4 lo, s16x4 hi) { return __builtin_shufflevector(lo, hi, 0, 1, 2, 3, 4, 5, 6, 7); }

constexpr int DM = 1024, DEPTH = 4, TC = 8192, TL = 16384, T = 24576, DFF = 2816, INW = 7168, NMODW = 9216;
constexpr int C_AQ = 0, C_AK = 512, C_AV = 640, C_WQ = 768, C_WK = 1280, C_WV = 1408, C_HQ = 1536, C_HFF = 2048, C_HFB = 2560, C_HI = 3072, C_HG = 3584, C_GA = 4096;
constexpr float EPS = 1e-6f, LOG2E = 1.4426950408889634f;
constexpr size_t O_X = 0, O_NKA = 25165824, O_NVA = 29360128, O_NKW = 33554432, O_NVW = 37748736, O_NST = 41943040;
constexpr size_t al256(size_t x) { return (x + 255) & ~(size_t)255; }
constexpr size_t WS_CTL = 0;
constexpr size_t WS_BAR = 4096;
constexpr size_t CTL_BYTES = 32768;
constexpr size_t WS_MOD = CTL_BYTES;
constexpr size_t WS_LB = WS_MOD + al256((size_t)DEPTH * 9 * NMODW * 4);
constexpr size_t WS_ROPE = WS_LB + 16384;
constexpr size_t WS_WFI = WS_ROPE + 8192;
constexpr size_t WS_WFO = WS_WFI + (size_t)2 * 5632 * 1024 * 2;
constexpr size_t WS_WIN = WS_WFO + (size_t)2 * 1024 * 2816 * 2;
constexpr size_t WS_WBR = WS_WIN + (size_t)7168 * 1024 * 2;
constexpr size_t WS_WOUT = WS_WBR + (size_t)3 * 1024 * 512 * 2;
constexpr size_t WS_HB = WS_WOUT + (size_t)1024 * 1024 * 2;
constexpr size_t WS_PROJ = WS_HB + (size_t)T * 1024 * 2;
constexpr size_t WS_OATT = WS_PROJ + (size_t)T * INW * 2;
constexpr size_t WS_OHG = WS_OATT + (size_t)T * 512 * 2;
constexpr size_t WS_OWIN = WS_OHG + (size_t)T * 512 * 2;
constexpr size_t WS_OF = WS_OWIN + (size_t)T * 512 * 2;
constexpr size_t WS_KAL = WS_OF + (size_t)2 * T * 512 * 4;
constexpr size_t SZ_KL = (size_t)8 * 2 * 2304 * 64 * 2, SZ_KC = (size_t)32 * 2 * 256 * 64 * 2;
constexpr size_t WS_VAL = WS_KAL + SZ_KL;
constexpr size_t WS_KWL = WS_VAL + SZ_KL;
constexpr size_t WS_VWL = WS_KWL + SZ_KL;
constexpr size_t WS_KAC = WS_VWL + SZ_KL;
constexpr size_t WS_VAC = WS_KAC + SZ_KC;
constexpr size_t WS_KWC = WS_VAC + SZ_KC;
constexpr size_t WS_VWC = WS_KWC + SZ_KC;
constexpr size_t WS_END = WS_VWC + SZ_KC;
constexpr int LDS_BYTES = 160 * 1024, LDS_MISC = 159 * 1024;
constexpr int NPH = 1 + 13 * DEPTH + 1;

struct Args { const float* in[22]; float* out; unsigned char* ws; int ph_lo, ph_hi; };

namespace pg8 {
#define PG8_LAS __attribute__((address_space(3)))
typedef unsigned short bf16_t;
typedef short bf16x8 __attribute__((ext_vector_type(8)));
typedef float f32x4 __attribute__((ext_vector_type(4)));
typedef unsigned u32x4 __attribute__((ext_vector_type(4)));
constexpr int BM = 256, BK = 64, HALF = 128, HTB = HALF * BK * 2  , STAGE_BYTES = 8 * HTB, NXCD = 8, WGM = 8;

__host__ __device__ __forceinline__ int lds_byte(int r, int c) { const int st = (r >> 4) * 2 + (c >> 5), rr = r & 15, cc = c & 31, ob = rr * 64 + cc * 2; return st * 1024 + (ob ^ (((ob >> 9) & 1) << 5)); }
__host__ __device__ __forceinline__ void stage_rc(int b, int& R, int& C) { const int st = b / 1024, sb = b % 1024, swz = sb ^ (((sb >> 9) & 1) << 5); R = (st >> 1) * 16 + swz / 64; C = (st & 1) * 32 + (swz % 64) / 2; }
__host__ __device__ __forceinline__ int perm32(int rho) { const int n = rho >> 4, i = rho & 15; return 8 * (i >> 2) + 4 * n + (i & 3); }

struct Unit { int pm, pn; };
struct Gemm { const bf16_t* A; const bf16_t* Bt; int M, N, K; };

struct StaticOrder {
    int nM, nN, nwg, G, c;
    __host__ __device__ void init(int M, int N, int G_, int c_) { nM = M / BM; nN = N / BM; nwg = nM * nN; G = G_; c = c_; }
    __host__ __device__ bool next(int i, Unit& u) const {
        const long L = (long)i * G + c; if (L >= nwg) return false;
        int wgid = (int)L; { const int q = nwg / NXCD, r = nwg % NXCD, xcd = wgid % NXCD, off = wgid / NXCD; wgid = (xcd < r ? xcd * (q + 1) : r * (q + 1) + (xcd - r) * q) + off; }
        const int nig = WGM * nN, gid = wgid / nig, fm = gid * WGM, gsz = (nM - fm) < WGM ? (nM - fm) : WGM;
        u.pm = fm + ((wgid % nig) % gsz); u.pn = (wgid % nig) / gsz; return true;
    }
    __device__ __forceinline__ void a_ready(const Unit&) const {}
    __device__ __forceinline__ void done(const Unit&) const {}
};
struct EpiBf16P {
    static constexpr bool PERM = true, AFTER_DRAIN = false;
    bf16_t* O; int ldc;
    __device__ __forceinline__ void operator()(const f32x4 (&acc)[2][2][4][2], const Unit& u, int wr, int wc, int fr, int fq) const {
        const int row0 = u.pm * BM + wr * 64 + fr, col0 = u.pn * BM + wc * 32 + 8 * fq;
#pragma unroll
        for (int ai = 0; ai < 2; ++ai)
#pragma unroll
            for (int m = 0; m < 4; ++m) { bf16_t* rowp = O + (size_t)(row0 + ai * HALF + m * 16) * ldc + col0;
#pragma unroll
                for (int bj = 0; bj < 2; ++bj) { const f32x4 v0 = acc[ai][bj][m][0], v1 = acc[ai][bj][m][1];
                    u32x4 w; w.x = pk2(v0[0], v0[1]); w.y = pk2(v0[2], v0[3]); w.z = pk2(v1[0], v1[1]); w.w = pk2(v1[2], v1[3]);
                    *(u32x4*)(rowp + bj * HALF) = w; } }
    }
};
struct EpiSwiglu {
    static constexpr bool PERM = true, AFTER_DRAIN = false;
    bf16_t* O;
    __device__ __forceinline__ void operator()(const f32x4 (&acc)[2][2][4][2], const Unit& u, int wr, int wc, int fr, int fq) const {
        const int row0 = u.pm * BM + wr * 64 + fr, col0 = u.pn * HALF + wc * 32 + 8 * fq;
#pragma unroll
        for (int ai = 0; ai < 2; ++ai)
#pragma unroll
            for (int m = 0; m < 4; ++m) { bf16_t* rowp = O + (size_t)(row0 + ai * HALF + m * 16) * DFF + col0;
                float r[8];
#pragma unroll
                for (int n = 0; n < 2; ++n)
#pragma unroll
                    for (int j = 0; j < 4; ++j) { const float g = acc[ai][0][m][n][j], up = acc[ai][1][m][n][j]; r[4 * n + j] = g * __builtin_amdgcn_rcpf(1.f + __expf(-g)) * up; }
                u32x4 w; w.x = pk2(r[0], r[1]); w.y = pk2(r[2], r[3]); w.z = pk2(r[4], r[5]); w.w = pk2(r[6], r[7]);
                *(u32x4*)rowp = w; }
    }
};
struct EpiResid {
    static constexpr bool PERM = false, AFTER_DRAIN = false;
    const float* xa; const float* xb; float* out; const float* mod; float coef;
    __device__ __forceinline__ void operator()(const f32x4 (&acc)[2][2][4][2], const Unit& u, int wr, int wc, int fr, int fq) const {
        const int row0 = u.pm * BM + wr * 64 + fr, col0 = u.pn * BM + wc * 32 + 4 * fq;
#pragma unroll
        for (int ai = 0; ai < 2; ++ai)
#pragma unroll
            for (int m = 0; m < 4; ++m) { const int row = row0 + ai * HALF + m * 16; const int cond = row < TC ? 8 : ((row - TC) >> 11);
                const float* bp = row < TC ? xa + (size_t)row * DM : xb + (size_t)(row - TC) * DM; const float* mp = mod + (size_t)cond * NMODW; float* op = out + (size_t)row * DM;
#pragma unroll
                for (int bj = 0; bj < 2; ++bj)
#pragma unroll
                    for (int n = 0; n < 2; ++n) { const int c = col0 + bj * HALF + n * 16; const f32x4 b = *(const f32x4*)(bp + c), g = *(const f32x4*)(mp + c);
                        *(f32x4*)(op + c) = b + coef * g * acc[ai][bj][m][n]; } }
    }
};
struct EpiBranch {
    static constexpr bool PERM = false, AFTER_DRAIN = false;
    const bf16_t* gate; float* acc32; bf16_t* outbf; int mode;
    __device__ __forceinline__ void operator()(const f32x4 (&acc)[2][2][4][2], const Unit& u, int wr, int wc, int fr, int fq) const {
        const int row0 = u.pm * BM + wr * 64 + fr, col0 = u.pn * BM + wc * 32 + 4 * fq;
#pragma unroll
        for (int ai = 0; ai < 2; ++ai)
#pragma unroll
            for (int m = 0; m < 4; ++m) { const int row = row0 + ai * HALF + m * 16;
#pragma unroll
                for (int bj = 0; bj < 2; ++bj)
#pragma unroll
                    for (int n = 0; n < 2; ++n) { const int c = col0 + bj * HALF + n * 16;
                        const u32x2 gv = *(const u32x2*)(gate + (size_t)row * INW + c);
                        f32x4 g; g[0] = sigmoidf_(bflo(gv.x)); g[1] = sigmoidf_(bfhi(gv.x)); g[2] = sigmoidf_(bflo(gv.y)); g[3] = sigmoidf_(bfhi(gv.y));
                        f32x4 v = g * acc[ai][bj][m][n];
                        float* ap = acc32 + (size_t)row * DM + c;
                        if (mode == 0) { *(f32x4*)ap = v; }
                        else if (mode == 1) { v += *(const f32x4*)ap; *(f32x4*)ap = v; }
                        else { v += *(const f32x4*)ap; u32x2 w; w.x = pk2(v[0], v[1]); w.y = pk2(v[2], v[3]); *(u32x2*)(outbf + (size_t)row * DM + c) = w; } } }
    }
};

template <class Epi, class Sched, bool STAMP = false>
__device__ __forceinline__ void gemm_phase(PG8_LAS unsigned char* lds, const Gemm g, const Sched& S, const Epi& E, unsigned long long* stamps) {
    const int tid = otid(), wid = __builtin_amdgcn_readfirstlane(tid >> 6), lane = tid & 63, wr = wid >> 2, wc = wid & 3, fr = lane & 15, fq = lane >> 4;
    const int K = g.K, nt = K / BK;
    int ts_lo = 0, ts_hi = 0, nts = 0; const unsigned long long rt_entry = STAMP ? (unsigned long long)wall_clock64() : 0ull;
#define PG8_STAMP() do { if (STAMP && wid == 0 && nts < 64) { const unsigned long long _c = (unsigned long long)clock64(); \
        ts_lo = (lane == nts) ? (int)(unsigned)_c : ts_lo; ts_hi = (lane == nts) ? (int)(unsigned)(_c >> 32) : ts_hi; ++nts; } } while (0)
    PG8_STAMP();
    unsigned voffA[2], voffB[2];
#pragma unroll
    for (int i = 0; i < 2; ++i) { int R, C; stage_rc(tid * 16 + i * 8192, R, C); const int Rb = Epi::PERM ? ((R & ~31) + perm32(R & 31)) : R;
        voffA[i] = (unsigned)(R * K + C) * 2u; voffB[i] = (unsigned)(Rb * K + C) * 2u; }
    const size_t kstep = (size_t)(BK * 2);
    const size_t hstep = (size_t)HALF * K * 2;
    const size_t tstep = 2 * hstep;
    const unsigned ldsw = (unsigned)wid * 1024u;
    const int aoff = lds_byte(wr * 64 + fr, fq * 8), boff = lds_byte(wc * 32 + fr, fq * 8);
#define PG8_SA(b, h) (((b) * 2 + (h)) * HTB)
#define PG8_SB(b, h) ((4 + (b) * 2 + (h)) * HTB)
#define PG8_STAGE(bufoff, gbase, voff) do { _Pragma("unroll") for (int _i = 0; _i < 2; ++_i) \
        __builtin_amdgcn_global_load_lds((const unsigned*)((const char*)(gbase) + (voff)[_i]), (PG8_LAS unsigned*)(lds + (bufoff) + ldsw + _i * 8192), 16, 0, 0); } while (0)
#define PG8_LDA(dst, b, h) do { _Pragma("unroll") for (int m = 0; m < 4; ++m) _Pragma("unroll") for (int k = 0; k < 2; ++k) dst[m][k] = *(const PG8_LAS bf16x8*)(lds + PG8_SA(b, h) + aoff + m * 2048 + k * 1024); } while (0)
#define PG8_LDB(dst, b, h) do { _Pragma("unroll") for (int n = 0; n < 2; ++n) _Pragma("unroll") for (int k = 0; k < 2; ++k) dst[n][k] = *(const PG8_LAS bf16x8*)(lds + PG8_SB(b, h) + boff + n * 2048 + k * 1024); } while (0)
#define PG8_MMA(ai, bj, At, Bt) do { __builtin_amdgcn_s_setprio(1); _Pragma("unroll") for (int m = 0; m < 4; ++m) _Pragma("unroll") for (int n = 0; n < 2; ++n) _Pragma("unroll") for (int k = 0; k < 2; ++k) \
        acc[ai][bj][m][n] = __builtin_amdgcn_mfma_f32_16x16x32_bf16(Bt[n][k], At[m][k], acc[ai][bj][m][n], 0, 0, 0); __builtin_amdgcn_s_setprio(0); } while (0)
#define PG8_WAIT_V(n) asm volatile("s_waitcnt vmcnt(" #n ")" ::: "memory")
#define PG8_WAIT_L(n) asm volatile("s_waitcnt lgkmcnt(" #n ")" ::: "memory")
#define PG8_BAR __builtin_amdgcn_s_barrier()
#define PG8_SCHED __builtin_amdgcn_sched_barrier(0)
    Unit cur, nxt; int ui = 0;
    if (!S.next(0, cur)) return;
    f32x4 acc[2][2][4][2];
#pragma unroll
    for (int a = 0; a < 2; ++a)
#pragma unroll
        for (int b = 0; b < 2; ++b)
#pragma unroll
            for (int m = 0; m < 4; ++m)
#pragma unroll
                for (int n = 0; n < 2; ++n) acc[a][b][m][n] = (f32x4){0.f, 0.f, 0.f, 0.f};
    bf16x8 At[4][2], B0[2][2], B1[2][2];
    const char* cA = (const char*)g.A + (size_t)cur.pm * tstep; const char* cB = (const char*)g.Bt + (size_t)cur.pn * tstep;
    S.a_ready(cur);
    PG8_STAGE(PG8_SB(0, 0), cB, voffB); PG8_STAGE(PG8_SA(0, 0), cA, voffA); PG8_STAGE(PG8_SB(0, 1), cB + hstep, voffB); PG8_STAGE(PG8_SA(0, 1), cA + hstep, voffA);
    if (wr == 1) PG8_BAR;
    PG8_WAIT_V(4); PG8_BAR;
    PG8_STAGE(PG8_SB(1, 0), cB + kstep, voffB); PG8_STAGE(PG8_SA(1, 0), cA + kstep, voffA); PG8_STAGE(PG8_SB(1, 1), cB + hstep + kstep, voffB);
    PG8_WAIT_V(6); PG8_BAR;
    PG8_STAMP();
    for (;;) {
        const bool has_next = S.next(ui + 1, nxt);
        const char* nA = has_next ? (const char*)g.A + (size_t)nxt.pm * tstep : cA; const char* nB = has_next ? (const char*)g.Bt + (size_t)nxt.pn * tstep : cB;
        for (int t = 0; t < nt; t += 2) {
            const bool last = (t == nt - 2);
            const char* a1 = cA + (size_t)(t + 1) * kstep;
            const char* a2 = last ? nA : cA + (size_t)(t + 2) * kstep; const char* b2 = last ? nB : cB + (size_t)(t + 2) * kstep;
            const char* a3 = a2 + kstep; const char* b3 = b2 + kstep;
            if (last && has_next) S.a_ready(nxt);
            PG8_LDB(B0, 0, 0); PG8_SCHED; PG8_LDA(At, 0, 0); PG8_STAGE(PG8_SA(1, 1), a1 + hstep, voffA);
            PG8_WAIT_L(8); PG8_BAR; PG8_WAIT_L(0); PG8_MMA(0, 0, At, B0); PG8_BAR; PG8_SCHED;
            PG8_LDB(B1, 0, 1); PG8_STAGE(PG8_SB(0, 0), b2, voffB);
            PG8_BAR; PG8_WAIT_L(0); PG8_MMA(0, 1, At, B1); PG8_BAR;
            PG8_LDA(At, 0, 1); PG8_STAGE(PG8_SA(0, 0), a2, voffA);
            PG8_BAR; PG8_WAIT_L(0); PG8_MMA(1, 0, At, B0); PG8_BAR; PG8_SCHED;
            PG8_STAGE(PG8_SB(0, 1), b2 + hstep, voffB);
            PG8_WAIT_V(6); PG8_BAR; PG8_MMA(1, 1, At, B1); PG8_BAR;
            PG8_LDB(B0, 1, 0); PG8_SCHED; PG8_LDA(At, 1, 0); PG8_STAGE(PG8_SA(0, 1), a2 + hstep, voffA);
            PG8_WAIT_L(8); PG8_BAR; PG8_WAIT_L(0); PG8_MMA(0, 0, At, B0); PG8_BAR; PG8_SCHED;
            PG8_LDB(B1, 1, 1); PG8_STAGE(PG8_SB(1, 0), b3, voffB);
            PG8_BAR; PG8_WAIT_L(0); PG8_MMA(0, 1, At, B1); PG8_BAR;
            PG8_LDA(At, 1, 1); PG8_STAGE(PG8_SA(1, 0), a3, voffA);
            PG8_BAR; PG8_WAIT_L(0); PG8_MMA(1, 0, At, B0); PG8_BAR; PG8_SCHED;
            PG8_STAGE(PG8_SB(1, 1), b3 + hstep, voffB);
            PG8_WAIT_V(6); PG8_BAR; PG8_MMA(1, 1, At, B1); PG8_BAR;
        }
        PG8_STAMP();
        if constexpr (!Epi::AFTER_DRAIN) { E(acc, cur, wr, wc, fr, fq); S.done(cur); }
        PG8_STAMP();
        if (!has_next) break;
#pragma unroll
        for (int a = 0; a < 2; ++a)
#pragma unroll
            for (int b = 0; b < 2; ++b)
#pragma unroll
                for (int m = 0; m < 4; ++m)
#pragma unroll
                    for (int n = 0; n < 2; ++n) acc[a][b][m][n] = (f32x4){0.f, 0.f, 0.f, 0.f};
        cur = nxt; cA = nA; cB = nB; ++ui;
    }
    PG8_WAIT_V(0);
    if (wr == 0) PG8_BAR;
    PG8_BAR;
    if constexpr (Epi::AFTER_DRAIN) { E.fused(acc, cur, wr, wc, fr, fq, lds, wid, lane); S.done(cur); }
    PG8_STAMP();
    if (STAMP && wid == 0) { stamps[lane] = lane < nts ? (((unsigned long long)(unsigned)ts_hi << 32) | (unsigned)ts_lo) : 0ull;
        if (lane == 62) stamps[62] = rt_entry; if (lane == 63) stamps[63] = (unsigned long long)wall_clock64(); }
#undef PG8_STAMP
#undef PG8_SA
#undef PG8_SB
#undef PG8_STAGE
#undef PG8_LDA
#undef PG8_LDB
#undef PG8_MMA
#undef PG8_WAIT_V
#undef PG8_WAIT_L
#undef PG8_BAR
#undef PG8_SCHED
}
}
DI int crow(int i, int h) { return (i & 3) + 8 * (i >> 2) + 4 * h; }
#define LDS_WAIT() asm volatile("s_waitcnt lgkmcnt(0)" ::: "memory")


DI void phase_p0(const Args& a, unsigned char* lds) {
    float* s = (float*)lds; float* red = (float*)(lds + 36864);
    const int tid = otid(), lane = tid & 63, w = tid >> 6;
    float* MOD = (float*)(a.ws + WS_MOD);
    if ((int)blockIdx.x < 144) {
        const float* c = a.in[7]; const float* cctx = a.in[8];
        for (int i = tid; i < 9 * 1024; i += 512) { const int ci = i >> 10, k = i & 1023; const float v = ci < 8 ? c[ci * 1024 + k] : cctx[k]; s[i] = v * sigmoidf_(v); }
        __syncthreads();
        for (int item = blockIdx.x; item < 144; item += gridDim.x) {
            const int l = item / 36, cc = item % 36;
            const float* W = a.in[9] + (size_t)l * 1024 * NMODW + cc * 256 + 4 * lane;
            f32x4 acc[9];
#pragma unroll
            for (int ci = 0; ci < 9; ++ci) acc[ci] = (f32x4){0.f, 0.f, 0.f, 0.f};
#pragma unroll 2
            for (int k4 = 0; k4 < 32; ++k4) {
                const int k = w * 128 + k4 * 4;
                const f32x4 w0 = *(const f32x4*)(W + (size_t)(k + 0) * NMODW), w1 = *(const f32x4*)(W + (size_t)(k + 1) * NMODW),
                            w2 = *(const f32x4*)(W + (size_t)(k + 2) * NMODW), w3 = *(const f32x4*)(W + (size_t)(k + 3) * NMODW);
#pragma unroll
                for (int ci = 0; ci < 9; ++ci) { const f32x4 sv = *(const f32x4*)(s + ci * 1024 + k); acc[ci] += sv[0] * w0 + sv[1] * w1 + sv[2] * w2 + sv[3] * w3; }
            }
#pragma unroll
            for (int ci = 0; ci < 9; ++ci) *(f32x4*)(red + ((w * 9 + ci) * 256 + 4 * lane)) = acc[ci];
            __syncthreads();
            for (int i = tid; i < 9 * 256; i += 512) { const int ci = i >> 8, col = i & 255; float v = 0.f;
#pragma unroll
                for (int ww = 0; ww < 8; ++ww) v += red[(ww * 9 + ci) * 256 + col];
                v += a.in[10][l * NMODW + cc * 256 + col];
                MOD[((size_t)l * 9 + ci) * NMODW + cc * 256 + col] = v; }
            __syncthreads();
        }
    }
    if (blockIdx.x == gridDim.x - 1) {
        float* LB = (float*)(a.ws + WS_LB); const float* lbin = a.in[16];
        for (int e = tid; e < 1024; e += 512) {
            const float x0 = lbin[e], x1 = lbin[1024 + e], x2 = lbin[2048 + e], x3 = lbin[3072 + e];
            const float mx = fmaxf(fmaxf(x0, x1), fmaxf(x2, x3));
            const float e0 = __expf(x0 - mx), e1 = __expf(x1 - mx), e2 = __expf(x2 - mx), e3 = __expf(x3 - mx); const float inv = 1.f / (e0 + e1 + e2 + e3);
            LB[e] = 0.f; LB[1024 + e] = e1 * inv; LB[2048 + e] = (e1 + e2) * inv; LB[3072 + e] = (e1 + e2 + e3) * inv;
        }
        float* cosT = (float*)(a.ws + WS_ROPE); float* sinT = cosT + 1024;
        for (int e = tid; e < 1024; e += 512) { const int pos = e >> 4, i = e & 15; const float inv = exp2f(-(float)i * (13.287712379549449f / 16.f)); const float ang = (float)pos * inv;
            cosT[e] = cosf(ang); sinT[e] = sinf(ang); }
    }
}

DI void transpose_item(const float* W, int ldw, int srccol0, int k0, bf16_t* WT, int K, int dstrow0, float* scr, int lane) {
#pragma unroll 8
    for (int i = 0; i < 32; ++i) { const int kk = 2 * i + (lane >> 5); scr[kk * 33 + (lane & 31)] = W[(size_t)(k0 + kk) * ldw + srccol0 + (lane & 31)]; }
    LDS_WAIT();
    const int c = lane & 7;
#pragma unroll
    for (int j = 0; j < 4; ++j) { const int n = (lane >> 3) + 8 * j; const float* sp = scr + (8 * c) * 33 + n;
        u32x4 o; o.x = pk2(sp[0 * 33], sp[1 * 33]); o.y = pk2(sp[2 * 33], sp[3 * 33]); o.z = pk2(sp[4 * 33], sp[5 * 33]); o.w = pk2(sp[6 * 33], sp[7 * 33]);
        *(u32x4*)(WT + (size_t)(dstrow0 + n) * K + k0 + 8 * c) = o; }
    LDS_WAIT();
}
DI void phase_wconv(const Args& a, unsigned char* lds, int l) {
    const int tid = otid(), lane = tid & 63, w = tid >> 6;
    float* scr = (float*)(lds + w * 8448);
    const int gw = obid() * 8 + w, NGW = gridDim.x * 8;
    for (int it = gw; it < 13312; it += NGW) {
        int r = it;
        if (r < 5632) { const int j = r / 2816; r -= j * 2816; const int kb = r / 176, nb = r % 176, n0 = 32 * nb, pn = n0 >> 8, loc = n0 & 255;
            const int src = (loc >> 7) * DFF + 128 * pn + (loc & 127);
            transpose_item(a.in[12] + (size_t)(l * 2 + j) * 1024 * 5632, 5632, src, 64 * kb, (bf16_t*)(a.ws + WS_WFI) + (size_t)j * 5632 * 1024, 1024, n0, scr, lane); continue; }
        r -= 5632;
        if (r < 2816) { const int j = r / 1408; r -= j * 1408; const int kb = r / 32, nb = r % 32;
            transpose_item(a.in[13] + (size_t)(l * 2 + j) * DFF * 1024, 1024, 32 * nb, 64 * kb, (bf16_t*)(a.ws + WS_WFO) + (size_t)j * 1024 * DFF, DFF, 32 * nb, scr, lane); continue; }
        r -= 2816;
        if (r < 3584) { const int kb = r / 224, nb = r % 224;
            transpose_item(a.in[14] + (size_t)l * 1024 * INW, INW, 32 * nb, 64 * kb, (bf16_t*)(a.ws + WS_WIN), 1024, 32 * nb, scr, lane); continue; }
        r -= 3584;
        if (r < 768) { const int k = r / 256; r -= k * 256; const int kb = r / 32, nb = r % 32;
            transpose_item(a.in[19] + (size_t)(l * 3 + k) * 512 * 1024, 1024, 32 * nb, 64 * kb, (bf16_t*)(a.ws + WS_WBR) + (size_t)k * 1024 * 512, 512, 32 * nb, scr, lane); continue; }
        r -= 768;
        { const int kb = r / 32, nb = r % 32;
            transpose_item(a.in[20] + (size_t)l * 1024 * 1024, 1024, 32 * nb, 64 * kb, (bf16_t*)(a.ws + WS_WOUT), 1024, 32 * nb, scr, lane); }
    }
}

DI void phase_norm(const Args& a, int l, int j, bool first) {
    const int tid = otid(), lane = tid & 63, w = tid >> 6;
    const int gw = obid() * 8 + w, NGW = gridDim.x * 8;
    const float* g = a.in[11] + (size_t)(l * 3 + j) * DM; const float* MOD = (const float*)(a.ws + WS_MOD) + (size_t)l * 9 * NMODW;
    bf16_t* HB = (bf16_t*)(a.ws + WS_HB);
    f32x4 gg[4];
#pragma unroll
    for (int jj = 0; jj < 4; ++jj) gg[jj] = *(const f32x4*)(g + 4 * lane + 256 * jj);
    for (int row = gw; row < T; row += NGW) {
        const float* xr = first ? (row < TC ? a.in[0] + (size_t)row * DM : a.in[1] + (size_t)(row - TC) * DM) : a.out + (size_t)row * DM;
        const int cond = row < TC ? 8 : ((row - TC) >> 11);
        const float* shift = MOD + (size_t)cond * NMODW + 3 * j * DM; const float* scale = shift + DM;
        f32x4 v[4]; float ss = 0.f;
#pragma unroll
        for (int jj = 0; jj < 4; ++jj) { v[jj] = *(const f32x4*)(xr + 4 * lane + 256 * jj); ss += (v[jj][0] * v[jj][0] + v[jj][1] * v[jj][1]) + (v[jj][2] * v[jj][2] + v[jj][3] * v[jj][3]); }
        const float rstd = rsqrtf(wave_sum(ss) * (1.f / DM) + EPS);
#pragma unroll
        for (int jj = 0; jj < 4; ++jj) { const f32x4 sc = *(const f32x4*)(scale + 4 * lane + 256 * jj), sh = *(const f32x4*)(shift + 4 * lane + 256 * jj);
            const f32x4 y = v[jj] * rstd * gg[jj] * (1.f + sc) + sh;
            u32x2 o; o.x = pk2(y[0], y[1]); o.y = pk2(y[2], y[3]);
            *(u32x2*)(HB + (size_t)row * DM + 4 * lane + 256 * jj) = o; }
    }
}
DI void phase_final(const Args& a) {
    const int tid = otid(), lane = tid & 63, w = tid >> 6;
    const int gw = obid() * 8 + w, NGW = gridDim.x * 8;
    const float* g = a.in[21];
    f32x4 gg[4];
#pragma unroll
    for (int jj = 0; jj < 4; ++jj) gg[jj] = *(const f32x4*)(g + 4 * lane + 256 * jj);
    for (int row = gw; row < T; row += NGW) {
        float* xr = a.out + (size_t)row * DM;
        f32x4 v[4]; float ss = 0.f;
#pragma unroll
        for (int jj = 0; jj < 4; ++jj) { v[jj] = *(const f32x4*)(xr + 4 * lane + 256 * jj); ss += (v[jj][0] * v[jj][0] + v[jj][1] * v[jj][1]) + (v[jj][2] * v[jj][2] + v[jj][3] * v[jj][3]); }
        const float rstd = rsqrtf(wave_sum(ss) * (1.f / DM) + EPS);
#pragma unroll
        for (int jj = 0; jj < 4; ++jj) *(f32x4*)(xr + 4 * lane + 256 * jj) = v[jj] * rstd * gg[jj];
    }
}

DI void phase_prep(const Args& a, int l) {
    const int tid = otid(), lane = tid & 63, w = tid >> 6;
    const int gw = obid() * 8 + w, NGW = gridDim.x * 8;
    bf16_t* PROJ = (bf16_t*)(a.ws + WS_PROJ);
    const float* cosT = (const float*)(a.ws + WS_ROPE); const float* sinT = cosT + 1024;
    const float qg = a.in[15][(l * 2 + 0) * 64 + lane], kg = a.in[15][(l * 2 + 1) * 64 + lane];
    bf16_t* KAL = (bf16_t*)(a.ws + WS_KAL); bf16_t* VAL = (bf16_t*)(a.ws + WS_VAL); bf16_t* KWL = (bf16_t*)(a.ws + WS_KWL); bf16_t* VWL = (bf16_t*)(a.ws + WS_VWL);
    bf16_t* KAC = (bf16_t*)(a.ws + WS_KAC); bf16_t* VAC = (bf16_t*)(a.ws + WS_VAC); bf16_t* KWC = (bf16_t*)(a.ws + WS_KWC); bf16_t* VWC = (bf16_t*)(a.ws + WS_VWC);
    for (int r = gw; r < T + 2048; r += NGW) {
        if (r < T) {
            const bool lat = r >= TC; int b, t;
            if (lat) { b = (r - TC) >> 11; t = (r - TC) & 2047; } else { b = r >> 8; t = r & 255; }
            float cs = 1.f, sn = 0.f;
            if (lat) { const int pos = (lane & 32) ? (t & 63) : (t >> 6); cs = cosT[pos * 16 + (lane & 15)]; sn = sinT[pos * 16 + (lane & 15)]; if (!(lane & 16)) sn = -sn; }
            bf16_t* pr = PROJ + (size_t)r * INW;
#pragma unroll
            for (int h = 0; h < 8; ++h) {
                const float x = bf2f(pr[C_AQ + 64 * h + lane]); const float ss = wave_sum(x * x);
                float y = x * rsqrtf(ss * (1.f / 64.f) + EPS) * qg;
                if (lat) { const float p = __shfl_xor(y, 16); y = y * cs + p * sn; }
                pr[C_AQ + 64 * h + lane] = f2bf(y * 0.125f);
            }
#pragma unroll
            for (int h = 0; h < 8; ++h) {
                float y = bf2f(pr[C_WQ + 64 * h + lane]);
                if (lat) { const float p = __shfl_xor(y, 16); y = y * cs + p * sn; }
                pr[C_WQ + 64 * h + lane] = f2bf(y * 0.125f);
            }
#pragma unroll
            for (int g2 = 0; g2 < 2; ++g2) {
                const float x = bf2f(pr[C_AK + 64 * g2 + lane]); const float ss = wave_sum(x * x);
                float y = x * rsqrtf(ss * (1.f / 64.f) + EPS) * kg;
                if (lat) { const float p = __shfl_xor(y, 16); y = y * cs + p * sn; }
                const bf16_t vbits = pr[C_AV + 64 * g2 + lane];
                float yw = bf2f(pr[C_WK + 64 * g2 + lane]);
                if (lat) { const float p = __shfl_xor(yw, 16); yw = yw * cs + p * sn; }
                const bf16_t wvbits = pr[C_WV + 64 * g2 + lane];
                if (lat) {
                    KAL[((size_t)(b * 2 + g2) * 2304 + 256 + t) * 64 + lane] = f2bf(y);
                    VAL[((size_t)(b * 2 + g2) * 64 + lane) * 2304 + 256 + t] = vbits;
                    KWL[((size_t)(b * 2 + g2) * 2304 + 256 + t) * 64 + lane] = f2bf(yw);
                    VWL[((size_t)(b * 2 + g2) * 64 + lane) * 2304 + 256 + t] = wvbits;
                } else {
                    KAC[((size_t)(b * 2 + g2) * 256 + t) * 64 + lane] = f2bf(y);
                    VAC[((size_t)(b * 2 + g2) * 64 + lane) * 256 + t] = vbits;
                    KWC[((size_t)(b * 2 + g2) * 256 + t) * 64 + lane] = f2bf(yw);
                    VWC[((size_t)(b * 2 + g2) * 64 + lane) * 256 + t] = wvbits;
                    const size_t oi = ((((size_t)b * DEPTH + l) * 256 + t) * 2 + g2) * 64 + lane;
                    a.out[O_NKA + oi] = y; a.out[O_NVA + oi] = bf2f(vbits); a.out[O_NKW + oi] = yw; a.out[O_NVW + oi] = bf2f(wvbits);
                }
            }
        } else {
            const int idx = r - T, b = idx >> 8, p = idx & 255;
#pragma unroll
            for (int g2 = 0; g2 < 2; ++g2) {
                const size_t ci = ((((size_t)b * DEPTH + l) * 256 + p) * 2 + g2) * 64 + lane;
                KAL[((size_t)(b * 2 + g2) * 2304 + p) * 64 + lane] = f2bf(a.in[2][ci]);
                VAL[((size_t)(b * 2 + g2) * 64 + lane) * 2304 + p] = f2bf(a.in[3][ci]);
                KWL[((size_t)(b * 2 + g2) * 2304 + p) * 64 + lane] = f2bf(a.in[4][ci]);
                VWL[((size_t)(b * 2 + g2) * 64 + lane) * 2304 + p] = f2bf(a.in[5][ci]);
            }
        }
    }
}

DI void attn_item(unsigned char* lds, const bf16_t* qp, bf16_t* op, const bf16_t* Kb, const bf16_t* VTb, int nk, int nA, int lo, int hi, bool win, int tq, bool has_sink, float sink2) {
    const int tid = otid(), lane = tid & 63, h = lane >> 5, c = lane & 31;
    const int ntile = nA + (hi - lo);
    bf16_t* Kst0 = (bf16_t*)lds; bf16_t* Vst0 = (bf16_t*)(lds + 9216);
    bf16x8 qf[4];
#pragma unroll
    for (int s = 0; s < 4; ++s) qf[s] = *(const bf16x8*)(qp + 16 * s + 8 * h);
    f32x16 O0, O1;
#pragma unroll
    for (int i = 0; i < 16; ++i) { O0[i] = 0.f; O1[i] = 0.f; }
    float m = has_sink ? sink2 : -1e30f; float lsum = (has_sink && h == 0) ? 1.f : 0.f;
    const int lrow = tid >> 3, lch = tid & 7;
    u32x4 kreg, vreg;
    { const int k0 = (0 < nA ? 0 : 4 + lo) * 64; kreg = *(const u32x4*)(Kb + (size_t)(k0 + lrow) * 64 + 8 * lch); vreg = *(const u32x4*)(VTb + (size_t)lrow * nk + k0 + 8 * lch); }
    *(u32x4*)(Kst0 + lrow * 72 + 8 * lch) = kreg; *(u32x4*)(Vst0 + lrow * 72 + 8 * lch) = vreg;
    __syncthreads();
    for (int i = 0; i < ntile; ++i) {
        const int cur = i & 1;
        const int k0 = (i < nA ? i : 4 + lo + (i - nA)) * 64;
        if (i + 1 < ntile) { const int k1 = (i + 1 < nA ? i + 1 : 4 + lo + (i + 1 - nA)) * 64;
            kreg = *(const u32x4*)(Kb + (size_t)(k1 + lrow) * 64 + 8 * lch); vreg = *(const u32x4*)(VTb + (size_t)lrow * nk + k1 + 8 * lch); }
        const bf16_t* Kc = Kst0 + cur * 9216; const bf16_t* Vc = Vst0 + cur * 9216;
        f32x16 st0, st1;
#pragma unroll
        for (int ii = 0; ii < 16; ++ii) { st0[ii] = 0.f; st1[ii] = 0.f; }
#pragma unroll
        for (int s = 0; s < 4; ++s) {
            const bf16x8 a0 = *(const bf16x8*)(Kc + c * 72 + 16 * s + 8 * h), a1 = *(const bf16x8*)(Kc + (32 + c) * 72 + 16 * s + 8 * h);
            st0 = MFMA32(a0, qf[s], st0); st1 = MFMA32(a1, qf[s], st1);
        }
        const bool domask = win && (i >= nA);
        float mx = -1e30f;
#pragma unroll
        for (int ii = 0; ii < 16; ++ii) {
            float v0 = st0[ii] * LOG2E, v1 = st1[ii] * LOG2E;
            if (domask) { const int d0 = tq - (k0 - 256 + crow(ii, h)); if (d0 > 128 || d0 < -128) v0 = -1e30f; const int d1 = d0 - 32; if (d1 > 128 || d1 < -128) v1 = -1e30f; }
            st0[ii] = v0; st1[ii] = v1; mx = fmaxf(mx, fmaxf(v0, v1));
        }
        mx = fmaxf(mx, __shfl_xor(mx, 32));
        const float mnew = fmaxf(m, mx); const float alpha = __builtin_amdgcn_exp2f(m - mnew); m = mnew;
        float ps = 0.f;
#pragma unroll
        for (int ii = 0; ii < 16; ++ii) { const float p0 = __builtin_amdgcn_exp2f(st0[ii] - mnew), p1 = __builtin_amdgcn_exp2f(st1[ii] - mnew); st0[ii] = p0; st1[ii] = p1; ps += p0 + p1; }
        lsum = lsum * alpha + ps;
#pragma unroll
        for (int ii = 0; ii < 16; ++ii) { O0[ii] *= alpha; O1[ii] *= alpha; }
#pragma unroll
        for (int s2 = 0; s2 < 2; ++s2) {
            const bf16x8 pb0 = pack8(st0[8 * s2], st0[8 * s2 + 1], st0[8 * s2 + 2], st0[8 * s2 + 3], st0[8 * s2 + 4], st0[8 * s2 + 5], st0[8 * s2 + 6], st0[8 * s2 + 7]);
            const bf16x8 pb1 = pack8(st1[8 * s2], st1[8 * s2 + 1], st1[8 * s2 + 2], st1[8 * s2 + 3], st1[8 * s2 + 4], st1[8 * s2 + 5], st1[8 * s2 + 6], st1[8 * s2 + 7]);
            {   const bf16_t* v0p = Vc + c * 72 + 16 * s2 + 4 * h; const bf16_t* v1p = Vc + (32 + c) * 72 + 16 * s2 + 4 * h;
                const bf16x8 a00 = cat44(*(const s16x4*)(v0p), *(const s16x4*)(v0p + 8)), a10 = cat44(*(const s16x4*)(v1p), *(const s16x4*)(v1p + 8));
                const bf16x8 a01 = cat44(*(const s16x4*)(v0p + 32), *(const s16x4*)(v0p + 40)), a11 = cat44(*(const s16x4*)(v1p + 32), *(const s16x4*)(v1p + 40));
                O0 = MFMA32(a00, pb0, O0); O1 = MFMA32(a10, pb0, O1); O0 = MFMA32(a01, pb1, O0); O1 = MFMA32(a11, pb1, O1); }
        }
        if (i + 1 < ntile) { *(u32x4*)(Kst0 + (cur ^ 1) * 9216 + lrow * 72 + 8 * lch) = kreg; *(u32x4*)(Vst0 + (cur ^ 1) * 9216 + lrow * 72 + 8 * lch) = vreg; }
        __syncthreads();
    }
    lsum += __shfl_xor(lsum, 32);
    const float inv = 1.f / lsum;
#pragma unroll
    for (int g4 = 0; g4 < 4; ++g4) {
        u32x2 w0, w1;
        w0.x = pk2(O0[4 * g4] * inv, O0[4 * g4 + 1] * inv); w0.y = pk2(O0[4 * g4 + 2] * inv, O0[4 * g4 + 3] * inv);
        w1.x = pk2(O1[4 * g4] * inv, O1[4 * g4 + 1] * inv); w1.y = pk2(O1[4 * g4 + 2] * inv, O1[4 * g4 + 3] * inv);
        *(u32x2*)(op + 8 * g4 + 4 * h) = w0; *(u32x2*)(op + 32 + 8 * g4 + 4 * h) = w1;
    }
}
#define LAS __attribute__((address_space(3)))
#define XB_TMO      128
#define XB_XCNT(j)  (256  + 64 * (j))
#define XB_XSUB(j)  (1280 + 64 * (j))
#define XB_XGEN(j)  (2304 + 64 * (j))
#define XB_TOP      3328
#define XB_TOPGEN   3392
#define XCD_BAR_WORDS 3456
#define XB_SPIN_CAP (1u << 18)

__device__ __forceinline__ unsigned xb_ld(unsigned* p)              { return __hip_atomic_load(p, __ATOMIC_RELAXED, __HIP_MEMORY_SCOPE_AGENT); }
__device__ __forceinline__ unsigned xb_add(unsigned* p, unsigned v) { return __hip_atomic_fetch_add(p, v, __ATOMIC_RELAXED, __HIP_MEMORY_SCOPE_AGENT); }
__device__ __forceinline__ unsigned xb_xcc_id() { return (unsigned)__builtin_amdgcn_s_getreg((3 << 11) | 20) & 0xFu; }
#define XB_SPIN(cond, bar) do { unsigned _sp = 0; while (cond) { __builtin_amdgcn_s_sleep(1); \
    if ((++_sp & 255u) == 0u) { if (xb_ld(&(bar)[XB_TMO])) break; if (_sp > XB_SPIN_CAP) { atomicAdd(&(bar)[XB_TMO], 1u); break; } } } } while (0)

struct XcdBarrier {
    unsigned* bar; unsigned x;
    volatile LAS unsigned* st;
};

__device__ __forceinline__ XcdBarrier xcd_barrier_post(unsigned* bar, volatile LAS unsigned* st) {
    XcdBarrier b; b.bar = bar; b.x = xb_xcc_id(); b.st = st;
    if (threadIdx.x == 0) (void)xb_add(&bar[XB_XCNT(b.x)], 1u);
    return b;
}
__device__ __forceinline__ void xcd_barrier_complete(unsigned* bar, unsigned x, unsigned& nloc, unsigned& nx) {
    const unsigned G = gridDim.x * gridDim.y * gridDim.z;
    unsigned sum, cnt, mine, sp = 0u;
    for (;;) {
        sum = 0u; cnt = 0u; mine = 0u;
#pragma unroll
        for (unsigned j = 0; j < 16; ++j) { const unsigned c = xb_ld(&bar[XB_XCNT(j)]); sum += c; cnt += (c > 0u) ? 1u : 0u; mine = (j == x) ? c : mine; }
        if (sum == G) break;
        __builtin_amdgcn_s_sleep(1);
        if ((++sp & 255u) == 0u) { if (xb_ld(&bar[XB_TMO])) break; if (sp > XB_SPIN_CAP) { atomicAdd(&bar[XB_TMO], 1u); break; } }
    }
    nloc = mine > 0u ? mine : 1u; nx = cnt > 0u ? cnt : 1u;
}

__device__ __forceinline__ void xcd_barrier(const XcdBarrier& b) {
    asm volatile("s_waitcnt vmcnt(0)" ::: "memory");
    __syncthreads();
    if (threadIdx.x == 0) {
        unsigned* bar = b.bar;
        __builtin_amdgcn_s_waitcnt(0);
        unsigned nloc = b.st[0], nx = b.st[1];
        if (nloc == 0u) { xcd_barrier_complete(bar, b.x, nloc, nx); b.st[0] = nloc; b.st[1] = nx; }
        const unsigned old = xb_add(&bar[XB_XSUB(b.x)], 1u);
        const unsigned gen = old / nloc;
        if (old + 1u == (gen + 1u) * nloc) {
            __builtin_amdgcn_fence(__ATOMIC_RELEASE, "agent");
            asm volatile("s_waitcnt vmcnt(0)" ::: "memory");
            const unsigned og = xb_add(&bar[XB_TOP], 1u);
            const unsigned tg = og / nx;
            if (og + 1u == (tg + 1u) * nx) xb_add(&bar[XB_TOPGEN], 1u);
            else XB_SPIN(xb_ld(&bar[XB_TOPGEN]) == tg, bar);
            __builtin_amdgcn_fence(__ATOMIC_ACQUIRE, "agent");
            xb_add(&bar[XB_XGEN(b.x)], 1u);
            asm volatile("s_waitcnt vmcnt(0)" ::: "memory");
        } else {
            XB_SPIN(xb_ld(&bar[XB_XGEN(b.x)]) == gen, bar);
            __builtin_amdgcn_fence(__ATOMIC_ACQUIRE, "agent");
            asm volatile("s_waitcnt vmcnt(0)" ::: "memory");
        }
    }
    __syncthreads();
}


DI void hgrn_item(const Args& a, unsigned char* lds, int l, int seq, int hd) {
    const int tid = otid(), lane = tid & 63, w = tid >> 6, dir = w >> 2, wd = w & 3, tg = tid & 255, h = lane >> 5, c = lane & 31;
    const bool lat = seq < 8; const int b = lat ? seq : seq - 8; const int L = lat ? 2048 : 256; const int nch = L >> 5; const int seqbase = lat ? TC + b * 2048 : b * 256;
    unsigned char* base = lds + dir * 73728;
    bf16_t* RQ = (bf16_t*)base; bf16_t* RZ = (bf16_t*)(base + 8704); bf16_t* RV = (bf16_t*)(base + 17408);
    bf16_t* QS = (bf16_t*)(base + 26112); bf16_t* KS = (bf16_t*)(base + 34816); bf16_t* QB = (bf16_t*)(base + 43520);
    bf16_t* KLT = (bf16_t*)(base + 52224); bf16_t* VT = (bf16_t*)(base + 62464); float* DEC = (float*)(base + 72704);
    const bf16_t* PROJ = (const bf16_t*)(a.ws + WS_PROJ);
    float* OF = (float*)(a.ws + WS_OF);
    const int cq = C_HQ + 128 * hd, cz = (dir ? C_HFB : C_HFF) + 128 * hd, cv = C_HI + 128 * hd;
    f32x16 S[4];
    if (lat) { const float* sp = a.in[6] + ((((size_t)(b * DEPTH + l) * 2 + dir) * 4 + hd) * 128) * 128;
#pragma unroll
        for (int dt = 0; dt < 4; ++dt)
#pragma unroll
            for (int ii = 0; ii < 16; ++ii) S[dt][ii] = sp[(size_t)(32 * dt + crow(ii, h)) * 128 + 32 * wd + c];
    } else {
#pragma unroll
        for (int dt = 0; dt < 4; ++dt)
#pragma unroll
            for (int ii = 0; ii < 16; ++ii) S[dt][ii] = 0.f;
    }
    const int dmy = 32 * wd + c;
    const float lbv = ((const float*)(a.ws + WS_LB))[(l * 2 + dir) * 512 + 128 * hd + dmy];
    const float omlb = 1.f - lbv;
    u32x4 rq[2], rz[2], rv[2];
#define HG_GLOAD(ch) do { _Pragma("unroll") for (int i_ = 0; i_ < 2; ++i_) { const int idx_ = tg + 256 * i_, t_ = idx_ >> 4, cn_ = idx_ & 15, p_ = 32 * (ch) + t_, pos_ = dir ? L - 1 - p_ : p_; \
        const bf16_t* rp_ = PROJ + (size_t)(seqbase + pos_) * INW + 8 * cn_; rq[i_] = *(const u32x4*)(rp_ + cq); rz[i_] = *(const u32x4*)(rp_ + cz); rv[i_] = *(const u32x4*)(rp_ + cv); } } while (0)
    HG_GLOAD(0);
    for (int ch = 0; ch < nch; ++ch) {
#pragma unroll
        for (int i = 0; i < 2; ++i) { const int idx = tg + 256 * i, t = idx >> 4, cn = idx & 15;
            *(u32x4*)(RQ + t * 136 + 8 * cn) = rq[i]; *(u32x4*)(RZ + t * 136 + 8 * cn) = rz[i]; *(u32x4*)(RV + t * 136 + 8 * cn) = rv[i]; }
        __syncthreads();
        if (ch + 1 < nch) HG_GLOAD(ch + 1);
        {
            float qv[16], kv[16], gv[16]; float tot = 0.f;
#pragma unroll
            for (int tt = 0; tt < 16; ++tt) { const int t = 16 * h + tt; const float qr = bf2f(RQ[t * 136 + dmy]), z = bf2f(RZ[t * 136 + dmy]);
                const float sg = sigmoidf_(z); const float f = lbv + omlb * sg; const float g = __logf(fmaxf(f, 1e-30f));
                kv[tt] = omlb * (1.f - sg); qv[tt] = qr * sigmoidf_(qr); gv[tt] = g; tot += g; }
            const float other = __shfl_xor(tot, 32); const float tot0 = h ? other : tot, tot1 = h ? tot : other;
            float e[16];
            if (h == 0) { float run = 0.f;
#pragma unroll
                for (int tt = 15; tt >= 0; --tt) { e[tt] = run; run -= gv[tt]; }
            } else { float run = 0.f;
#pragma unroll
                for (int tt = 0; tt < 16; ++tt) { run += gv[tt]; e[tt] = run; } }
            float kl[16];
#pragma unroll
            for (int tt = 0; tt < 16; ++tt) { const int t = 16 * h + tt; const float ex = __expf(e[tt]), exn = __expf(-e[tt]);
                QS[t * 136 + dmy] = f2bf(qv[tt] * ex); KS[t * 136 + dmy] = f2bf(kv[tt] * exn); QB[t * 136 + dmy] = f2bf(qv[tt] * __expf(e[tt] + tot0)); kl[tt] = kv[tt] * __expf(tot1 - e[tt]); }
            *(bf16x8*)(KLT + dmy * 40 + 16 * h) = pack8(kl[0], kl[1], kl[2], kl[3], kl[4], kl[5], kl[6], kl[7]);
            *(bf16x8*)(KLT + dmy * 40 + 16 * h + 8) = pack8(kl[8], kl[9], kl[10], kl[11], kl[12], kl[13], kl[14], kl[15]);
            if (h == 0) DEC[dmy] = __expf(tot0 + tot1);
            bf16x8 v0, v1;
#pragma unroll
            for (int tt = 0; tt < 8; ++tt) { v0[tt] = (short)RV[(16 * h + tt) * 136 + dmy]; v1[tt] = (short)RV[(16 * h + 8 + tt) * 136 + dmy]; }
            *(bf16x8*)(VT + dmy * 40 + 16 * h) = v0; *(bf16x8*)(VT + dmy * 40 + 16 * h + 8) = v1;
        }
        __syncthreads();
        f32x16 st;
#pragma unroll
        for (int ii = 0; ii < 16; ++ii) st[ii] = 0.f;
#pragma unroll
        for (int s = 0; s < 8; ++s) { const bf16x8 ak = *(const bf16x8*)(KS + c * 136 + 16 * s + 8 * h), bq = *(const bf16x8*)(QS + c * 136 + 16 * s + 8 * h); st = MFMA32(ak, bq, st); }
#pragma unroll
        for (int ii = 0; ii < 16; ++ii) if (crow(ii, h) > c) st[ii] = 0.f;
        f32x16 o;
#pragma unroll
        for (int ii = 0; ii < 16; ++ii) o[ii] = 0.f;
#pragma unroll
        for (int s2 = 0; s2 < 2; ++s2) {
            const bf16x8 pb = pack8(st[8 * s2], st[8 * s2 + 1], st[8 * s2 + 2], st[8 * s2 + 3], st[8 * s2 + 4], st[8 * s2 + 5], st[8 * s2 + 6], st[8 * s2 + 7]);
            const bf16_t* vp = VT + dmy * 40 + 16 * s2 + 4 * h;
            o = MFMA32(cat44(*(const s16x4*)vp, *(const s16x4*)(vp + 8)), pb, o);
        }
#pragma unroll
        for (int dt = 0; dt < 4; ++dt)
#pragma unroll
            for (int s2 = 0; s2 < 2; ++s2) {
                const bf16x8 xs = pack8(S[dt][8 * s2], S[dt][8 * s2 + 1], S[dt][8 * s2 + 2], S[dt][8 * s2 + 3], S[dt][8 * s2 + 4], S[dt][8 * s2 + 5], S[dt][8 * s2 + 6], S[dt][8 * s2 + 7]);
                const bf16_t* qb = QB + c * 136 + 32 * dt + 16 * s2 + 4 * h;
                o = MFMA32(xs, cat44(*(const s16x4*)qb, *(const s16x4*)(qb + 8)), o);
            }
        {   const int p = 32 * ch + c, pos = dir ? L - 1 - p : p;
            float* op = OF + ((size_t)dir * T + seqbase + pos) * 512 + 128 * hd + 32 * wd;
#pragma unroll
            for (int g4 = 0; g4 < 4; ++g4) { f32x4 v; v[0] = o[4 * g4]; v[1] = o[4 * g4 + 1]; v[2] = o[4 * g4 + 2]; v[3] = o[4 * g4 + 3]; *(f32x4*)(op + 8 * g4 + 4 * h) = v; } }
#pragma unroll
        for (int dt = 0; dt < 4; ++dt) {
#pragma unroll
            for (int g4 = 0; g4 < 4; ++g4) { const f32x4 dv4 = *(const f32x4*)(DEC + 32 * dt + 8 * g4 + 4 * h);
                S[dt][4 * g4] *= dv4[0]; S[dt][4 * g4 + 1] *= dv4[1]; S[dt][4 * g4 + 2] *= dv4[2]; S[dt][4 * g4 + 3] *= dv4[3]; }
#pragma unroll
            for (int s2 = 0; s2 < 2; ++s2) { const bf16x8 ak = *(const bf16x8*)(KLT + (32 * dt + c) * 40 + 16 * s2 + 8 * h), bv = *(const bf16x8*)(VT + dmy * 40 + 16 * s2 + 8 * h);
                S[dt] = MFMA32(ak, bv, S[dt]); }
        }
    }
#undef HG_GLOAD
    if (!lat) { float* sp = a.out + O_NST + ((((size_t)(b * DEPTH + l) * 2 + dir) * 4 + hd) * 128) * 128;
#pragma unroll
        for (int dt = 0; dt < 4; ++dt)
#pragma unroll
            for (int ii = 0; ii < 16; ++ii) sp[(size_t)(32 * dt + crow(ii, h)) * 128 + 32 * wd + c] = S[dt][ii];
    }
}

DI void phase_mixer(const Args& a, unsigned char* lds, int l, int rep) {
    unsigned* ctl = (unsigned*)(a.ws + WS_CTL) + 16 * l + 8 * rep;
    volatile int* slot = (volatile int*)(lds + LDS_MISC);
    const int tid = otid(), lane = tid & 63, w = tid >> 6, c = lane & 31;
    bf16_t* PROJ = (bf16_t*)(a.ws + WS_PROJ);
    for (;;) {
        __syncthreads();
        if (tid == 0) *slot = (int)__hip_atomic_fetch_add(ctl, 1u, __ATOMIC_RELAXED, __HIP_MEMORY_SCOPE_AGENT);
        __syncthreads();
        const int it = *slot;
        if (it >= 1696) break;
#ifndef NO_HG
        if (it < 32) { hgrn_item(a, lds, l, it >> 2, it & 3); continue; }
        if (it >= 544 && it < 672) { const int idx = it - 544; hgrn_item(a, lds, l, 8 + (idx >> 2), idx & 3); continue; }
#endif
        int idx, kind;
        if (it < 544) { idx = it - 32; kind = 0; } else if (it < 1184) { idx = it - 672; kind = 1; } else if (it < 1440) { idx = it - 1184; kind = 2; } else { idx = it - 1440; kind = 3; }
        const bool lat = kind < 2, isw = kind & 1;
        int b, g, qb;
        if (lat) { b = idx >> 6; g = (idx >> 5) & 1; qb = idx & 31; } else { b = idx >> 3; g = (idx >> 2) & 1; qb = idx & 3; }
        const int r = w & 3, tq = 64 * qb + 32 * (w >> 2) + c;
        const int row = (lat ? TC + b * 2048 : b * 256) + tq;
        const bf16_t* qp = PROJ + (size_t)row * INW + (isw ? C_WQ : C_AQ) + (4 * g + r) * 64;
        bf16_t* op = (bf16_t*)(a.ws + (isw ? WS_OWIN : WS_OATT)) + (size_t)row * 512 + (4 * g + r) * 64;
        const bf16_t* Kb; const bf16_t* VTb; int nk;
        if (lat) { nk = 2304; Kb = (const bf16_t*)(a.ws + (isw ? WS_KWL : WS_KAL)) + (size_t)(b * 2 + g) * 2304 * 64; VTb = (const bf16_t*)(a.ws + (isw ? WS_VWL : WS_VAL)) + (size_t)(b * 2 + g) * 64 * 2304; }
        else { nk = 256; Kb = (const bf16_t*)(a.ws + (isw ? WS_KWC : WS_KAC)) + (size_t)(b * 2 + g) * 256 * 64; VTb = (const bf16_t*)(a.ws + (isw ? WS_VWC : WS_VAC)) + (size_t)(b * 2 + g) * 64 * 256; }
        int nA = 4, lo = 0, hi = 0; bool win = false;
        if (kind == 0) nA = 36;
        if (kind == 1) { lo = qb - 2 < 0 ? 0 : qb - 2; hi = qb + 3 > 32 ? 32 : qb + 3; win = true; }
        const float sink2 = isw ? a.in[18][l * 8 + 4 * g + r] * LOG2E : 0.f;
#ifndef NO_ATT
        attn_item(lds, qp, op, Kb, VTb, nk, nA, lo, hi, win, tq, isw, sink2);
#endif
    }
}

DI void phase_hgcomb(const Args& a, int l) {
    const int tid = otid(), lane = tid & 63, w = tid >> 6;
    const int gw = obid() * 8 + w, NGW = gridDim.x * 8;
    const float* OF = (const float*)(a.ws + WS_OF); const bf16_t* PROJ = (const bf16_t*)(a.ws + WS_PROJ); bf16_t* OHG = (bf16_t*)(a.ws + WS_OHG);
    const f32x2 gn = *(const f32x2*)(a.in[17] + l * 128 + 2 * lane);
    for (int it = gw; it < T * 4; it += NGW) {
        const int row = it >> 2, hd = it & 3;
        const f32x2 x0 = *(const f32x2*)(OF + (size_t)row * 512 + 128 * hd + 2 * lane), x1 = *(const f32x2*)(OF + ((size_t)T + row) * 512 + 128 * hd + 2 * lane);
        const float s0 = x0[0] + x1[0], s1 = x0[1] + x1[1];
        const float rstd = rsqrtf(wave_sum(s0 * s0 + s1 * s1) * (1.f / 128.f) + EPS);
        const unsigned gb = *(const unsigned*)(PROJ + (size_t)row * INW + C_HG + 128 * hd + 2 * lane);
        const float g0 = bflo(gb), g1 = bfhi(gb);
        *(unsigned*)(OHG + (size_t)row * 512 + 128 * hd + 2 * lane) = pk2(s0 * rstd * gn[0] * g0 * sigmoidf_(g0), s1 * rstd * gn[1] * g1 * sigmoidf_(g1));
    }
}

template <class Epi> DI void run_gemm(unsigned char* lds, const bf16_t* A, const bf16_t* Bt, int N, int K, const Epi& E) {
    pg8::Gemm g{A, Bt, T, N, K}; pg8::StaticOrder S; S.init(T, N, (int)gridDim.x, obid());
    pg8::gemm_phase<Epi, pg8::StaticOrder, false>((PG8_LAS unsigned char*)lds, g, S, E, nullptr);
}

__global__ void __launch_bounds__(512, 2) mk_fwd(Args a) {
    extern __shared__ __attribute__((aligned(16))) unsigned char lds[];
    cg::grid_group grid = cg::this_grid();
    {   volatile LAS unsigned* st = (volatile LAS unsigned*)((LAS unsigned char*)lds + LDS_MISC + 16);
        if (threadIdx.x < 2) st[threadIdx.x] = 0u;
        __syncthreads(); }
    const XcdBarrier bar = xcd_barrier_post((unsigned*)(a.ws + WS_BAR), (volatile LAS unsigned*)((LAS unsigned char*)lds + LDS_MISC + 16));
    bf16_t* HB = (bf16_t*)(a.ws + WS_HB); bf16_t* PROJ = (bf16_t*)(a.ws + WS_PROJ); bf16_t* ACT = PROJ;
    float* M32 = (float*)(a.ws + WS_OF);
    for (int ph = a.ph_lo; ph < a.ph_hi; ++ph) {
        if (ph > a.ph_lo) { if (ph == a.ph_lo + 1) grid.sync(); else xcd_barrier(bar);
#if PROBE_MASK & 8
            xcd_barrier(bar); xcd_barrier(bar);
#endif
        }
#ifndef NO_P0
        if (ph == 0) { phase_p0(a, lds); continue; }
#endif
#ifndef NO_C0
        if (ph == NPH - 1) { phase_final(a); continue; }
#endif
        const int l = (ph - 1) / 13, k = (ph - 1) % 13;
        int reps = 1;
        if ((PROBE_MASK & 1) && (k == 0 || k == 3 || k == 10 || k == 7)) reps = 2;
        if ((PROBE_MASK & 2) && (k == 1 || k == 11 || k == 4 || k == 8)) reps = 2;
        if ((PROBE_MASK & 4) && k == 6) reps = 2;
        for (int rep = 0; rep < reps; ++rep) {
        if (rep) xcd_barrier(bar);
        const float* MODL = (const float*)(a.ws + WS_MOD) + (size_t)l * 9 * NMODW;
        const float* xa = a.out; const float* xb = a.out + (size_t)TC * DM;
        const bf16_t* WFI = (const bf16_t*)(a.ws + WS_WFI); const bf16_t* WFO = (const bf16_t*)(a.ws + WS_WFO);
        if (k == 100) {}
#ifndef NO_C0
        else if (k == 0) { phase_wconv(a, lds, l); phase_norm(a, l, 0, l == 0); }
        else if (k == 3 || k == 10) { phase_norm(a, l, k == 3 ? 1 : 2, false); }
#endif
#ifndef NO_G_SW
        else if (k == 1 || k == 11) { run_gemm(lds, HB, k == 1 ? WFI : WFI + (size_t)5632 * 1024, 2 * DFF, DM, pg8::EpiSwiglu{ACT}); }
#endif
#ifndef NO_G_RES
        else if (k == 2 || k == 9 || k == 12) {
            if (k == 2 && l == 0) { xa = a.in[0]; xb = a.in[1]; }
            const bf16_t* A = k == 9 ? HB : ACT; const bf16_t* Bt = k == 9 ? (const bf16_t*)(a.ws + WS_WOUT) : (k == 2 ? WFO : WFO + (size_t)1024 * DFF);
            const int K = k == 9 ? DM : DFF; const int gi = k == 2 ? 2 : (k == 9 ? 5 : 8);
            run_gemm(lds, A, Bt, DM, K, pg8::EpiResid{xa, xb, a.out, MODL + gi * DM, k == 9 ? 1.0f : 0.5f});
        }
#endif
#ifndef NO_G_BF
        else if (k == 4) { run_gemm(lds, HB, (const bf16_t*)(a.ws + WS_WIN), INW, DM, pg8::EpiBf16P{PROJ, INW}); }
#endif
#ifndef NO_PREP
        else if (k == 5) { phase_prep(a, l); }
#endif
#ifndef NO_MIX
        else if (k == 6) { phase_mixer(a, lds, l, rep); }
#endif
#ifndef NO_C0
        else if (k == 7) { phase_hgcomb(a, l); }
#endif
#ifndef NO_G_BR
        else if (k == 8) {
            const bf16_t* WBR = (const bf16_t*)(a.ws + WS_WBR);
            for (int kk = 0; kk < 3; ++kk) {
                const bf16_t* A = (const bf16_t*)(a.ws + (kk == 0 ? WS_OATT : (kk == 1 ? WS_OHG : WS_OWIN)));
                run_gemm(lds, A, WBR + (size_t)kk * 1024 * 512, DM, 512, pg8::EpiBranch{PROJ + C_GA + 1024 * kk, M32, HB, kk});
            }
        }
#endif
        }
    }
}

#ifndef MK_PER_PHASE
#define MK_PER_PHASE 0
#endif
extern "C" void kernel_launch(void* const* d_in, const int* in_sizes, int n_in, void* d_out, int out_size, void* d_ws, size_t ws_size, hipStream_t stream) {
    static int grid = 0;
    if (!grid) {
        if (n_in != 22 || ws_size < WS_END) { fprintf(stderr, "kernel_launch: unexpected n_in %d or ws_size %zu < %zu\n", n_in, ws_size, (size_t)WS_END); grid = -1; return; }
        int dev = 0, cus = 0, per_cu = 0;
        (void)hipGetDevice(&dev); (void)hipDeviceGetAttribute(&cus, hipDeviceAttributeMultiprocessorCount, dev);
        if (hipFuncSetAttribute((const void*)mk_fwd, hipFuncAttributeMaxDynamicSharedMemorySize, LDS_BYTES) != hipSuccess) { fprintf(stderr, "kernel_launch: hipFuncSetAttribute failed\n"); grid = -1; return; }
        (void)hipOccupancyMaxActiveBlocksPerMultiprocessor(&per_cu, mk_fwd, 512, LDS_BYTES);
        if (per_cu < 1) per_cu = 1;
        grid = cus * per_cu; if (grid > 256) grid = 256;
    }
    if (grid < 0) return;
    (void)hipMemsetAsync((char*)d_ws + WS_CTL, 0, CTL_BYTES, stream);
    Args a{};
    for (int i = 0; i < 22; ++i) a.in[i] = (const float*)d_in[i];
    a.out = (float*)d_out; a.ws = (unsigned char*)d_ws;
#if MK_PER_PHASE
    for (int ph = 0; ph < NPH; ++ph) { a.ph_lo = ph; a.ph_hi = ph + 1; hipLaunchKernelGGL(mk_fwd, dim3(grid), dim3(512), LDS_BYTES, stream, a); }
#else
    a.ph_lo = 0; a.ph_hi = NPH;
    void* args[] = {&a};
    hipError_t e = hipLaunchCooperativeKernel((void*)mk_fwd, dim3(grid), dim3(512), args, LDS_BYTES, stream);
    if (e != hipSuccess) fprintf(stderr, "cooperative launch failed: %s (grid %d)\n", hipGetErrorString(e), grid);
#endif
}
```

```cpp
#include <hip/hip_runtime.h>
#include <hip/hip_cooperative_groups.h>
#include <cstdio>
#include <cstdint>
namespace cg = cooperative_groups;

#ifndef PROBE_MASK
#define PROBE_MASK 0
#endif
#ifndef STAGGER
#define STAGGER 0
#endif
#define DI __device__ __forceinline__
typedef unsigned short bf16_t;
typedef short bf16x8 __attribute__((ext_vector_type(8)));
typedef short s16x4 __attribute__((ext_vector_type(4)));
typedef float f32x2 __attribute__((ext_vector_type(2)));
typedef float f32x4 __attribute__((ext_vector_type(4)));
typedef float f32x16 __attribute__((ext_vector_type(16)));
typedef unsigned u32x2 __attribute__((ext_vector_type(2)));
typedef unsigned u32x4 __attribute__((ext_vector_type(4)));
typedef __bf16 bf16x2n __attribute__((ext_vector_type(2)));

DI int otid() { int t = threadIdx.x; asm volatile("" : "+v"(t)); return t; }
DI int obid() { int b = blockIdx.x; asm volatile("" : "+s"(b)); return b; }
DI unsigned pk2(float lo, float hi) { f32x2 v = {lo, hi}; return __builtin_bit_cast(unsigned, __builtin_convertvector(v, bf16x2n)); }
DI float bflo(unsigned u) { return __uint_as_float(u << 16); }
DI float bfhi(unsigned u) { return __uint_as_float(u & 0xffff0000u); }
DI float bf2f(bf16_t b) { return __uint_as_float(((unsigned)b) << 16); }
DI bf16_t f2bf(float f) { return (bf16_t)(pk2(f, 0.f) & 0xffffu); }
DI float sigmoidf_(float x) { return __builtin_amdgcn_rcpf(1.f + __expf(-x)); }
DI float wave_sum(float v) {
#pragma unroll
    for (int o = 1; o < 64; o <<= 1) v += __shfl_xor(v, o);
    return v;
}
#define MFMA32(a, b, c) __builtin_amdgcn_mfma_f32_32x32x16_bf16((a), (b), (c), 0, 0, 0)
DI bf16x8 pack8(float a0, float a1, float a2, float a3, float a4, float a5, float a6, float a7) {
    u32x4 p; p.x = pk2(a0, a1); p.y = pk2(a2, a3); p.z = pk2(a4, a5); p.w = pk2(a6, a7); return __builtin_bit_cast(bf16x8, p);
}
DI bf16x8 cat44(s16x4 lo, s16x4 hi) { return __builtin_shufflevector(lo, hi, 0, 1, 2, 3, 4, 5, 6, 7); }

constexpr int DM = 1024, DEPTH = 4, TC = 8192, TL = 16384, T = 24576, DFF = 2816, INW = 7168, NMODW = 9216;
constexpr int C_AQ = 0, C_AK = 512, C_AV = 640, C_WQ = 768, C_WK = 1280, C_WV = 1408, C_HQ = 1536, C_HFF = 2048, C_HFB = 2560, C_HI = 3072, C_HG = 3584, C_GA = 4096;
constexpr float EPS = 1e-6f, LOG2E = 1.4426950408889634f;
constexpr size_t O_X = 0, O_NKA = 25165824, O_NVA = 29360128, O_NKW = 33554432, O_NVW = 37748736, O_NST = 41943040;
constexpr size_t al256(size_t x) { return (x + 255) & ~(size_t)255; }
constexpr size_t WS_CTL = 0;
constexpr size_t WS_BAR = 4096;
constexpr size_t CTL_BYTES = 32768;
constexpr size_t WS_MOD = CTL_BYTES;
constexpr size_t WS_LB = WS_MOD + al256((size_t)DEPTH * 9 * NMODW * 4);
constexpr size_t WS_ROPE = WS_LB + 16384;
constexpr size_t WS_WFI = WS_ROPE + 8192;
constexpr size_t WS_WFO = WS_WFI + (size_t)2 * 5632 * 1024 * 2;
constexpr size_t WS_WIN = WS_WFO + (size_t)2 * 1024 * 2816 * 2;
constexpr size_t WS_WBR = WS_WIN + (size_t)7168 * 1024 * 2;
constexpr size_t WS_WOUT = WS_WBR + (size_t)3 * 1024 * 512 * 2;
constexpr size_t WS_HB = WS_WOUT + (size_t)1024 * 1024 * 2;
constexpr size_t WS_PROJ = WS_HB + (size_t)T * 1024 * 2;
constexpr size_t WS_OATT = WS_PROJ + (size_t)T * INW * 2;
constexpr size_t WS_OHG = WS_OATT + (size_t)T * 512 * 2;
constexpr size_t WS_OWIN = WS_OHG + (size_t)T * 512 * 2;
constexpr size_t WS_OF = WS_OWIN + (size_t)T * 512 * 2;
constexpr size_t WS_KAL = WS_OF + (size_t)2 * T * 512 * 4;
constexpr size_t SZ_KL = (size_t)8 * 2 * 2304 * 64 * 2, SZ_KC = (size_t)32 * 2 * 256 * 64 * 2;
constexpr size_t WS_VAL = WS_KAL + SZ_KL;
constexpr size_t WS_KWL = WS_VAL + SZ_KL;
constexpr size_t WS_VWL = WS_KWL + SZ_KL;
constexpr size_t WS_KAC = WS_VWL + SZ_KL;
constexpr size_t WS_VAC = WS_KAC + SZ_KC;
constexpr size_t WS_KWC = WS_VAC + SZ_KC;
constexpr size_t WS_VWC = WS_KWC + SZ_KC;
constexpr size_t WS_END = WS_VWC + SZ_KC;
constexpr int LDS_BYTES = 160 * 1024, LDS_MISC = 159 * 1024;
constexpr int NPH = 1 + 13 * DEPTH + 1;

struct Args { const float* in[22]; float* out; unsigned char* ws; int ph_lo, ph_hi; };

namespace pg8 {
#define PG8_LAS __attribute__((address_space(3)))
typedef unsigned short bf16_t;
typedef short bf16x8 __attribute__((ext_vector_type(8)));
typedef float f32x4 __attribute__((ext_vector_type(4)));
typedef unsigned u32x4 __attribute__((ext_vector_type(4)));
constexpr int BM = 256, BK = 64, HALF = 128, HTB = HALF * BK * 2  , STAGE_BYTES = 8 * HTB, NXCD = 8, WGM = 8;

__host__ __device__ __forceinline__ int lds_byte(int r, int c) { const int st = (r >> 4) * 2 + (c >> 5), rr = r & 15, cc = c & 31, ob = rr * 64 + cc * 2; return st * 1024 + (ob ^ (((ob >> 9) & 1) << 5)); }
__host__ __device__ __forceinline__ void stage_rc(int b, int& R, int& C) { const int st = b / 1024, sb = b % 1024, swz = sb ^ (((sb >> 9) & 1) << 5); R = (st >> 1) * 16 + swz / 64; C = (st & 1) * 32 + (swz % 64) / 2; }
__host__ __device__ __forceinline__ int perm32(int rho) { const int n = rho >> 4, i = rho & 15; return 8 * (i >> 2) + 4 * n + (i & 3); }

struct Unit { int pm, pn; };
struct Gemm { const bf16_t* A; const bf16_t* Bt; int M, N, K; };

struct StaticOrder {
    int nM, nN, nwg, G, c;
    __host__ __device__ void init(int M, int N, int G_, int c_) { nM = M / BM; nN = N / BM; nwg = nM * nN; G = G_; c = c_; }
    __host__ __device__ bool next(int i, Unit& u) const {
        const long L = (long)i * G + c; if (L >= nwg) return false;
        int wgid = (int)L; { const int q = nwg / NXCD, r = nwg % NXCD, xcd = wgid % NXCD, off = wgid / NXCD; wgid = (xcd < r ? xcd * (q + 1) : r * (q + 1) + (xcd - r) * q) + off; }
        const int nig = WGM * nN, gid = wgid / nig, fm = gid * WGM, gsz = (nM - fm) < WGM ? (nM - fm) : WGM;
        u.pm = fm + ((wgid % nig) % gsz); u.pn = (wgid % nig) / gsz; return true;
    }
    __device__ __forceinline__ void a_ready(const Unit&) const {}
    __device__ __forceinline__ void done(const Unit&) const {}
};
struct EpiBf16P {
    static constexpr bool PERM = true, AFTER_DRAIN = false;
    bf16_t* O; int ldc;
    __device__ __forceinline__ void operator()(const f32x4 (&acc)[2][2][4][2], const Unit& u, int wr, int wc, int fr, int fq) const {
        const int row0 = u.pm * BM + wr * 64 + fr, col0 = u.pn * BM + wc * 32 + 8 * fq;
#pragma unroll
        for (int ai = 0; ai < 2; ++ai)
#pragma unroll
            for (int m = 0; m < 4; ++m) { bf16_t* rowp = O + (size_t)(row0 + ai * HALF + m * 16) * ldc + col0;
#pragma unroll
                for (int bj = 0; bj < 2; ++bj) { const f32x4 v0 = acc[ai][bj][m][0], v1 = acc[ai][bj][m][1];
                    u32x4 w; w.x = pk2(v0[0], v0[1]); w.y = pk2(v0[2], v0[3]); w.z = pk2(v1[0], v1[1]); w.w = pk2(v1[2], v1[3]);
                    *(u32x4*)(rowp + bj * HALF) = w; } }
    }
};
struct EpiSwiglu {
    static constexpr bool PERM = true, AFTER_DRAIN = false;
    bf16_t* O;
    __device__ __forceinline__ void operator()(const f32x4 (&acc)[2][2][4][2], const Unit& u, int wr, int wc, int fr, int fq) const {
        const int row0 = u.pm * BM + wr * 64 + fr, col0 = u.pn * HALF + wc * 32 + 8 * fq;
#pragma unroll
        for (int ai = 0; ai < 2; ++ai)
#pragma unroll
            for (int m = 0; m < 4; ++m) { bf16_t* rowp = O + (size_t)(row0 + ai * HALF + m * 16) * DFF + col0;
                float r[8];
#pragma unroll
                for (int n = 0; n < 2; ++n)
#pragma unroll
                    for (int j = 0; j < 4; ++j) { const float g = acc[ai][0][m][n][j], up = acc[ai][1][m][n][j]; r[4 * n + j] = g * __builtin_amdgcn_rcpf(1.f + __expf(-g)) * up; }
                u32x4 w; w.x = pk2(r[0], r[1]); w.y = pk2(r[2], r[3]); w.z = pk2(r[4], r[5]); w.w = pk2(r[6], r[7]);
                *(u32x4*)rowp = w; }
    }
};
struct EpiResid {
    static constexpr bool PERM = false, AFTER_DRAIN = false;
    const float* xa; const float* xb; float* out; const float* mod; float coef;
    __device__ __forceinline__ void operator()(const f32x4 (&acc)[2][2][4][2], const Unit& u, int wr, int wc, int fr, int fq) const {
        const int row0 = u.pm * BM + wr * 64 + fr, col0 = u.pn * BM + wc * 32 + 4 * fq;
#pragma unroll
        for (int ai = 0; ai < 2; ++ai)
#pragma unroll
            for (int m = 0; m < 4; ++m) { const int row = row0 + ai * HALF + m * 16; const int cond = row < TC ? 8 : ((row - TC) >> 11);
                const float* bp = row < TC ? xa + (size_t)row * DM : xb + (size_t)(row - TC) * DM; const float* mp = mod + (size_t)cond * NMODW; float* op = out + (size_t)row * DM;
#pragma unroll
                for (int bj = 0; bj < 2; ++bj)
#pragma unroll
                    for (int n = 0; n < 2; ++n) { const int c = col0 + bj * HALF + n * 16; const f32x4 b = *(const f32x4*)(bp + c), g = *(const f32x4*)(mp + c);
                        *(f32x4*)(op + c) = b + coef * g * acc[ai][bj][m][n]; } }
    }
};
struct EpiBranch {
    static constexpr bool PERM = false, AFTER_DRAIN = false;
    const bf16_t* gate; float* acc32; bf16_t* outbf; int mode;
    __device__ __forceinline__ void operator()(const f32x4 (&acc)[2][2][4][2], const Unit& u, int wr, int wc, int fr, int fq) const {
        const int row0 = u.pm * BM + wr * 64 + fr, col0 = u.pn * BM + wc * 32 + 4 * fq;
#pragma unroll
        for (int ai = 0; ai < 2; ++ai)
#pragma unroll
            for (int m = 0; m < 4; ++m) { const int row = row0 + ai * HALF + m * 16;
#pragma unroll
                for (int bj = 0; bj < 2; ++bj)
#pragma unroll
                    for (int n = 0; n < 2; ++n) { const int c = col0 + bj * HALF + n * 16;
                        const u32x2 gv = *(const u32x2*)(gate + (size_t)row * INW + c);
                        f32x4 g; g[0] = sigmoidf_(bflo(gv.x)); g[1] = sigmoidf_(bfhi(gv.x)); g[2] = sigmoidf_(bflo(gv.y)); g[3] = sigmoidf_(bfhi(gv.y));
                        f32x4 v = g * acc[ai][bj][m][n];
                        bf16_t* hp = outbf + (size_t)row * DM + c;
                        if (mode != 0) { const u32x2 pv = *(const u32x2*)hp; v[0] += bflo(pv.x); v[1] += bfhi(pv.x); v[2] += bflo(pv.y); v[3] += bfhi(pv.y); }
                        u32x2 w; w.x = pk2(v[0], v[1]); w.y = pk2(v[2], v[3]); *(u32x2*)hp = w; } }
    }
};

template <class Epi, class Sched, bool STAMP = false>
__device__ __forceinline__ void gemm_phase(PG8_LAS unsigned char* lds, const Gemm g, const Sched& S, const Epi& E, unsigned long long* stamps) {
    const int tid = otid(), wid = __builtin_amdgcn_readfirstlane(tid >> 6), lane = tid & 63, wr = wid >> 2, wc = wid & 3, fr = lane & 15, fq = lane >> 4;
    const int K = g.K, nt = K / BK;
    int ts_lo = 0, ts_hi = 0, nts = 0; const unsigned long long rt_entry = STAMP ? (unsigned long long)wall_clock64() : 0ull;
#define PG8_STAMP() do { if (STAMP && wid == 0 && nts < 64) { const unsigned long long _c = (unsigned long long)clock64(); \
        ts_lo = (lane == nts) ? (int)(unsigned)_c : ts_lo; ts_hi = (lane == nts) ? (int)(unsigned)(_c >> 32) : ts_hi; ++nts; } } while (0)
    PG8_STAMP();
    unsigned voffA[2], voffB[2];
#pragma unroll
    for (int i = 0; i < 2; ++i) { int R, C; stage_rc(tid * 16 + i * 8192, R, C); const int Rb = Epi::PERM ? ((R & ~31) + perm32(R & 31)) : R;
        voffA[i] = (unsigned)(R * K + C) * 2u; voffB[i] = (unsigned)(Rb * K + C) * 2u; }
    const size_t kstep = (size_t)(BK * 2);
    const size_t hstep = (size_t)HALF * K * 2;
    const size_t tstep = 2 * hstep;
    const unsigned ldsw = (unsigned)wid * 1024u;
    const int aoff = lds_byte(wr * 64 + fr, fq * 8), boff = lds_byte(wc * 32 + fr, fq * 8);
#define PG8_SA(b, h) (((b) * 2 + (h)) * HTB)
#define PG8_SB(b, h) ((4 + (b) * 2 + (h)) * HTB)
#define PG8_STAGE(bufoff, gbase, voff) do { _Pragma("unroll") for (int _i = 0; _i < 2; ++_i) \
        __builtin_amdgcn_global_load_lds((const unsigned*)((const char*)(gbase) + (voff)[_i]), (PG8_LAS unsigned*)(lds + (bufoff) + ldsw + _i * 8192), 16, 0, 0); } while (0)
#define PG8_LDA(dst, b, h) do { _Pragma("unroll") for (int m = 0; m < 4; ++m) _Pragma("unroll") for (int k = 0; k < 2; ++k) dst[m][k] = *(const PG8_LAS bf16x8*)(lds + PG8_SA(b, h) + aoff + m * 2048 + k * 1024); } while (0)
#define PG8_LDB(dst, b, h) do { _Pragma("unroll") for (int n = 0; n < 2; ++n) _Pragma("unroll") for (int k = 0; k < 2; ++k) dst[n][k] = *(const PG8_LAS bf16x8*)(lds + PG8_SB(b, h) + boff + n * 2048 + k * 1024); } while (0)
#define PG8_MMA(ai, bj, At, Bt) do { __builtin_amdgcn_s_setprio(1); _Pragma("unroll") for (int m = 0; m < 4; ++m) _Pragma("unroll") for (int n = 0; n < 2; ++n) _Pragma("unroll") for (int k = 0; k < 2; ++k) \
        acc[ai][bj][m][n] = __builtin_amdgcn_mfma_f32_16x16x32_bf16(Bt[n][k], At[m][k], acc[ai][bj][m][n], 0, 0, 0); __builtin_amdgcn_s_setprio(0); } while (0)
#define PG8_WAIT_V(n) asm volatile("s_waitcnt vmcnt(" #n ")" ::: "memory")
#define PG8_WAIT_L(n) asm volatile("s_waitcnt lgkmcnt(" #n ")" ::: "memory")
#define PG8_BAR __builtin_amdgcn_s_barrier()
#define PG8_SCHED __builtin_amdgcn_sched_barrier(0)
    Unit cur, nxt; int ui = 0;
    if (!S.next(0, cur)) return;
    f32x4 acc[2][2][4][2];
#pragma unroll
    for (int a = 0; a < 2; ++a)
#pragma unroll
        for (int b = 0; b < 2; ++b)
#pragma unroll
            for (int m = 0; m < 4; ++m)
#pragma unroll
                for (int n = 0; n < 2; ++n) acc[a][b][m][n] = (f32x4){0.f, 0.f, 0.f, 0.f};
    bf16x8 At[4][2], B0[2][2], B1[2][2];
    const char* cA = (const char*)g.A + (size_t)cur.pm * tstep; const char* cB = (const char*)g.Bt + (size_t)cur.pn * tstep;
    S.a_ready(cur);
    PG8_STAGE(PG8_SB(0, 0), cB, voffB); PG8_STAGE(PG8_SA(0, 0), cA, voffA); PG8_STAGE(PG8_SB(0, 1), cB + hstep, voffB); PG8_STAGE(PG8_SA(0, 1), cA + hstep, voffA);
    if (wr == 1) PG8_BAR;
    PG8_WAIT_V(4); PG8_BAR;
    PG8_STAGE(PG8_SB(1, 0), cB + kstep, voffB); PG8_STAGE(PG8_SA(1, 0), cA + kstep, voffA); PG8_STAGE(PG8_SB(1, 1), cB + hstep + kstep, voffB);
    PG8_WAIT_V(6); PG8_BAR;
    PG8_STAMP();
    for (;;) {
        const bool has_next = S.next(ui + 1, nxt);
        const char* nA = has_next ? (const char*)g.A + (size_t)nxt.pm * tstep : cA; const char* nB = has_next ? (const char*)g.Bt + (size_t)nxt.pn * tstep : cB;
        for (int t = 0; t < nt; t += 2) {
            const bool last = (t == nt - 2);
            const char* a1 = cA + (size_t)(t + 1) * kstep;
            const char* a2 = last ? nA : cA + (size_t)(t + 2) * kstep; const char* b2 = last ? nB : cB + (size_t)(t + 2) * kstep;
            const char* a3 = a2 + kstep; const char* b3 = b2 + kstep;
            if (last && has_next) S.a_ready(nxt);
            PG8_LDB(B0, 0, 0); PG8_SCHED; PG8_LDA(At, 0, 0); PG8_STAGE(PG8_SA(1, 1), a1 + hstep, voffA);
            PG8_WAIT_L(8); PG8_BAR; PG8_WAIT_L(0); PG8_MMA(0, 0, At, B0); PG8_BAR; PG8_SCHED;
            PG8_LDB(B1, 0, 1); PG8_STAGE(PG8_SB(0, 0), b2, voffB);
            PG8_BAR; PG8_WAIT_L(0); PG8_MMA(0, 1, At, B1); PG8_BAR;
            PG8_LDA(At, 0, 1); PG8_STAGE(PG8_SA(0, 0), a2, voffA);
            PG8_BAR; PG8_WAIT_L(0); PG8_MMA(1, 0, At, B0); PG8_BAR; PG8_SCHED;
            PG8_STAGE(PG8_SB(0, 1), b2 + hstep, voffB);
            PG8_WAIT_V(6); PG8_BAR; PG8_MMA(1, 1, At, B1); PG8_BAR;
            PG8_LDB(B0, 1, 0); PG8_SCHED; PG8_LDA(At, 1, 0); PG8_STAGE(PG8_SA(0, 1), a2 + hstep, voffA);
            PG8_WAIT_L(8); PG8_BAR; PG8_WAIT_L(0); PG8_MMA(0, 0, At, B0); PG8_BAR; PG8_SCHED;
            PG8_LDB(B1, 1, 1); PG8_STAGE(PG8_SB(1, 0), b3, voffB);
            PG8_BAR; PG8_WAIT_L(0); PG8_MMA(0, 1, At, B1); PG8_BAR;
            PG8_LDA(At, 1, 1); PG8_STAGE(PG8_SA(1, 0), a3, voffA);
            PG8_BAR; PG8_WAIT_L(0); PG8_MMA(1, 0, At, B0); PG8_BAR; PG8_SCHED;
            PG8_STAGE(PG8_SB(1, 1), b3 + hstep, voffB);
            PG8_WAIT_V(6); PG8_BAR; PG8_MMA(1, 1, At, B1); PG8_BAR;
        }
        PG8_STAMP();
        if constexpr (!Epi::AFTER_DRAIN) { E(acc, cur, wr, wc, fr, fq); S.done(cur); }
        PG8_STAMP();
        if (!has_next) break;
#pragma unroll
        for (int a = 0; a < 2; ++a)
#pragma unroll
            for (int b = 0; b < 2; ++b)
#pragma unroll
                for (int m = 0; m < 4; ++m)
#pragma unroll
                    for (int n = 0; n < 2; ++n) acc[a][b][m][n] = (f32x4){0.f, 0.f, 0.f, 0.f};
        cur = nxt; cA = nA; cB = nB; ++ui;
    }
    PG8_WAIT_V(0);
    if (wr == 0) PG8_BAR;
    PG8_BAR;
    if constexpr (Epi::AFTER_DRAIN) { E.fused(acc, cur, wr, wc, fr, fq, lds, wid, lane); S.done(cur); }
    PG8_STAMP();
    if (STAMP && wid == 0) { stamps[lane] = lane < nts ? (((unsigned long long)(unsigned)ts_hi << 32) | (unsigned)ts_lo) : 0ull;
        if (lane == 62) stamps[62] = rt_entry; if (lane == 63) stamps[63] = (unsigned long long)wall_clock64(); }
#undef PG8_STAMP
#undef PG8_SA
#undef PG8_SB
#undef PG8_STAGE
#undef PG8_LDA
#undef PG8_LDB
#undef PG8_MMA
#undef PG8_WAIT_V
#undef PG8_WAIT_L
#undef PG8_BAR
#undef PG8_SCHED
}
}
DI int crow(int i, int h) { return (i & 3) + 8 * (i >> 2) + 4 * h; }
#define LDS_WAIT() asm volatile("s_waitcnt lgkmcnt(0)" ::: "memory")


DI void phase_p0(const Args& a, unsigned char* lds) {
    float* s = (float*)lds; float* red = (float*)(lds + 36864);
    const int tid = otid(), lane = tid & 63, w = tid >> 6;
    float* MOD = (float*)(a.ws + WS_MOD);
    if ((int)blockIdx.x < 144) {
        const float* c = a.in[7]; const float* cctx = a.in[8];
        for (int i = tid; i < 9 * 1024; i += 512) { const int ci = i >> 10, k = i & 1023; const float v = ci < 8 ? c[ci * 1024 + k] : cctx[k]; s[i] = v * sigmoidf_(v); }
        __syncthreads();
        for (int item = blockIdx.x; item < 144; item += gridDim.x) {
            const int l = item / 36, cc = item % 36;
            const float* W = a.in[9] + (size_t)l * 1024 * NMODW + cc * 256 + 4 * lane;
            f32x4 acc[9];
#pragma unroll
            for (int ci = 0; ci < 9; ++ci) acc[ci] = (f32x4){0.f, 0.f, 0.f, 0.f};
#pragma unroll 2
            for (int k4 = 0; k4 < 32; ++k4) {
                const int k = w * 128 + k4 * 4;
                const f32x4 w0 = *(const f32x4*)(W + (size_t)(k + 0) * NMODW), w1 = *(const f32x4*)(W + (size_t)(k + 1) * NMODW),
                            w2 = *(const f32x4*)(W + (size_t)(k + 2) * NMODW), w3 = *(const f32x4*)(W + (size_t)(k + 3) * NMODW);
#pragma unroll
                for (int ci = 0; ci < 9; ++ci) { const f32x4 sv = *(const f32x4*)(s + ci * 1024 + k); acc[ci] += sv[0] * w0 + sv[1] * w1 + sv[2] * w2 + sv[3] * w3; }
            }
#pragma unroll
            for (int ci = 0; ci < 9; ++ci) *(f32x4*)(red + ((w * 9 + ci) * 256 + 4 * lane)) = acc[ci];
            __syncthreads();
            for (int i = tid; i < 9 * 256; i += 512) { const int ci = i >> 8, col = i & 255; float v = 0.f;
#pragma unroll
                for (int ww = 0; ww < 8; ++ww) v += red[(ww * 9 + ci) * 256 + col];
                v += a.in[10][l * NMODW + cc * 256 + col];
                MOD[((size_t)l * 9 + ci) * NMODW + cc * 256 + col] = v; }
            __syncthreads();
        }
    }
    if (blockIdx.x == gridDim.x - 1) {
        float* LB = (float*)(a.ws + WS_LB); const float* lbin = a.in[16];
        for (int e = tid; e < 1024; e += 512) {
            const float x0 = lbin[e], x1 = lbin[1024 + e], x2 = lbin[2048 + e], x3 = lbin[3072 + e];
            const float mx = fmaxf(fmaxf(x0, x1), fmaxf(x2, x3));
            const float e0 = __expf(x0 - mx), e1 = __expf(x1 - mx), e2 = __expf(x2 - mx), e3 = __expf(x3 - mx); const float inv = 1.f / (e0 + e1 + e2 + e3);
            LB[e] = 0.f; LB[1024 + e] = e1 * inv; LB[2048 + e] = (e1 + e2) * inv; LB[3072 + e] = (e1 + e2 + e3) * inv;
        }
        float* cosT = (float*)(a.ws + WS_ROPE); float* sinT = cosT + 1024;
        for (int e = tid; e < 1024; e += 512) { const int pos = e >> 4, i = e & 15; const float inv = exp2f(-(float)i * (13.287712379549449f / 16.f)); const float ang = (float)pos * inv;
            cosT[e] = cosf(ang); sinT[e] = sinf(ang); }
    }
}

DI void transpose_item(const float* W, int ldw, int srccol0, int k0, bf16_t* WT, int K, int dstrow0, float* scr, int lane) {
#pragma unroll 8
    for (int i = 0; i < 32; ++i) { const int kk = 2 * i + (lane >> 5); scr[kk * 33 + (lane & 31)] = W[(size_t)(k0 + kk) * ldw + srccol0 + (lane & 31)]; }
    LDS_WAIT();
    const int c = lane & 7;
#pragma unroll
    for (int j = 0; j < 4; ++j) { const int n = (lane >> 3) + 8 * j; const float* sp = scr + (8 * c) * 33 + n;
        u32x4 o; o.x = pk2(sp[0 * 33], sp[1 * 33]); o.y = pk2(sp[2 * 33], sp[3 * 33]); o.z = pk2(sp[4 * 33], sp[5 * 33]); o.w = pk2(sp[6 * 33], sp[7 * 33]);
        *(u32x4*)(WT + (size_t)(dstrow0 + n) * K + k0 + 8 * c) = o; }
    LDS_WAIT();
}
DI void phase_wconv(const Args& a, unsigned char* lds, int l) {
    const int tid = otid(), lane = tid & 63, w = tid >> 6;
    float* scr = (float*)(lds + w * 8448);
    const int gw = obid() * 8 + w, NGW = gridDim.x * 8;
    for (int it = gw; it < 13312; it += NGW) {
        int r = it;
        if (r < 5632) { const int j = r / 2816; r -= j * 2816; const int kb = r / 176, nb = r % 176, n0 = 32 * nb, pn = n0 >> 8, loc = n0 & 255;
            const int src = (loc >> 7) * DFF + 128 * pn + (loc & 127);
            transpose_item(a.in[12] + (size_t)(l * 2 + j) * 1024 * 5632, 5632, src, 64 * kb, (bf16_t*)(a.ws + WS_WFI) + (size_t)j * 5632 * 1024, 1024, n0, scr, lane); continue; }
        r -= 5632;
        if (r < 2816) { const int j = r / 1408; r -= j * 1408; const int kb = r / 32, nb = r % 32;
            transpose_item(a.in[13] + (size_t)(l * 2 + j) * DFF * 1024, 1024, 32 * nb, 64 * kb, (bf16_t*)(a.ws + WS_WFO) + (size_t)j * 1024 * DFF, DFF, 32 * nb, scr, lane); continue; }
        r -= 2816;
        if (r < 3584) { const int kb = r / 224, nb = r % 224;
            transpose_item(a.in[14] + (size_t)l * 1024 * INW, INW, 32 * nb, 64 * kb, (bf16_t*)(a.ws + WS_WIN), 1024, 32 * nb, scr, lane); continue; }
        r -= 3584;
        if (r < 768) { const int k = r / 256; r -= k * 256; const int kb = r / 32, nb = r % 32;
            transpose_item(a.in[19] + (size_t)(l * 3 + k) * 512 * 1024, 1024, 32 * nb, 64 * kb, (bf16_t*)(a.ws + WS_WBR) + (size_t)k * 1024 * 512, 512, 32 * nb, scr, lane); continue; }
        r -= 768;
        { const int kb = r / 32, nb = r % 32;
            transpose_item(a.in[20] + (size_t)l * 1024 * 1024, 1024, 32 * nb, 64 * kb, (bf16_t*)(a.ws + WS_WOUT), 1024, 32 * nb, scr, lane); }
    }
}

DI void phase_norm(const Args& a, int l, int j, bool first) {
    const int tid = otid(), lane = tid & 63, w = tid >> 6;
    const int gw = obid() * 8 + w, NGW = gridDim.x * 8;
    const float* g = a.in[11] + (size_t)(l * 3 + j) * DM; const float* MOD = (const float*)(a.ws + WS_MOD) + (size_t)l * 9 * NMODW;
    bf16_t* HB = (bf16_t*)(a.ws + WS_HB);
    f32x4 gg[4];
#pragma unroll
    for (int jj = 0; jj < 4; ++jj) gg[jj] = *(const f32x4*)(g + 4 * lane + 256 * jj);
    for (int row = gw; row < T; row += NGW) {
        const float* xr = first ? (row < TC ? a.in[0] + (size_t)row * DM : a.in[1] + (size_t)(row - TC) * DM) : a.out + (size_t)row * DM;
        const int cond = row < TC ? 8 : ((row - TC) >> 11);
        const float* shift = MOD + (size_t)cond * NMODW + 3 * j * DM; const float* scale = shift + DM;
        f32x4 v[4]; float ss = 0.f;
#pragma unroll
        for (int jj = 0; jj < 4; ++jj) { v[jj] = *(const f32x4*)(xr + 4 * lane + 256 * jj); ss += (v[jj][0] * v[jj][0] + v[jj][1] * v[jj][1]) + (v[jj][2] * v[jj][2] + v[jj][3] * v[jj][3]); }
        const float rstd = rsqrtf(wave_sum(ss) * (1.f / DM) + EPS);
#pragma unroll
        for (int jj = 0; jj < 4; ++jj) { const f32x4 sc = *(const f32x4*)(scale + 4 * lane + 256 * jj), sh = *(const f32x4*)(shift + 4 * lane + 256 * jj);
            const f32x4 y = v[jj] * rstd * gg[jj] * (1.f + sc) + sh;
            u32x2 o; o.x = pk2(y[0], y[1]); o.y = pk2(y[2], y[3]);
            *(u32x2*)(HB + (size_t)row * DM + 4 * lane + 256 * jj) = o; }
    }
}
DI void phase_final(const Args& a) {
    const int tid = otid(), lane = tid & 63, w = tid >> 6;
    const int gw = obid() * 8 + w, NGW = gridDim.x * 8;
    const float* g = a.in[21];
    f32x4 gg[4];
#pragma unroll
    for (int jj = 0; jj < 4; ++jj) gg[jj] = *(const f32x4*)(g + 4 * lane + 256 * jj);
    for (int row = gw; row < T; row += NGW) {
        float* xr = a.out + (size_t)row * DM;
        f32x4 v[4]; float ss = 0.f;
#pragma unroll
        for (int jj = 0; jj < 4; ++jj) { v[jj] = *(const f32x4*)(xr + 4 * lane + 256 * jj); ss += (v[jj][0] * v[jj][0] + v[jj][1] * v[jj][1]) + (v[jj][2] * v[jj][2] + v[jj][3] * v[jj][3]); }
        const float rstd = rsqrtf(wave_sum(ss) * (1.f / DM) + EPS);
#pragma unroll
        for (int jj = 0; jj < 4; ++jj) *(f32x4*)(xr + 4 * lane + 256 * jj) = v[jj] * rstd * gg[jj];
    }
}

DI void phase_prep(const Args& a, int l) {
    const int tid = otid(), lane = tid & 63, w = tid >> 6;
    const int gw = obid() * 8 + w, NGW = gridDim.x * 8;
    bf16_t* PROJ = (bf16_t*)(a.ws + WS_PROJ);
    const float* cosT = (const float*)(a.ws + WS_ROPE); const float* sinT = cosT + 1024;
    const float qg = a.in[15][(l * 2 + 0) * 64 + lane], kg = a.in[15][(l * 2 + 1) * 64 + lane];
    bf16_t* KAL = (bf16_t*)(a.ws + WS_KAL); bf16_t* VAL = (bf16_t*)(a.ws + WS_VAL); bf16_t* KWL = (bf16_t*)(a.ws + WS_KWL); bf16_t* VWL = (bf16_t*)(a.ws + WS_VWL);
    bf16_t* KAC = (bf16_t*)(a.ws + WS_KAC); bf16_t* VAC = (bf16_t*)(a.ws + WS_VAC); bf16_t* KWC = (bf16_t*)(a.ws + WS_KWC); bf16_t* VWC = (bf16_t*)(a.ws + WS_VWC);
    for (int r = gw; r < T + 2048; r += NGW) {
        if (r < T) {
            const bool lat = r >= TC; int b, t;
            if (lat) { b = (r - TC) >> 11; t = (r - TC) & 2047; } else { b = r >> 8; t = r & 255; }
            float cs = 1.f, sn = 0.f;
            if (lat) { const int pos = (lane & 32) ? (t & 63) : (t >> 6); cs = cosT[pos * 16 + (lane & 15)]; sn = sinT[pos * 16 + (lane & 15)]; if (!(lane & 16)) sn = -sn; }
            bf16_t* pr = PROJ + (size_t)r * INW;
            bf16_t raw[24];
#pragma unroll
            for (int hh = 0; hh < 24; ++hh) raw[hh] = pr[64 * hh + lane];
#pragma unroll
            for (int h = 0; h < 8; ++h) {
                const float x = bf2f(raw[h]); const float ss = wave_sum(x * x);
                float y = x * rsqrtf(ss * (1.f / 64.f) + EPS) * qg;
                if (lat) { const float p = __shfl_xor(y, 16); y = y * cs + p * sn; }
                pr[C_AQ + 64 * h + lane] = f2bf(y * 0.125f);
            }
#pragma unroll
            for (int h = 0; h < 8; ++h) {
                float y = bf2f(raw[12 + h]);
                if (lat) { const float p = __shfl_xor(y, 16); y = y * cs + p * sn; }
                pr[C_WQ + 64 * h + lane] = f2bf(y * 0.125f);
            }
#pragma unroll
            for (int g2 = 0; g2 < 2; ++g2) {
                const float x = bf2f(raw[8 + g2]); const float ss = wave_sum(x * x);
                float y = x * rsqrtf(ss * (1.f / 64.f) + EPS) * kg;
                if (lat) { const float p = __shfl_xor(y, 16); y = y * cs + p * sn; }
                const bf16_t vbits = raw[10 + g2];
                float yw = bf2f(raw[20 + g2]);
                if (lat) { const float p = __shfl_xor(yw, 16); yw = yw * cs + p * sn; }
                const bf16_t wvbits = raw[22 + g2];
                if (lat) {
                    KAL[((size_t)(b * 2 + g2) * 2304 + 256 + t) * 64 + lane] = f2bf(y);
                    VAL[((size_t)(b * 2 + g2) * 64 + lane) * 2304 + 256 + t] = vbits;
                    KWL[((size_t)(b * 2 + g2) * 2304 + 256 + t) * 64 + lane] = f2bf(yw);
                    VWL[((size_t)(b * 2 + g2) * 64 + lane) * 2304 + 256 + t] = wvbits;
                } else {
                    KAC[((size_t)(b * 2 + g2) * 256 + t) * 64 + lane] = f2bf(y);
                    VAC[((size_t)(b * 2 + g2) * 64 + lane) * 256 + t] = vbits;
                    KWC[((size_t)(b * 2 + g2) * 256 + t) * 64 + lane] = f2bf(yw);
                    VWC[((size_t)(b * 2 + g2) * 64 + lane) * 256 + t] = wvbits;
                    const size_t oi = ((((size_t)b * DEPTH + l) * 256 + t) * 2 + g2) * 64 + lane;
                    a.out[O_NKA + oi] = y; a.out[O_NVA + oi] = bf2f(vbits); a.out[O_NKW + oi] = yw; a.out[O_NVW + oi] = bf2f(wvbits);
                }
            }
        } else {
            const int idx = r - T, b = idx >> 8, p = idx & 255;
#pragma unroll
            for (int g2 = 0; g2 < 2; ++g2) {
                const size_t ci = ((((size_t)b * DEPTH + l) * 256 + p) * 2 + g2) * 64 + lane;
                KAL[((size_t)(b * 2 + g2) * 2304 + p) * 64 + lane] = f2bf(a.in[2][ci]);
                VAL[((size_t)(b * 2 + g2) * 64 + lane) * 2304 + p] = f2bf(a.in[3][ci]);
                KWL[((size_t)(b * 2 + g2) * 2304 + p) * 64 + lane] = f2bf(a.in[4][ci]);
                VWL[((size_t)(b * 2 + g2) * 64 + lane) * 2304 + p] = f2bf(a.in[5][ci]);
            }
        }
    }
}

DI void attn_item(unsigned char* lds, const bf16_t* qp, bf16_t* op, const bf16_t* Kb, const bf16_t* VTb, int nk, int nA, int lo, int hi, bool win, int tq, bool has_sink, float sink2) {
    const int tid = otid(), lane = tid & 63, h = lane >> 5, c = lane & 31;
    const int ntile = nA + (hi - lo);
    bf16_t* Kst0 = (bf16_t*)lds; bf16_t* Vst0 = (bf16_t*)(lds + 9216);
    bf16x8 qf[4];
#pragma unroll
    for (int s = 0; s < 4; ++s) qf[s] = *(const bf16x8*)(qp + 16 * s + 8 * h);
    f32x16 O0, O1;
#pragma unroll
    for (int i = 0; i < 16; ++i) { O0[i] = 0.f; O1[i] = 0.f; }
    float m = has_sink ? sink2 : -1e30f; float lsum = (has_sink && h == 0) ? 1.f : 0.f;
    const int lrow = tid >> 3, lch = tid & 7;
    u32x4 kreg, vreg;
    { const int k0 = (0 < nA ? 0 : 4 + lo) * 64; kreg = *(const u32x4*)(Kb + (size_t)(k0 + lrow) * 64 + 8 * lch); vreg = *(const u32x4*)(VTb + (size_t)lrow * nk + k0 + 8 * lch); }
    *(u32x4*)(Kst0 + lrow * 72 + 8 * lch) = kreg; *(u32x4*)(Vst0 + lrow * 72 + 8 * lch) = vreg;
    __syncthreads();
    for (int i = 0; i < ntile; ++i) {
        const int cur = i & 1;
        const int k0 = (i < nA ? i : 4 + lo + (i - nA)) * 64;
        if (i + 1 < ntile) { const int k1 = (i + 1 < nA ? i + 1 : 4 + lo + (i + 1 - nA)) * 64;
            kreg = *(const u32x4*)(Kb + (size_t)(k1 + lrow) * 64 + 8 * lch); vreg = *(const u32x4*)(VTb + (size_t)lrow * nk + k1 + 8 * lch); }
        const bf16_t* Kc = Kst0 + cur * 9216; const bf16_t* Vc = Vst0 + cur * 9216;
        f32x16 st0, st1;
#pragma unroll
        for (int ii = 0; ii < 16; ++ii) { st0[ii] = 0.f; st1[ii] = 0.f; }
#pragma unroll
        for (int s = 0; s < 4; ++s) {
            const bf16x8 a0 = *(const bf16x8*)(Kc + c * 72 + 16 * s + 8 * h), a1 = *(const bf16x8*)(Kc + (32 + c) * 72 + 16 * s + 8 * h);
            st0 = MFMA32(a0, qf[s], st0); st1 = MFMA32(a1, qf[s], st1);
        }
        const bool domask = win && (i >= nA);
        float mx = -1e30f;
#pragma unroll
        for (int ii = 0; ii < 16; ++ii) {
            float v0 = st0[ii] * LOG2E, v1 = st1[ii] * LOG2E;
            if (domask) { const int d0 = tq - (k0 - 256 + crow(ii, h)); if (d0 > 128 || d0 < -128) v0 = -1e30f; const int d1 = d0 - 32; if (d1 > 128 || d1 < -128) v1 = -1e30f; }
            st0[ii] = v0; st1[ii] = v1; mx = fmaxf(mx, fmaxf(v0, v1));
        }
        mx = fmaxf(mx, __shfl_xor(mx, 32));
        const float mnew = fmaxf(m, mx); const float alpha = __builtin_amdgcn_exp2f(m - mnew); m = mnew;
        float ps = 0.f;
#pragma unroll
        for (int ii = 0; ii < 16; ++ii) { const float p0 = __builtin_amdgcn_exp2f(st0[ii] - mnew), p1 = __builtin_amdgcn_exp2f(st1[ii] - mnew); st0[ii] = p0; st1[ii] = p1; ps += p0 + p1; }
        lsum = lsum * alpha + ps;
#pragma unroll
        for (int ii = 0; ii < 16; ++ii) { O0[ii] *= alpha; O1[ii] *= alpha; }
#pragma unroll
        for (int s2 = 0; s2 < 2; ++s2) {
            const bf16x8 pb0 = pack8(st0[8 * s2], st0[8 * s2 + 1], st0[8 * s2 + 2], st0[8 * s2 + 3], st0[8 * s2 + 4], st0[8 * s2 + 5], st0[8 * s2 + 6], st0[8 * s2 + 7]);
            const bf16x8 pb1 = pack8(st1[8 * s2], st1[8 * s2 + 1], st1[8 * s2 + 2], st1[8 * s2 + 3], st1[8 * s2 + 4], st1[8 * s2 + 5], st1[8 * s2 + 6], st1[8 * s2 + 7]);
            {   const bf16_t* v0p = Vc + c * 72 + 16 * s2 + 4 * h; const bf16_t* v1p = Vc + (32 + c) * 72 + 16 * s2 + 4 * h;
                const bf16x8 a00 = cat44(*(const s16x4*)(v0p), *(const s16x4*)(v0p + 8)), a10 = cat44(*(const s16x4*)(v1p), *(const s16x4*)(v1p + 8));
                const bf16x8 a01 = cat44(*(const s16x4*)(v0p + 32), *(const s16x4*)(v0p + 40)), a11 = cat44(*(const s16x4*)(v1p + 32), *(const s16x4*)(v1p + 40));
                O0 = MFMA32(a00, pb0, O0); O1 = MFMA32(a10, pb0, O1); O0 = MFMA32(a01, pb1, O0); O1 = MFMA32(a11, pb1, O1); }
        }
        if (i + 1 < ntile) { *(u32x4*)(Kst0 + (cur ^ 1) * 9216 + lrow * 72 + 8 * lch) = kreg; *(u32x4*)(Vst0 + (cur ^ 1) * 9216 + lrow * 72 + 8 * lch) = vreg; }
        __syncthreads();
    }
    lsum += __shfl_xor(lsum, 32);
    const float inv = 1.f / lsum;
#pragma unroll
    for (int g4 = 0; g4 < 4; ++g4) {
        u32x2 w0, w1;
        w0.x = pk2(O0[4 * g4] * inv, O0[4 * g4 + 1] * inv); w0.y = pk2(O0[4 * g4 + 2] * inv, O0[4 * g4 + 3] * inv);
        w1.x = pk2(O1[4 * g4] * inv, O1[4 * g4 + 1] * inv); w1.y = pk2(O1[4 * g4 + 2] * inv, O1[4 * g4 + 3] * inv);
        *(u32x2*)(op + 8 * g4 + 4 * h) = w0; *(u32x2*)(op + 32 + 8 * g4 + 4 * h) = w1;
    }
}
#define LAS __attribute__((address_space(3)))
#define XB_TMO      128
#define XB_XCNT(j)  (256  + 64 * (j))
#define XB_XSUB(j)  (1280 + 64 * (j))
#define XB_XGEN(j)  (2304 + 64 * (j))
#define XB_TOP      3328
#define XB_TOPGEN   3392
#define XCD_BAR_WORDS 3456
#define XB_SPIN_CAP (1u << 18)

__device__ __forceinline__ unsigned xb_ld(unsigned* p)              { return __hip_atomic_load(p, __ATOMIC_RELAXED, __HIP_MEMORY_SCOPE_AGENT); }
__device__ __forceinline__ unsigned xb_add(unsigned* p, unsigned v) { return __hip_atomic_fetch_add(p, v, __ATOMIC_RELAXED, __HIP_MEMORY_SCOPE_AGENT); }
__device__ __forceinline__ unsigned xb_xcc_id() { return (unsigned)__builtin_amdgcn_s_getreg((3 << 11) | 20) & 0xFu; }
#define XB_SPIN(cond, bar) do { unsigned _sp = 0; while (cond) { __builtin_amdgcn_s_sleep(1); \
    if ((++_sp & 255u) == 0u) { if (xb_ld(&(bar)[XB_TMO])) break; if (_sp > XB_SPIN_CAP) { atomicAdd(&(bar)[XB_TMO], 1u); break; } } } } while (0)

struct XcdBarrier {
    unsigned* bar; unsigned x;
    volatile LAS unsigned* st;
};

__device__ __forceinline__ XcdBarrier xcd_barrier_post(unsigned* bar, volatile LAS unsigned* st) {
    XcdBarrier b; b.bar = bar; b.x = xb_xcc_id(); b.st = st;
    if (threadIdx.x == 0) (void)xb_add(&bar[XB_XCNT(b.x)], 1u);
    return b;
}
__device__ __forceinline__ void xcd_barrier_complete(unsigned* bar, unsigned x, unsigned& nloc, unsigned& nx) {
    const unsigned G = gridDim.x * gridDim.y * gridDim.z;
    unsigned sum, cnt, mine, sp = 0u;
    for (;;) {
        sum = 0u; cnt = 0u; mine = 0u;
#pragma unroll
        for (unsigned j = 0; j < 16; ++j) { const unsigned c = xb_ld(&bar[XB_XCNT(j)]); sum += c; cnt += (c > 0u) ? 1u : 0u; mine = (j == x) ? c : mine; }
        if (sum == G) break;
        __builtin_amdgcn_s_sleep(1);
        if ((++sp & 255u) == 0u) { if (xb_ld(&bar[XB_TMO])) break; if (sp > XB_SPIN_CAP) { atomicAdd(&bar[XB_TMO], 1u); break; } }
    }
    nloc = mine > 0u ? mine : 1u; nx = cnt > 0u ? cnt : 1u;
}

__device__ __forceinline__ void xcd_barrier(const XcdBarrier& b) {
    asm volatile("s_waitcnt vmcnt(0)" ::: "memory");
    __syncthreads();
    if (threadIdx.x == 0) {
        unsigned* bar = b.bar;
        __builtin_amdgcn_s_waitcnt(0);
        unsigned nloc = b.st[0], nx = b.st[1];
        if (nloc == 0u) { xcd_barrier_complete(bar, b.x, nloc, nx); b.st[0] = nloc; b.st[1] = nx; }
        const unsigned old = xb_add(&bar[XB_XSUB(b.x)], 1u);
        const unsigned gen = old / nloc;
        if (old + 1u == (gen + 1u) * nloc) {
            __builtin_amdgcn_fence(__ATOMIC_RELEASE, "agent");
            asm volatile("s_waitcnt vmcnt(0)" ::: "memory");
            const unsigned og = xb_add(&bar[XB_TOP], 1u);
            const unsigned tg = og / nx;
            if (og + 1u == (tg + 1u) * nx) xb_add(&bar[XB_TOPGEN], 1u);
            else XB_SPIN(xb_ld(&bar[XB_TOPGEN]) == tg, bar);
            __builtin_amdgcn_fence(__ATOMIC_ACQUIRE, "agent");
            xb_add(&bar[XB_XGEN(b.x)], 1u);
            asm volatile("s_waitcnt vmcnt(0)" ::: "memory");
        } else {
            XB_SPIN(xb_ld(&bar[XB_XGEN(b.x)]) == gen, bar);
            __builtin_amdgcn_fence(__ATOMIC_ACQUIRE, "agent");
            asm volatile("s_waitcnt vmcnt(0)" ::: "memory");
        }
    }
    __syncthreads();
}


DI void hgrn_item(const Args& a, unsigned char* lds, int l, int seq, int hd, int dir) {
    const int tid = otid(), lane = tid & 63, w = tid >> 6, h = lane >> 5, c = lane & 31;
    const bool lat = seq < 8; const int b = lat ? seq : seq - 8; const int L = lat ? 2048 : 256; const int nch = L >> 5; const int seqbase = lat ? TC + b * 2048 : b * 256;
    bf16_t* RQ = (bf16_t*)lds; bf16_t* RZ = (bf16_t*)(lds + 8704); bf16_t* RV = (bf16_t*)(lds + 17408);
    bf16_t* QS = (bf16_t*)(lds + 26112); bf16_t* KS = (bf16_t*)(lds + 34816);
    bf16_t* KST = (bf16_t*)(lds + 43520); bf16_t* VT = (bf16_t*)(lds + 53760); float* E0 = (float*)(lds + 64000); float* E1 = E0 + 128;
    const bf16_t* PROJ = (const bf16_t*)(a.ws + WS_PROJ);
    float* OF = (float*)(a.ws + WS_OF);
    const int cq = C_HQ + 128 * hd, cz = (dir ? C_HFB : C_HFF) + 128 * hd, cv = C_HI + 128 * hd;
    const int wd = w & 3;
    const int dmy = 32 * wd + c;
    const int t0 = 16 * (w >> 2) + 8 * h;
    f32x16 S[4];
    if (w < 4) {
        if (lat) { const float* sp = a.in[6] + ((((size_t)(b * DEPTH + l) * 2 + dir) * 4 + hd) * 128) * 128;
#pragma unroll
            for (int dt = 0; dt < 4; ++dt)
#pragma unroll
                for (int ii = 0; ii < 16; ++ii) S[dt][ii] = sp[(size_t)(32 * dt + crow(ii, h)) * 128 + dmy];
        } else {
#pragma unroll
            for (int dt = 0; dt < 4; ++dt)
#pragma unroll
                for (int ii = 0; ii < 16; ++ii) S[dt][ii] = 0.f;
        }
    }
    const float lbv = ((const float*)(a.ws + WS_LB))[(l * 2 + dir) * 512 + 128 * hd + dmy];
    const float omlb = 1.f - lbv;
    u32x4 rq, rz, rv;
    const int lt = tid >> 4, lcn = tid & 15;
#define HG_GLOAD(ch) do { const int p_ = 32 * (ch) + lt, pos_ = dir ? L - 1 - p_ : p_; const bf16_t* rp_ = PROJ + (size_t)(seqbase + pos_) * INW + 8 * lcn; \
        rq = *(const u32x4*)(rp_ + cq); rz = *(const u32x4*)(rp_ + cz); rv = *(const u32x4*)(rp_ + cv); } while (0)
    HG_GLOAD(0);
    for (int ch = 0; ch < nch; ++ch) {
        *(u32x4*)(RQ + lt * 136 + 8 * lcn) = rq; *(u32x4*)(RZ + lt * 136 + 8 * lcn) = rz; *(u32x4*)(RV + lt * 136 + 8 * lcn) = rv;
        __syncthreads();
        if (ch + 1 < nch) HG_GLOAD(ch + 1);
        {
            float qv[8], kv[8], gv[8]; float qtot = 0.f;
#pragma unroll
            for (int tt = 0; tt < 8; ++tt) { const int t = t0 + tt; const float qr = bf2f(RQ[t * 136 + dmy]), z = bf2f(RZ[t * 136 + dmy]);
                const float sg = sigmoidf_(z); const float f = lbv + omlb * sg; const float g = __logf(fmaxf(f, 1e-30f));
                kv[tt] = omlb * (1.f - sg); qv[tt] = qr * sigmoidf_(qr); gv[tt] = g; qtot += g; }
            const float partner = __shfl_xor(qtot, 32);
            float e[8];
            if (w < 4) { float run = h ? 0.f : -partner;
#pragma unroll
                for (int tt = 7; tt >= 0; --tt) { e[tt] = run; run -= gv[tt]; }
                if (h == 0) E0[dmy] = __expf(qtot + partner);
            } else { float run = h ? partner : 0.f;
#pragma unroll
                for (int tt = 0; tt < 8; ++tt) { run += gv[tt]; e[tt] = run; }
                if (h == 0) E1[dmy] = __expf(qtot + partner);
            }
            float ke[8];
#pragma unroll
            for (int tt = 0; tt < 8; ++tt) { const int t = t0 + tt; const float ex = __expf(e[tt]), exn = __builtin_amdgcn_rcpf(ex);
                ke[tt] = kv[tt] * exn;
                QS[t * 136 + dmy] = f2bf(qv[tt] * ex); KS[t * 136 + dmy] = f2bf(ke[tt]); }
            *(bf16x8*)(KST + dmy * 40 + t0) = pack8(ke[0], ke[1], ke[2], ke[3], ke[4], ke[5], ke[6], ke[7]);
            bf16x8 v0;
#pragma unroll
            for (int tt = 0; tt < 8; ++tt) v0[tt] = (short)RV[(t0 + tt) * 136 + dmy];
            *(bf16x8*)(VT + dmy * 40 + t0) = v0;
        }
        __syncthreads();
        if (w < 4) {
            f32x16 st;
#pragma unroll
            for (int ii = 0; ii < 16; ++ii) st[ii] = 0.f;
#pragma unroll
            for (int s = 0; s < 8; ++s) { const bf16x8 ak = *(const bf16x8*)(KS + c * 136 + 16 * s + 8 * h), bq = *(const bf16x8*)(QS + c * 136 + 16 * s + 8 * h); st = MFMA32(ak, bq, st); }
#pragma unroll
            for (int ii = 0; ii < 16; ++ii) if (crow(ii, h) > c) st[ii] = 0.f;
            f32x16 o;
#pragma unroll
            for (int ii = 0; ii < 16; ++ii) o[ii] = 0.f;
#pragma unroll
            for (int s2 = 0; s2 < 2; ++s2) {
                const bf16x8 pb = pack8(st[8 * s2], st[8 * s2 + 1], st[8 * s2 + 2], st[8 * s2 + 3], st[8 * s2 + 4], st[8 * s2 + 5], st[8 * s2 + 6], st[8 * s2 + 7]);
                const bf16_t* vp = VT + dmy * 40 + 16 * s2 + 4 * h;
                o = MFMA32(cat44(*(const s16x4*)vp, *(const s16x4*)(vp + 8)), pb, o);
            }
#pragma unroll
            for (int dt = 0; dt < 4; ++dt) {
#pragma unroll
                for (int g4 = 0; g4 < 4; ++g4) { const f32x4 ev = *(const f32x4*)(E0 + 32 * dt + 8 * g4 + 4 * h);
                    S[dt][4 * g4] *= ev[0]; S[dt][4 * g4 + 1] *= ev[1]; S[dt][4 * g4 + 2] *= ev[2]; S[dt][4 * g4 + 3] *= ev[3]; }
#pragma unroll
                for (int s2 = 0; s2 < 2; ++s2) {
                    const bf16x8 xs = pack8(S[dt][8 * s2], S[dt][8 * s2 + 1], S[dt][8 * s2 + 2], S[dt][8 * s2 + 3], S[dt][8 * s2 + 4], S[dt][8 * s2 + 5], S[dt][8 * s2 + 6], S[dt][8 * s2 + 7]);
                    const bf16_t* qb = QS + c * 136 + 32 * dt + 16 * s2 + 4 * h;
                    o = MFMA32(xs, cat44(*(const s16x4*)qb, *(const s16x4*)(qb + 8)), o);
                }
            }
            {   const int p = 32 * ch + c, pos = dir ? L - 1 - p : p;
                float* op = OF + ((size_t)dir * T + seqbase + pos) * 512 + 128 * hd + 32 * wd;
#pragma unroll
                for (int g4 = 0; g4 < 4; ++g4) { f32x4 v; v[0] = o[4 * g4]; v[1] = o[4 * g4 + 1]; v[2] = o[4 * g4 + 2]; v[3] = o[4 * g4 + 3]; *(f32x4*)(op + 8 * g4 + 4 * h) = v; } }
#pragma unroll
            for (int dt = 0; dt < 4; ++dt) {
#pragma unroll
                for (int s2 = 0; s2 < 2; ++s2) { const bf16x8 ak = *(const bf16x8*)(KST + (32 * dt + c) * 40 + 16 * s2 + 8 * h), bv = *(const bf16x8*)(VT + dmy * 40 + 16 * s2 + 8 * h);
                    S[dt] = MFMA32(ak, bv, S[dt]); }
#pragma unroll
                for (int g4 = 0; g4 < 4; ++g4) { const f32x4 ev = *(const f32x4*)(E1 + 32 * dt + 8 * g4 + 4 * h);
                    S[dt][4 * g4] *= ev[0]; S[dt][4 * g4 + 1] *= ev[1]; S[dt][4 * g4 + 2] *= ev[2]; S[dt][4 * g4 + 3] *= ev[3]; }
            }
        }
    }
#undef HG_GLOAD
    if (!lat && w < 4) { float* sp = a.out + O_NST + ((((size_t)(b * DEPTH + l) * 2 + dir) * 4 + hd) * 128) * 128;
#pragma unroll
        for (int dt = 0; dt < 4; ++dt)
#pragma unroll
            for (int ii = 0; ii < 16; ++ii) sp[(size_t)(32 * dt + crow(ii, h)) * 128 + dmy] = S[dt][ii];
    }
}

DI void phase_mixer(const Args& a, unsigned char* lds, int l, int rep) {
    unsigned* ctl = (unsigned*)(a.ws + WS_CTL) + 16 * l + 8 * rep;
    volatile int* slot = (volatile int*)(lds + LDS_MISC);
    const int tid = otid(), lane = tid & 63, w = tid >> 6, c = lane & 31;
    bf16_t* PROJ = (bf16_t*)(a.ws + WS_PROJ);
    for (;;) {
        __syncthreads();
        if (tid == 0) *slot = (int)__hip_atomic_fetch_add(ctl, 1u, __ATOMIC_RELAXED, __HIP_MEMORY_SCOPE_AGENT);
        __syncthreads();
        const int it = *slot;
        if (it >= 1856) break;
#if PROBE_MASK & 16
        if (rep && !(it < 64 || (it >= 576 && it < 832))) continue;
#endif
#if PROBE_MASK & 32
        if (rep && (it < 64 || (it >= 576 && it < 832))) continue;
#endif
#ifndef NO_HG
        if (it < 64) { hgrn_item(a, lds, l, it >> 3, (it >> 1) & 3, it & 1); continue; }
        if (it >= 576 && it < 832) { const int idx = it - 576; hgrn_item(a, lds, l, 8 + (idx >> 3), (idx >> 1) & 3, idx & 1); continue; }
#endif
        int idx, kind;
        if (it < 576) { idx = it - 64; kind = 0; } else if (it < 1344) { idx = it - 832; kind = 1; } else if (it < 1600) { idx = it - 1344; kind = 2; } else { idx = it - 1600; kind = 3; }
        const bool lat = kind < 2, isw = kind & 1;
        int b, g, qb;
        if (lat) { b = idx >> 6; g = (idx >> 5) & 1; qb = idx & 31; } else { b = idx >> 3; g = (idx >> 2) & 1; qb = idx & 3; }
        const int r = w & 3, tq = 64 * qb + 32 * (w >> 2) + c;
        const int row = (lat ? TC + b * 2048 : b * 256) + tq;
        const bf16_t* qp = PROJ + (size_t)row * INW + (isw ? C_WQ : C_AQ) + (4 * g + r) * 64;
        bf16_t* op = (bf16_t*)(a.ws + (isw ? WS_OWIN : WS_OATT)) + (size_t)row * 512 + (4 * g + r) * 64;
        const bf16_t* Kb; const bf16_t* VTb; int nk;
        if (lat) { nk = 2304; Kb = (const bf16_t*)(a.ws + (isw ? WS_KWL : WS_KAL)) + (size_t)(b * 2 + g) * 2304 * 64; VTb = (const bf16_t*)(a.ws + (isw ? WS_VWL : WS_VAL)) + (size_t)(b * 2 + g) * 64 * 2304; }
        else { nk = 256; Kb = (const bf16_t*)(a.ws + (isw ? WS_KWC : WS_KAC)) + (size_t)(b * 2 + g) * 256 * 64; VTb = (const bf16_t*)(a.ws + (isw ? WS_VWC : WS_VAC)) + (size_t)(b * 2 + g) * 64 * 256; }
        int nA = 4, lo = 0, hi = 0; bool win = false;
        if (kind == 0) nA = 36;
        if (kind == 1) { lo = qb - 2 < 0 ? 0 : qb - 2; hi = qb + 3 > 32 ? 32 : qb + 3; win = true; }
        const float sink2 = isw ? a.in[18][l * 8 + 4 * g + r] * LOG2E : 0.f;
#ifndef NO_ATT
        attn_item(lds, qp, op, Kb, VTb, nk, nA, lo, hi, win, tq, isw, sink2);
#endif
    }
}

DI void phase_hgcomb(const Args& a, int l) {
    const int tid = otid(), lane = tid & 63, w = tid >> 6;
    const int gw = obid() * 8 + w, NGW = gridDim.x * 8;
    const float* OF = (const float*)(a.ws + WS_OF); const bf16_t* PROJ = (const bf16_t*)(a.ws + WS_PROJ); bf16_t* OHG = (bf16_t*)(a.ws + WS_OHG);
    const f32x2 gn = *(const f32x2*)(a.in[17] + l * 128 + 2 * lane);
    for (int it = gw; it < T * 4; it += NGW) {
        const int row = it >> 2, hd = it & 3;
        const f32x2 x0 = *(const f32x2*)(OF + (size_t)row * 512 + 128 * hd + 2 * lane), x1 = *(const f32x2*)(OF + ((size_t)T + row) * 512 + 128 * hd + 2 * lane);
        const float s0 = x0[0] + x1[0], s1 = x0[1] + x1[1];
        const float rstd = rsqrtf(wave_sum(s0 * s0 + s1 * s1) * (1.f / 128.f) + EPS);
        const unsigned gb = *(const unsigned*)(PROJ + (size_t)row * INW + C_HG + 128 * hd + 2 * lane);
        const float g0 = bflo(gb), g1 = bfhi(gb);
        *(unsigned*)(OHG + (size_t)row * 512 + 128 * hd + 2 * lane) = pk2(s0 * rstd * gn[0] * g0 * sigmoidf_(g0), s1 * rstd * gn[1] * g1 * sigmoidf_(g1));
    }
}

template <class Epi> DI void run_gemm(unsigned char* lds, const bf16_t* A, const bf16_t* Bt, int N, int K, const Epi& E) {
    pg8::Gemm g{A, Bt, T, N, K}; pg8::StaticOrder S; S.init(T, N, (int)gridDim.x, obid());
#if STAGGER
    {
        const unsigned long long t0 = __builtin_amdgcn_s_memrealtime();
        const unsigned long long dly = (unsigned long long)((obid() >> 3) & 7) * (unsigned long long)(STAGGER * (K / 64));
        while (__builtin_amdgcn_s_memrealtime() - t0 < dly) __builtin_amdgcn_s_sleep(4);
    }
#endif
    pg8::gemm_phase<Epi, pg8::StaticOrder, false>((PG8_LAS unsigned char*)lds, g, S, E, nullptr);
}

__global__ void __launch_bounds__(512, 2) mk_fwd(Args a) {
    extern __shared__ __attribute__((aligned(16))) unsigned char lds[];
    cg::grid_group grid = cg::this_grid();
    {   volatile LAS unsigned* st = (volatile LAS unsigned*)((LAS unsigned char*)lds + LDS_MISC + 16);
        if (threadIdx.x < 2) st[threadIdx.x] = 0u;
        __syncthreads(); }
    const XcdBarrier bar = xcd_barrier_post((unsigned*)(a.ws + WS_BAR), (volatile LAS unsigned*)((LAS unsigned char*)lds + LDS_MISC + 16));
    bf16_t* HB = (bf16_t*)(a.ws + WS_HB); bf16_t* PROJ = (bf16_t*)(a.ws + WS_PROJ); bf16_t* ACT = PROJ;
    float* M32 = (float*)(a.ws + WS_OF);
    for (int ph = a.ph_lo; ph < a.ph_hi; ++ph) {
        if (ph > a.ph_lo) { if (ph == a.ph_lo + 1) grid.sync(); else xcd_barrier(bar);
#if PROBE_MASK & 8
            xcd_barrier(bar); xcd_barrier(bar);
#endif
        }
#ifndef NO_P0
        if (ph == 0) { phase_p0(a, lds); continue; }
#endif
#ifndef NO_C0
        if (ph == NPH - 1) { phase_final(a); continue; }
#endif
        const int l = (ph - 1) / 13, k = (ph - 1) % 13;
        int reps = 1;
        if ((PROBE_MASK & 1) && (k == 0 || k == 3 || k == 10 || k == 7)) reps = 2;
        if ((PROBE_MASK & 2) && (k == 1 || k == 11 || k == 4 || k == 8)) reps = 2;
        if ((PROBE_MASK & (4 | 16 | 32)) && k == 6) reps = 2;
        if ((PROBE_MASK & (64 | 128)) && (k == 1 || k == 11)) reps = 2;
        for (int rep = 0; rep < reps; ++rep) {
        if (rep) xcd_barrier(bar);
        const float* MODL = (const float*)(a.ws + WS_MOD) + (size_t)l * 9 * NMODW;
        const float* xa = a.out; const float* xb = a.out + (size_t)TC * DM;
        const bf16_t* WFI = (const bf16_t*)(a.ws + WS_WFI); const bf16_t* WFO = (const bf16_t*)(a.ws + WS_WFO);
        if (k == 100) {}
#ifndef NO_C0
        else if (k == 0) { phase_wconv(a, lds, l); phase_norm(a, l, 0, l == 0); }
        else if (k == 3 || k == 10) { phase_norm(a, l, k == 3 ? 1 : 2, false); }
#endif
#ifndef NO_G_SW
        else if (k == 1 || k == 11) { run_gemm(lds, HB, k == 1 ? WFI : WFI + (size_t)5632 * 1024, 2 * DFF, ((PROBE_MASK & 128) && rep == 0) ? 512 : DM, pg8::EpiSwiglu{ACT}); }
#endif
#ifndef NO_G_RES
        else if (k == 2 || k == 9 || k == 12) {
            if (k == 2 && l == 0) { xa = a.in[0]; xb = a.in[1]; }
            const bf16_t* A = k == 9 ? HB : ACT; const bf16_t* Bt = k == 9 ? (const bf16_t*)(a.ws + WS_WOUT) : (k == 2 ? WFO : WFO + (size_t)1024 * DFF);
            const int K = k == 9 ? DM : DFF; const int gi = k == 2 ? 2 : (k == 9 ? 5 : 8);
            run_gemm(lds, A, Bt, DM, K, pg8::EpiResid{xa, xb, a.out, MODL + gi * DM, k == 9 ? 1.0f : 0.5f});
        }
#endif
#ifndef NO_G_BF
        else if (k == 4) { run_gemm(lds, HB, (const bf16_t*)(a.ws + WS_WIN), INW, DM, pg8::EpiBf16P{PROJ, INW}); }
#endif
#ifndef NO_PREP
        else if (k == 5) { phase_prep(a, l); }
#endif
#ifndef NO_MIX
        else if (k == 6) { phase_mixer(a, lds, l, rep); }
#endif
#ifndef NO_C0
        else if (k == 7) { phase_hgcomb(a, l); }
#endif
#ifndef NO_G_BR
        else if (k == 8) {
            const bf16_t* WBR = (const bf16_t*)(a.ws + WS_WBR);
            for (int kk = 0; kk < 3; ++kk) {
                const bf16_t* A = (const bf16_t*)(a.ws + (kk == 0 ? WS_OATT : (kk == 1 ? WS_OHG : WS_OWIN)));
                run_gemm(lds, A, WBR + (size_t)kk * 1024 * 512, DM, 512, pg8::EpiBranch{PROJ + C_GA + 1024 * kk, M32, HB, kk});
            }
        }
#endif
        }
    }
}

#ifndef MK_PER_PHASE
#define MK_PER_PHASE 0
#endif
extern "C" void kernel_launch(void* const* d_in, const int* in_sizes, int n_in, void* d_out, int out_size, void* d_ws, size_t ws_size, hipStream_t stream) {
    static int grid = 0;
    if (!grid) {
        if (n_in != 22 || ws_size < WS_END) { fprintf(stderr, "kernel_launch: unexpected n_in %d or ws_size %zu < %zu\n", n_in, ws_size, (size_t)WS_END); grid = -1; return; }
        int dev = 0, cus = 0, per_cu = 0;
        (void)hipGetDevice(&dev); (void)hipDeviceGetAttribute(&cus, hipDeviceAttributeMultiprocessorCount, dev);
        if (hipFuncSetAttribute((const void*)mk_fwd, hipFuncAttributeMaxDynamicSharedMemorySize, LDS_BYTES) != hipSuccess) { fprintf(stderr, "kernel_launch: hipFuncSetAttribute failed\n"); grid = -1; return; }
        (void)hipOccupancyMaxActiveBlocksPerMultiprocessor(&per_cu, mk_fwd, 512, LDS_BYTES);
        if (per_cu < 1) per_cu = 1;
        grid = cus * per_cu; if (grid > 256) grid = 256;
    }
    if (grid < 0) return;
    (void)hipMemsetAsync((char*)d_ws + WS_CTL, 0, CTL_BYTES, stream);
    Args a{};
    for (int i = 0; i < 22; ++i) a.in[i] = (const float*)d_in[i];
    a.out = (float*)d_out; a.ws = (unsigned char*)d_ws;
#if MK_PER_PHASE
    for (int ph = 0; ph < NPH; ++ph) { a.ph_lo = ph; a.ph_hi = ph + 1; hipLaunchKernelGGL(mk_fwd, dim3(grid), dim3(512), LDS_BYTES, stream, a); }
#else
    a.ph_lo = 0; a.ph_hi = NPH;
    void* args[] = {&a};
    hipError_t e = hipLaunchCooperativeKernel((void*)mk_fwd, dim3(grid), dim3(512), args, LDS_BYTES, stream);
    if (e != hipSuccess) fprintf(stderr, "cooperative launch failed: %s (grid %d)\n", hipGetErrorString(e), grid);
#endif
}
```

```cpp
#include <hip/hip_runtime.h>
#include <hip/hip_cooperative_groups.h>
#include <cstdio>
#include <cstdint>
namespace cg = cooperative_groups;

#ifndef PROBE_MASK
#define PROBE_MASK 0
#endif
#ifndef STAGGER
#define STAGGER 0
#endif
#define DI __device__ __forceinline__
typedef unsigned short bf16_t;
typedef short bf16x8 __attribute__((ext_vector_type(8)));
typedef short s16x4 __attribute__((ext_vector_type(4)));
typedef float f32x2 __attribute__((ext_vector_type(2)));
typedef float f32x4 __attribute__((ext_vector_type(4)));
typedef float f32x16 __attribute__((ext_vector_type(16)));
typedef unsigned u32x2 __attribute__((ext_vector_type(2)));
typedef unsigned u32x4 __attribute__((ext_vector_type(4)));
typedef __bf16 bf16x2n __attribute__((ext_vector_type(2)));

DI int otid() { int t = threadIdx.x; asm volatile("" : "+v"(t)); return t; }
DI int obid() { int b = blockIdx.x; asm volatile("" : "+s"(b)); return b; }
DI unsigned pk2(float lo, float hi) { f32x2 v = {lo, hi}; return __builtin_bit_cast(unsigned, __builtin_convertvector(v, bf16x2n)); }
DI float bflo(unsigned u) { return __uint_as_float(u << 16); }
DI float bfhi(unsigned u) { return __uint_as_float(u & 0xffff0000u); }
DI float bf2f(bf16_t b) { return __uint_as_float(((unsigned)b) << 16); }
DI bf16_t f2bf(float f) { return (bf16_t)(pk2(f, 0.f) & 0xffffu); }
DI float sigmoidf_(float x) { return __builtin_amdgcn_rcpf(1.f + __expf(-x)); }
DI float wave_sum(float v) {
#pragma unroll
    for (int o = 1; o < 64; o <<= 1) v += __shfl_xor(v, o);
    return v;
}
#define MFMA32(a, b, c) __builtin_amdgcn_mfma_f32_32x32x16_bf16((a), (b), (c), 0, 0, 0)
DI bf16x8 pack8(float a0, float a1, float a2, float a3, float a4, float a5, float a6, float a7) {
    u32x4 p; p.x = pk2(a0, a1); p.y = pk2(a2, a3); p.z = pk2(a4, a5); p.w = pk2(a6, a7); return __builtin_bit_cast(bf16x8, p);
}
DI bf16x8 cat44(s16x4 lo, s16x4 hi) { return __builtin_shufflevector(lo, hi, 0, 1, 2, 3, 4, 5, 6, 7); }

constexpr int DM = 1024, DEPTH = 4, TC = 8192, TL = 16384, T = 24576, DFF = 2816, INW = 7168, NMODW = 9216;
constexpr int C_AQ = 0, C_AK = 512, C_AV = 640, C_WQ = 768, C_WK = 1280, C_WV = 1408, C_HQ = 1536, C_HFF = 2048, C_HFB = 2560, C_HI = 3072, C_HG = 3584, C_GA = 4096;
constexpr float EPS = 1e-6f, LOG2E = 1.4426950408889634f;
constexpr size_t O_X = 0, O_NKA = 25165824, O_NVA = 29360128, O_NKW = 33554432, O_NVW = 37748736, O_NST = 41943040;
constexpr size_t al256(size_t x) { return (x + 255) & ~(size_t)255; }
constexpr size_t WS_CTL = 0;
constexpr size_t WS_BAR = 4096;
constexpr size_t CTL_BYTES = 32768;
constexpr size_t WS_MOD = CTL_BYTES;
constexpr size_t WS_LB = WS_MOD + al256((size_t)DEPTH * 9 * NMODW * 4);
constexpr size_t WS_ROPE = WS_LB + 16384;
constexpr size_t WSZ = (size_t)(2 * 5632 * 1024 + 2 * 1024 * 2816 + 7168 * 1024 + 3 * 1024 * 512 + 1024 * 1024) * 2;
constexpr size_t WS_W = WS_ROPE + 8192;
constexpr size_t W_FI = 0;
constexpr size_t W_FO = W_FI + (size_t)2 * 5632 * 1024 * 2;
constexpr size_t W_IN = W_FO + (size_t)2 * 1024 * 2816 * 2;
constexpr size_t W_BR = W_IN + (size_t)7168 * 1024 * 2;
constexpr size_t W_OUT = W_BR + (size_t)3 * 1024 * 512 * 2;
constexpr size_t WS_HB = WS_W + 2 * WSZ;
constexpr size_t WS_PROJ = WS_HB + (size_t)T * 1024 * 2;
constexpr size_t WS_OATT = WS_PROJ + (size_t)T * INW * 2;
constexpr size_t WS_OHG = WS_OATT + (size_t)T * 512 * 2;
constexpr size_t WS_OWIN = WS_OHG + (size_t)T * 512 * 2;
constexpr size_t WS_OF = WS_OWIN + (size_t)T * 512 * 2;
constexpr size_t WS_KAL = WS_OF + (size_t)2 * T * 512 * 4;
constexpr size_t SZ_KL = (size_t)8 * 2 * 2304 * 64 * 2, SZ_KC = (size_t)32 * 2 * 256 * 64 * 2;
constexpr size_t WS_VAL = WS_KAL + SZ_KL;
constexpr size_t WS_KWL = WS_VAL + SZ_KL;
constexpr size_t WS_VWL = WS_KWL + SZ_KL;
constexpr size_t WS_KAC = WS_VWL + SZ_KL;
constexpr size_t WS_VAC = WS_KAC + SZ_KC;
constexpr size_t WS_KWC = WS_VAC + SZ_KC;
constexpr size_t WS_VWC = WS_KWC + SZ_KC;
constexpr size_t WS_END = WS_VWC + SZ_KC;
constexpr int LDS_BYTES = 160 * 1024, LDS_MISC = 159 * 1024;
constexpr int NPH = 1 + 13 * DEPTH + 1;

struct Args { const float* in[22]; float* out; unsigned char* ws; int ph_lo, ph_hi; };

namespace pg8 {
#define PG8_LAS __attribute__((address_space(3)))
typedef unsigned short bf16_t;
typedef short bf16x8 __attribute__((ext_vector_type(8)));
typedef float f32x4 __attribute__((ext_vector_type(4)));
typedef unsigned u32x4 __attribute__((ext_vector_type(4)));
constexpr int BM = 256, BK = 64, HALF = 128, HTB = HALF * BK * 2  , STAGE_BYTES = 8 * HTB, NXCD = 8, WGM = 8;

__host__ __device__ __forceinline__ int lds_byte(int r, int c) { const int st = (r >> 4) * 2 + (c >> 5), rr = r & 15, cc = c & 31, ob = rr * 64 + cc * 2; return st * 1024 + (ob ^ (((ob >> 9) & 1) << 5)); }
__host__ __device__ __forceinline__ void stage_rc(int b, int& R, int& C) { const int st = b / 1024, sb = b % 1024, swz = sb ^ (((sb >> 9) & 1) << 5); R = (st >> 1) * 16 + swz / 64; C = (st & 1) * 32 + (swz % 64) / 2; }
__host__ __device__ __forceinline__ int perm32(int rho) { const int n = rho >> 4, i = rho & 15; return 8 * (i >> 2) + 4 * n + (i & 3); }

struct Unit { int pm, pn; };
struct Gemm { const bf16_t* A; const bf16_t* Bt; int M, N, K; };

struct StaticOrder {
    int nM, nN, nwg, G, c;
    __host__ __device__ void init(int M, int N, int G_, int c_) { nM = M / BM; nN = N / BM; nwg = nM * nN; G = G_; c = c_; }
    __host__ __device__ bool next(int i, Unit& u) const {
        const long L = (long)i * G + c; if (L >= nwg) return false;
        int wgid = (int)L; { const int q = nwg / NXCD, r = nwg % NXCD, xcd = wgid % NXCD, off = wgid / NXCD; wgid = (xcd < r ? xcd * (q + 1) : r * (q + 1) + (xcd - r) * q) + off; }
        const int nig = WGM * nN, gid = wgid / nig, fm = gid * WGM, gsz = (nM - fm) < WGM ? (nM - fm) : WGM;
        u.pm = fm + ((wgid % nig) % gsz); u.pn = (wgid % nig) / gsz; return true;
    }
    __device__ __forceinline__ void a_ready(const Unit&) const {}
    __device__ __forceinline__ void done(const Unit&) const {}
};
struct EpiBf16P {
    static constexpr bool PERM = true, AFTER_DRAIN = false;
    bf16_t* O; int ldc;
    __device__ __forceinline__ void operator()(const f32x4 (&acc)[2][2][4][2], const Unit& u, int wr, int wc, int fr, int fq) const {
        const int row0 = u.pm * BM + wr * 64 + fr, col0 = u.pn * BM + wc * 32 + 8 * fq;
#pragma unroll
        for (int ai = 0; ai < 2; ++ai)
#pragma unroll
            for (int m = 0; m < 4; ++m) { bf16_t* rowp = O + (size_t)(row0 + ai * HALF + m * 16) * ldc + col0;
#pragma unroll
                for (int bj = 0; bj < 2; ++bj) { const f32x4 v0 = acc[ai][bj][m][0], v1 = acc[ai][bj][m][1];
                    u32x4 w; w.x = pk2(v0[0], v0[1]); w.y = pk2(v0[2], v0[3]); w.z = pk2(v1[0], v1[1]); w.w = pk2(v1[2], v1[3]);
                    *(u32x4*)(rowp + bj * HALF) = w; } }
    }
};
struct EpiSwiglu {
    static constexpr bool PERM = true, AFTER_DRAIN = false;
    bf16_t* O;
    __device__ __forceinline__ void operator()(const f32x4 (&acc)[2][2][4][2], const Unit& u, int wr, int wc, int fr, int fq) const {
        const int row0 = u.pm * BM + wr * 64 + fr, col0 = u.pn * HALF + wc * 32 + 8 * fq;
#pragma unroll
        for (int ai = 0; ai < 2; ++ai)
#pragma unroll
            for (int m = 0; m < 4; ++m) { bf16_t* rowp = O + (size_t)(row0 + ai * HALF + m * 16) * DFF + col0;
                float r[8];
#pragma unroll
                for (int n = 0; n < 2; ++n)
#pragma unroll
                    for (int j = 0; j < 4; ++j) { const float g = acc[ai][0][m][n][j], up = acc[ai][1][m][n][j]; r[4 * n + j] = g * __builtin_amdgcn_rcpf(1.f + __expf(-g)) * up; }
                u32x4 w; w.x = pk2(r[0], r[1]); w.y = pk2(r[2], r[3]); w.z = pk2(r[4], r[5]); w.w = pk2(r[6], r[7]);
                *(u32x4*)rowp = w; }
    }
};
struct EpiResid {
    static constexpr bool PERM = false, AFTER_DRAIN = false;
    const float* xa; const float* xb; float* out; const float* mod; float coef;
    __device__ __forceinline__ void operator()(const f32x4 (&acc)[2][2][4][2], const Unit& u, int wr, int wc, int fr, int fq) const {
        const int row0 = u.pm * BM + wr * 64 + fr, col0 = u.pn * BM + wc * 32 + 4 * fq;
        const int trow = u.pm * BM; const int cond = trow < TC ? 8 : ((trow - TC) >> 11);
        const float* bbase = trow < TC ? xa + (size_t)row0 * DM : xb + (size_t)(row0 - TC) * DM; const float* mp = mod + (size_t)cond * NMODW;
        f32x4 g[2][2];
#pragma unroll
        for (int bj = 0; bj < 2; ++bj)
#pragma unroll
            for (int n = 0; n < 2; ++n) g[bj][n] = coef * *(const f32x4*)(mp + col0 + bj * HALF + n * 16);
#pragma unroll
        for (int ai = 0; ai < 2; ++ai) {
            f32x4 bv[4][2][2];
#pragma unroll
            for (int m = 0; m < 4; ++m)
#pragma unroll
                for (int bj = 0; bj < 2; ++bj)
#pragma unroll
                    for (int n = 0; n < 2; ++n) bv[m][bj][n] = *(const f32x4*)(bbase + (size_t)(ai * HALF + m * 16) * DM + col0 + bj * HALF + n * 16);
#pragma unroll
            for (int m = 0; m < 4; ++m) { float* op = out + (size_t)(row0 + ai * HALF + m * 16) * DM + col0;
#pragma unroll
                for (int bj = 0; bj < 2; ++bj)
#pragma unroll
                    for (int n = 0; n < 2; ++n) *(f32x4*)(op + bj * HALF + n * 16) = bv[m][bj][n] + g[bj][n] * acc[ai][bj][m][n]; }
        }
    }
};
struct EpiBranch {
    static constexpr bool PERM = true, AFTER_DRAIN = false;
    const bf16_t* gate; float* acc32; bf16_t* outbf; int mode;
    __device__ __forceinline__ void operator()(const f32x4 (&acc)[2][2][4][2], const Unit& u, int wr, int wc, int fr, int fq) const {
        const int row0 = u.pm * BM + wr * 64 + fr, col0 = u.pn * BM + wc * 32 + 8 * fq;
#pragma unroll
        for (int ai = 0; ai < 2; ++ai) {
            u32x4 gv[4][2], pv[4][2];
#pragma unroll
            for (int m = 0; m < 4; ++m)
#pragma unroll
                for (int bj = 0; bj < 2; ++bj) { const int row = row0 + ai * HALF + m * 16, c = col0 + bj * HALF;
                    gv[m][bj] = *(const u32x4*)(gate + (size_t)row * INW + c);
                    if (mode != 0) pv[m][bj] = *(const u32x4*)(outbf + (size_t)row * DM + c); else pv[m][bj] = (u32x4){0u, 0u, 0u, 0u}; }
#pragma unroll
            for (int m = 0; m < 4; ++m)
#pragma unroll
                for (int bj = 0; bj < 2; ++bj) { const int row = row0 + ai * HALF + m * 16, c = col0 + bj * HALF;
                    const u32x4 g = gv[m][bj], p = pv[m][bj];
                    float v[8];
                    v[0] = sigmoidf_(bflo(g.x)) * acc[ai][bj][m][0][0] + bflo(p.x); v[1] = sigmoidf_(bfhi(g.x)) * acc[ai][bj][m][0][1] + bfhi(p.x);
                    v[2] = sigmoidf_(bflo(g.y)) * acc[ai][bj][m][0][2] + bflo(p.y); v[3] = sigmoidf_(bfhi(g.y)) * acc[ai][bj][m][0][3] + bfhi(p.y);
                    v[4] = sigmoidf_(bflo(g.z)) * acc[ai][bj][m][1][0] + bflo(p.z); v[5] = sigmoidf_(bfhi(g.z)) * acc[ai][bj][m][1][1] + bfhi(p.z);
                    v[6] = sigmoidf_(bflo(g.w)) * acc[ai][bj][m][1][2] + bflo(p.w); v[7] = sigmoidf_(bfhi(g.w)) * acc[ai][bj][m][1][3] + bfhi(p.w);
                    u32x4 w; w.x = pk2(v[0], v[1]); w.y = pk2(v[2], v[3]); w.z = pk2(v[4], v[5]); w.w = pk2(v[6], v[7]);
                    *(u32x4*)(outbf + (size_t)row * DM + c) = w; }
        }
    }
};

template <class Epi, class Sched, bool STAMP = false>
__device__ __forceinline__ void gemm_phase(PG8_LAS unsigned char* lds, const Gemm g, const Sched& S, const Epi& E, unsigned long long* stamps) {
    const int tid = otid(), wid = __builtin_amdgcn_readfirstlane(tid >> 6), lane = tid & 63, wr = wid >> 2, wc = wid & 3, fr = lane & 15, fq = lane >> 4;
    const int K = g.K, nt = K / BK;
    int ts_lo = 0, ts_hi = 0, nts = 0; const unsigned long long rt_entry = STAMP ? (unsigned long long)wall_clock64() : 0ull;
#define PG8_STAMP() do { if (STAMP && wid == 0 && nts < 64) { const unsigned long long _c = (unsigned long long)clock64(); \
        ts_lo = (lane == nts) ? (int)(unsigned)_c : ts_lo; ts_hi = (lane == nts) ? (int)(unsigned)(_c >> 32) : ts_hi; ++nts; } } while (0)
    PG8_STAMP();
    unsigned voffA[2], voffB[2];
#pragma unroll
    for (int i = 0; i < 2; ++i) { int R, C; stage_rc(tid * 16 + i * 8192, R, C); const int Rb = Epi::PERM ? ((R & ~31) + perm32(R & 31)) : R;
        voffA[i] = (unsigned)(R * K + C) * 2u; voffB[i] = (unsigned)(Rb * K + C) * 2u; }
    const size_t kstep = (size_t)(BK * 2);
    const size_t hstep = (size_t)HALF * K * 2;
    const size_t tstep = 2 * hstep;
    const unsigned ldsw = (unsigned)wid * 1024u;
    const int aoff = lds_byte(wr * 64 + fr, fq * 8), boff = lds_byte(wc * 32 + fr, fq * 8);
#define PG8_SA(b, h) (((b) * 2 + (h)) * HTB)
#define PG8_SB(b, h) ((4 + (b) * 2 + (h)) * HTB)
#define PG8_STAGE(bufoff, gbase, voff) do { _Pragma("unroll") for (int _i = 0; _i < 2; ++_i) \
        __builtin_amdgcn_global_load_lds((const unsigned*)((const char*)(gbase) + (voff)[_i]), (PG8_LAS unsigned*)(lds + (bufoff) + ldsw + _i * 8192), 16, 0, 0); } while (0)
#define PG8_LDA(dst, b, h) do { _Pragma("unroll") for (int m = 0; m < 4; ++m) _Pragma("unroll") for (int k = 0; k < 2; ++k) dst[m][k] = *(const PG8_LAS bf16x8*)(lds + PG8_SA(b, h) + aoff + m * 2048 + k * 1024); } while (0)
#define PG8_LDB(dst, b, h) do { _Pragma("unroll") for (int n = 0; n < 2; ++n) _Pragma("unroll") for (int k = 0; k < 2; ++k) dst[n][k] = *(const PG8_LAS bf16x8*)(lds + PG8_SB(b, h) + boff + n * 2048 + k * 1024); } while (0)
#define PG8_MMA(ai, bj, At, Bt) do { __builtin_amdgcn_s_setprio(1); _Pragma("unroll") for (int m = 0; m < 4; ++m) _Pragma("unroll") for (int n = 0; n < 2; ++n) _Pragma("unroll") for (int k = 0; k < 2; ++k) \
        acc[ai][bj][m][n] = __builtin_amdgcn_mfma_f32_16x16x32_bf16(Bt[n][k], At[m][k], acc[ai][bj][m][n], 0, 0, 0); __builtin_amdgcn_s_setprio(0); } while (0)
#define PG8_WAIT_V(n) asm volatile("s_waitcnt vmcnt(" #n ")" ::: "memory")
#define PG8_WAIT_L(n) asm volatile("s_waitcnt lgkmcnt(" #n ")" ::: "memory")
#define PG8_BAR __builtin_amdgcn_s_barrier()
#define PG8_SCHED __builtin_amdgcn_sched_barrier(0)
    Unit cur, nxt; int ui = 0;
    if (!S.next(0, cur)) return;
    f32x4 acc[2][2][4][2];
#pragma unroll
    for (int a = 0; a < 2; ++a)
#pragma unroll
        for (int b = 0; b < 2; ++b)
#pragma unroll
            for (int m = 0; m < 4; ++m)
#pragma unroll
                for (int n = 0; n < 2; ++n) acc[a][b][m][n] = (f32x4){0.f, 0.f, 0.f, 0.f};
    bf16x8 At[4][2], B0[2][2], B1[2][2];
    const char* cA = (const char*)g.A + (size_t)cur.pm * tstep; const char* cB = (const char*)g.Bt + (size_t)cur.pn * tstep;
    S.a_ready(cur);
    PG8_STAGE(PG8_SB(0, 0), cB, voffB); PG8_STAGE(PG8_SA(0, 0), cA, voffA); PG8_STAGE(PG8_SB(0, 1), cB + hstep, voffB); PG8_STAGE(PG8_SA(0, 1), cA + hstep, voffA);
    if (wr == 1) PG8_BAR;
    PG8_WAIT_V(4); PG8_BAR;
    PG8_STAGE(PG8_SB(1, 0), cB + kstep, voffB); PG8_STAGE(PG8_SA(1, 0), cA + kstep, voffA); PG8_STAGE(PG8_SB(1, 1), cB + hstep + kstep, voffB);
    PG8_WAIT_V(6); PG8_BAR;
    PG8_STAMP();
    for (;;) {
        const bool has_next = S.next(ui + 1, nxt);
        const char* nA = has_next ? (const char*)g.A + (size_t)nxt.pm * tstep : cA; const char* nB = has_next ? (const char*)g.Bt + (size_t)nxt.pn * tstep : cB;
        for (int t = 0; t < nt; t += 2) {
            const bool last = (t == nt - 2);
            const char* a1 = cA + (size_t)(t + 1) * kstep;
            const char* a2 = last ? nA : cA + (size_t)(t + 2) * kstep; const char* b2 = last ? nB : cB + (size_t)(t + 2) * kstep;
            const char* a3 = a2 + kstep; const char* b3 = b2 + kstep;
            if (last && has_next) S.a_ready(nxt);
            PG8_LDB(B0, 0, 0); PG8_SCHED; PG8_LDA(At, 0, 0); PG8_STAGE(PG8_SA(1, 1), a1 + hstep, voffA);
            PG8_WAIT_L(8); PG8_BAR; PG8_WAIT_L(0); PG8_MMA(0, 0, At, B0); PG8_BAR; PG8_SCHED;
            PG8_LDB(B1, 0, 1); PG8_STAGE(PG8_SB(0, 0), b2, voffB);
            PG8_BAR; PG8_WAIT_L(0); PG8_MMA(0, 1, At, B1); PG8_BAR;
            PG8_LDA(At, 0, 1); PG8_STAGE(PG8_SA(0, 0), a2, voffA);
            PG8_BAR; PG8_WAIT_L(0); PG8_MMA(1, 0, At, B0); PG8_BAR; PG8_SCHED;
            PG8_STAGE(PG8_SB(0, 1), b2 + hstep, voffB);
            PG8_WAIT_V(6); PG8_BAR; PG8_MMA(1, 1, At, B1); PG8_BAR;
            PG8_LDB(B0, 1, 0); PG8_SCHED; PG8_LDA(At, 1, 0); PG8_STAGE(PG8_SA(0, 1), a2 + hstep, voffA);
            PG8_WAIT_L(8); PG8_BAR; PG8_WAIT_L(0); PG8_MMA(0, 0, At, B0); PG8_BAR; PG8_SCHED;
            PG8_LDB(B1, 1, 1); PG8_STAGE(PG8_SB(1, 0), b3, voffB);
            PG8_BAR; PG8_WAIT_L(0); PG8_MMA(0, 1, At, B1); PG8_BAR;
            PG8_LDA(At, 1, 1); PG8_STAGE(PG8_SA(1, 0), a3, voffA);
            PG8_BAR; PG8_WAIT_L(0); PG8_MMA(1, 0, At, B0); PG8_BAR; PG8_SCHED;
            PG8_STAGE(PG8_SB(1, 1), b3 + hstep, voffB);
            PG8_WAIT_V(6); PG8_BAR; PG8_MMA(1, 1, At, B1); PG8_BAR;
        }
        PG8_STAMP();
        if constexpr (!Epi::AFTER_DRAIN) { E(acc, cur, wr, wc, fr, fq); S.done(cur); }
        PG8_STAMP();
        if (!has_next) break;
#pragma unroll
        for (int a = 0; a < 2; ++a)
#pragma unroll
            for (int b = 0; b < 2; ++b)
#pragma unroll
                for (int m = 0; m < 4; ++m)
#pragma unroll
                    for (int n = 0; n < 2; ++n) acc[a][b][m][n] = (f32x4){0.f, 0.f, 0.f, 0.f};
        cur = nxt; cA = nA; cB = nB; ++ui;
    }
    PG8_WAIT_V(0);
    if (wr == 0) PG8_BAR;
    PG8_BAR;
    if constexpr (Epi::AFTER_DRAIN) { E.fused(acc, cur, wr, wc, fr, fq, lds, wid, lane); S.done(cur); }
    PG8_STAMP();
    if (STAMP && wid == 0) { stamps[lane] = lane < nts ? (((unsigned long long)(unsigned)ts_hi << 32) | (unsigned)ts_lo) : 0ull;
        if (lane == 62) stamps[62] = rt_entry; if (lane == 63) stamps[63] = (unsigned long long)wall_clock64(); }
#undef PG8_STAMP
#undef PG8_SA
#undef PG8_SB
#undef PG8_STAGE
#undef PG8_LDA
#undef PG8_LDB
#undef PG8_MMA
#undef PG8_WAIT_V
#undef PG8_WAIT_L
#undef PG8_BAR
#undef PG8_SCHED
}
}
DI int crow(int i, int h) { return (i & 3) + 8 * (i >> 2) + 4 * h; }
#define LDS_WAIT() asm volatile("s_waitcnt lgkmcnt(0)" ::: "memory")


DI void phase_p0(const Args& a, unsigned char* lds) {
    float* s = (float*)lds; float* red = (float*)(lds + 36864);
    const int tid = otid(), lane = tid & 63, w = tid >> 6;
    float* MOD = (float*)(a.ws + WS_MOD);
    if ((int)blockIdx.x < 144) {
        const float* c = a.in[7]; const float* cctx = a.in[8];
        for (int i = tid; i < 9 * 1024; i += 512) { const int ci = i >> 10, k = i & 1023; const float v = ci < 8 ? c[ci * 1024 + k] : cctx[k]; s[i] = v * sigmoidf_(v); }
        __syncthreads();
        for (int item = blockIdx.x; item < 144; item += gridDim.x) {
            const int l = item / 36, cc = item % 36;
            const float* W = a.in[9] + (size_t)l * 1024 * NMODW + cc * 256 + 4 * lane;
            f32x4 acc[9];
#pragma unroll
            for (int ci = 0; ci < 9; ++ci) acc[ci] = (f32x4){0.f, 0.f, 0.f, 0.f};
#pragma unroll 2
            for (int k4 = 0; k4 < 32; ++k4) {
                const int k = w * 128 + k4 * 4;
                const f32x4 w0 = *(const f32x4*)(W + (size_t)(k + 0) * NMODW), w1 = *(const f32x4*)(W + (size_t)(k + 1) * NMODW),
                            w2 = *(const f32x4*)(W + (size_t)(k + 2) * NMODW), w3 = *(const f32x4*)(W + (size_t)(k + 3) * NMODW);
#pragma unroll
                for (int ci = 0; ci < 9; ++ci) { const f32x4 sv = *(const f32x4*)(s + ci * 1024 + k); acc[ci] += sv[0] * w0 + sv[1] * w1 + sv[2] * w2 + sv[3] * w3; }
            }
#pragma unroll
            for (int ci = 0; ci < 9; ++ci) *(f32x4*)(red + ((w * 9 + ci) * 256 + 4 * lane)) = acc[ci];
            __syncthreads();
            for (int i = tid; i < 9 * 256; i += 512) { const int ci = i >> 8, col = i & 255; float v = 0.f;
#pragma unroll
                for (int ww = 0; ww < 8; ++ww) v += red[(ww * 9 + ci) * 256 + col];
                v += a.in[10][l * NMODW + cc * 256 + col];
                MOD[((size_t)l * 9 + ci) * NMODW + cc * 256 + col] = v; }
            __syncthreads();
        }
    }
    if (blockIdx.x == gridDim.x - 1) {
        float* LB = (float*)(a.ws + WS_LB); const float* lbin = a.in[16];
        for (int e = tid; e < 1024; e += 512) {
            const float x0 = lbin[e], x1 = lbin[1024 + e], x2 = lbin[2048 + e], x3 = lbin[3072 + e];
            const float mx = fmaxf(fmaxf(x0, x1), fmaxf(x2, x3));
            const float e0 = __expf(x0 - mx), e1 = __expf(x1 - mx), e2 = __expf(x2 - mx), e3 = __expf(x3 - mx); const float inv = 1.f / (e0 + e1 + e2 + e3);
            LB[e] = 0.f; LB[1024 + e] = e1 * inv; LB[2048 + e] = (e1 + e2) * inv; LB[3072 + e] = (e1 + e2 + e3) * inv;
        }
        float* cosT = (float*)(a.ws + WS_ROPE); float* sinT = cosT + 1024;
        for (int e = tid; e < 1024; e += 512) { const int pos = e >> 4, i = e & 15; const float inv = exp2f(-(float)i * (13.287712379549449f / 16.f)); const float ang = (float)pos * inv;
            cosT[e] = cosf(ang); sinT[e] = sinf(ang); }
    }
}

DI void transpose_item(const float* W, int ldw, int srccol0, int k0, bf16_t* WT, int K, int dstrow0, float* scr, int lane) {
#pragma unroll 8
    for (int i = 0; i < 32; ++i) { const int kk = 2 * i + (lane >> 5); scr[kk * 33 + (lane & 31)] = W[(size_t)(k0 + kk) * ldw + srccol0 + (lane & 31)]; }
    LDS_WAIT();
    const int c = lane & 7;
#pragma unroll
    for (int j = 0; j < 4; ++j) { const int n = (lane >> 3) + 8 * j; const float* sp = scr + (8 * c) * 33 + n;
        u32x4 o; o.x = pk2(sp[0 * 33], sp[1 * 33]); o.y = pk2(sp[2 * 33], sp[3 * 33]); o.z = pk2(sp[4 * 33], sp[5 * 33]); o.w = pk2(sp[6 * 33], sp[7 * 33]);
        *(u32x4*)(WT + (size_t)(dstrow0 + n) * K + k0 + 8 * c) = o; }
    LDS_WAIT();
}
DI void phase_wconv(const Args& a, unsigned char* lds, int l, int it0, int it1, int rank, int nrank) {
    const int tid = otid(), lane = tid & 63, w = tid >> 6;
    float* scr = (float*)(lds + w * 8448);
    unsigned char* wb = a.ws + WS_W + (size_t)(l & 1) * WSZ;
    for (int it = it0 + rank * 8 + w; it < it1; it += nrank * 8) {
        int r = it;
        if (r < 5632) { const int j = r / 2816; r -= j * 2816; const int kb = r / 176, nb = r % 176, n0 = 32 * nb, pn = n0 >> 8, loc = n0 & 255;
            const int src = (loc >> 7) * DFF + 128 * pn + (loc & 127);
            transpose_item(a.in[12] + (size_t)(l * 2 + j) * 1024 * 5632, 5632, src, 64 * kb, (bf16_t*)(wb + W_FI) + (size_t)j * 5632 * 1024, 1024, n0, scr, lane); continue; }
        r -= 5632;
        if (r < 2816) { const int j = r / 1408; r -= j * 1408; const int kb = r / 32, nb = r % 32;
            transpose_item(a.in[13] + (size_t)(l * 2 + j) * DFF * 1024, 1024, 32 * nb, 64 * kb, (bf16_t*)(wb + W_FO) + (size_t)j * 1024 * DFF, DFF, 32 * nb, scr, lane); continue; }
        r -= 2816;
        if (r < 3584) { const int kb = r / 224, nb = r % 224;
            transpose_item(a.in[14] + (size_t)l * 1024 * INW, INW, 32 * nb, 64 * kb, (bf16_t*)(wb + W_IN), 1024, 32 * nb, scr, lane); continue; }
        r -= 3584;
        if (r < 768) { const int k = r / 256; r -= k * 256; const int kb = r / 32, nb = r % 32;
            transpose_item(a.in[19] + (size_t)(l * 3 + k) * 512 * 1024, 1024, 32 * nb, 64 * kb, (bf16_t*)(wb + W_BR) + (size_t)k * 1024 * 512, 512, 32 * nb, scr, lane); continue; }
        r -= 768;
        { const int kb = r / 32, nb = r % 32;
            transpose_item(a.in[20] + (size_t)l * 1024 * 1024, 1024, 32 * nb, 64 * kb, (bf16_t*)(wb + W_OUT), 1024, 32 * nb, scr, lane); }
    }
}

DI void phase_norm(const Args& a, int l, int j, bool first) {
    const int tid = otid(), lane = tid & 63, w = tid >> 6;
    const int gw = obid() * 8 + w, NGW = gridDim.x * 8;
    const float* g = a.in[11] + (size_t)(l * 3 + j) * DM; const float* MOD = (const float*)(a.ws + WS_MOD) + (size_t)l * 9 * NMODW;
    bf16_t* HB = (bf16_t*)(a.ws + WS_HB);
    f32x4 gg[4];
#pragma unroll
    for (int jj = 0; jj < 4; ++jj) gg[jj] = *(const f32x4*)(g + 4 * lane + 256 * jj);
    for (int row = gw; row < T; row += NGW) {
        const float* xr = first ? (row < TC ? a.in[0] + (size_t)row * DM : a.in[1] + (size_t)(row - TC) * DM) : a.out + (size_t)row * DM;
        const int cond = row < TC ? 8 : ((row - TC) >> 11);
        const float* shift = MOD + (size_t)cond * NMODW + 3 * j * DM; const float* scale = shift + DM;
        f32x4 v[4]; float ss = 0.f;
#pragma unroll
        for (int jj = 0; jj < 4; ++jj) { v[jj] = *(const f32x4*)(xr + 4 * lane + 256 * jj); ss += (v[jj][0] * v[jj][0] + v[jj][1] * v[jj][1]) + (v[jj][2] * v[jj][2] + v[jj][3] * v[jj][3]); }
        const float rstd = rsqrtf(wave_sum(ss) * (1.f / DM) + EPS);
#pragma unroll
        for (int jj = 0; jj < 4; ++jj) { const f32x4 sc = *(const f32x4*)(scale + 4 * lane + 256 * jj), sh = *(const f32x4*)(shift + 4 * lane + 256 * jj);
            const f32x4 y = v[jj] * rstd * gg[jj] * (1.f + sc) + sh;
            u32x2 o; o.x = pk2(y[0], y[1]); o.y = pk2(y[2], y[3]);
            *(u32x2*)(HB + (size_t)row * DM + 4 * lane + 256 * jj) = o; }
    }
}
DI void phase_final(const Args& a) {
    const int tid = otid(), lane = tid & 63, w = tid >> 6;
    const int gw = obid() * 8 + w, NGW = gridDim.x * 8;
    const float* g = a.in[21];
    f32x4 gg[4];
#pragma unroll
    for (int jj = 0; jj < 4; ++jj) gg[jj] = *(const f32x4*)(g + 4 * lane + 256 * jj);
    for (int row = gw; row < T; row += NGW) {
        float* xr = a.out + (size_t)row * DM;
        f32x4 v[4]; float ss = 0.f;
#pragma unroll
        for (int jj = 0; jj < 4; ++jj) { v[jj] = *(const f32x4*)(xr + 4 * lane + 256 * jj); ss += (v[jj][0] * v[jj][0] + v[jj][1] * v[jj][1]) + (v[jj][2] * v[jj][2] + v[jj][3] * v[jj][3]); }
        const float rstd = rsqrtf(wave_sum(ss) * (1.f / DM) + EPS);
#pragma unroll
        for (int jj = 0; jj < 4; ++jj) *(f32x4*)(xr + 4 * lane + 256 * jj) = v[jj] * rstd * gg[jj];
    }
}

DI void phase_prep(const Args& a, int l) {
    const int tid = otid(), lane = tid & 63, w = tid >> 6;
    const int gw = obid() * 8 + w, NGW = gridDim.x * 8;
    bf16_t* PROJ = (bf16_t*)(a.ws + WS_PROJ);
    const float* cosT = (const float*)(a.ws + WS_ROPE); const float* sinT = cosT + 1024;
    const float qg = a.in[15][(l * 2 + 0) * 64 + lane], kg = a.in[15][(l * 2 + 1) * 64 + lane];
    bf16_t* KAL = (bf16_t*)(a.ws + WS_KAL); bf16_t* VAL = (bf16_t*)(a.ws + WS_VAL); bf16_t* KWL = (bf16_t*)(a.ws + WS_KWL); bf16_t* VWL = (bf16_t*)(a.ws + WS_VWL);
    bf16_t* KAC = (bf16_t*)(a.ws + WS_KAC); bf16_t* VAC = (bf16_t*)(a.ws + WS_VAC); bf16_t* KWC = (bf16_t*)(a.ws + WS_KWC); bf16_t* VWC = (bf16_t*)(a.ws + WS_VWC);
    for (int r = gw; r < T + 2048; r += NGW) {
        if (r < T) {
            const bool lat = r >= TC; int b, t;
            if (lat) { b = (r - TC) >> 11; t = (r - TC) & 2047; } else { b = r >> 8; t = r & 255; }
            float cs = 1.f, sn = 0.f;
            if (lat) { const int pos = (lane & 32) ? (t & 63) : (t >> 6); cs = cosT[pos * 16 + (lane & 15)]; sn = sinT[pos * 16 + (lane & 15)]; if (!(lane & 16)) sn = -sn; }
            bf16_t* pr = PROJ + (size_t)r * INW;
            bf16_t raw[24];
#pragma unroll
            for (int hh = 0; hh < 24; ++hh) raw[hh] = pr[64 * hh + lane];
#pragma unroll
            for (int h = 0; h < 8; ++h) {
                const float x = bf2f(raw[h]); const float ss = wave_sum(x * x);
                float y = x * rsqrtf(ss * (1.f / 64.f) + EPS) * qg;
                if (lat) { const float p = __shfl_xor(y, 16); y = y * cs + p * sn; }
                pr[C_AQ + 64 * h + lane] = f2bf(y * (0.125f * LOG2E));
            }
#pragma unroll
            for (int h = 0; h < 8; ++h) {
                float y = bf2f(raw[12 + h]);
                if (lat) { const float p = __shfl_xor(y, 16); y = y * cs + p * sn; }
                pr[C_WQ + 64 * h + lane] = f2bf(y * (0.125f * LOG2E));
            }
#pragma unroll
            for (int g2 = 0; g2 < 2; ++g2) {
                const float x = bf2f(raw[8 + g2]); const float ss = wave_sum(x * x);
                float y = x * rsqrtf(ss * (1.f / 64.f) + EPS) * kg;
                if (lat) { const float p = __shfl_xor(y, 16); y = y * cs + p * sn; }
                const bf16_t vbits = raw[10 + g2];
                float yw = bf2f(raw[20 + g2]);
                if (lat) { const float p = __shfl_xor(yw, 16); yw = yw * cs + p * sn; }
                const bf16_t wvbits = raw[22 + g2];
                if (lat) {
                    KAL[((size_t)(b * 2 + g2) * 2304 + 256 + t) * 64 + lane] = f2bf(y);
                    VAL[((size_t)(b * 2 + g2) * 64 + lane) * 2304 + 256 + t] = vbits;
                    KWL[((size_t)(b * 2 + g2) * 2304 + 256 + t) * 64 + lane] = f2bf(yw);
                    VWL[((size_t)(b * 2 + g2) * 64 + lane) * 2304 + 256 + t] = wvbits;
                } else {
                    KAC[((size_t)(b * 2 + g2) * 256 + t) * 64 + lane] = f2bf(y);
                    VAC[((size_t)(b * 2 + g2) * 64 + lane) * 256 + t] = vbits;
                    KWC[((size_t)(b * 2 + g2) * 256 + t) * 64 + lane] = f2bf(yw);
                    VWC[((size_t)(b * 2 + g2) * 64 + lane) * 256 + t] = wvbits;
                    const size_t oi = ((((size_t)b * DEPTH + l) * 256 + t) * 2 + g2) * 64 + lane;
                    a.out[O_NKA + oi] = y; a.out[O_NVA + oi] = bf2f(vbits); a.out[O_NKW + oi] = yw; a.out[O_NVW + oi] = bf2f(wvbits);
                }
            }
        } else {
            const int idx = r - T, b = idx >> 8, p = idx & 255;
#pragma unroll
            for (int g2 = 0; g2 < 2; ++g2) {
                const size_t ci = ((((size_t)b * DEPTH + l) * 256 + p) * 2 + g2) * 64 + lane;
                KAL[((size_t)(b * 2 + g2) * 2304 + p) * 64 + lane] = f2bf(a.in[2][ci]);
                VAL[((size_t)(b * 2 + g2) * 64 + lane) * 2304 + p] = f2bf(a.in[3][ci]);
                KWL[((size_t)(b * 2 + g2) * 2304 + p) * 64 + lane] = f2bf(a.in[4][ci]);
                VWL[((size_t)(b * 2 + g2) * 64 + lane) * 2304 + p] = f2bf(a.in[5][ci]);
            }
        }
    }
}

DI void attn_item(unsigned char* lds, const bf16_t* qp, bf16_t* op, const bf16_t* Kb, const bf16_t* VTb, int nk, int nA, int lo, int hi, bool win, int tq, bool has_sink, float sink2) {
    const int tid = otid(), lane = tid & 63, h = lane >> 5, c = lane & 31;
    const int ntile = nA + (hi - lo);
    bf16_t* Kst0 = (bf16_t*)lds; bf16_t* Vst0 = (bf16_t*)(lds + 9216);
    bf16x8 qf[4];
#pragma unroll
    for (int s = 0; s < 4; ++s) qf[s] = *(const bf16x8*)(qp + 16 * s + 8 * h);
    f32x16 O0, O1;
#pragma unroll
    for (int i = 0; i < 16; ++i) { O0[i] = 0.f; O1[i] = 0.f; }
    float m = 0.f, lsum = 0.f;
    const int lrow = tid >> 3, lch = tid & 7;
    u32x4 kreg, vreg;
    { const int k0 = (0 < nA ? 0 : 4 + lo) * 64; kreg = *(const u32x4*)(Kb + (size_t)(k0 + lrow) * 64 + 8 * lch); vreg = *(const u32x4*)(VTb + (size_t)lrow * nk + k0 + 8 * lch); }
    *(u32x4*)(Kst0 + lrow * 72 + 8 * lch) = kreg; *(u32x4*)(Vst0 + lrow * 72 + 8 * lch) = vreg;
    __syncthreads();
    for (int i = 0; i < ntile; ++i) {
        const int cur = i & 1;
        const int k0 = (i < nA ? i : 4 + lo + (i - nA)) * 64;
        if (i + 1 < ntile) { const int k1 = (i + 1 < nA ? i + 1 : 4 + lo + (i + 1 - nA)) * 64;
            kreg = *(const u32x4*)(Kb + (size_t)(k1 + lrow) * 64 + 8 * lch); vreg = *(const u32x4*)(VTb + (size_t)lrow * nk + k1 + 8 * lch); }
        const bf16_t* Kc = Kst0 + cur * 9216; const bf16_t* Vc = Vst0 + cur * 9216;
        f32x16 st0, st1;
        const float cinit = -m;
#pragma unroll
        for (int ii = 0; ii < 16; ++ii) { st0[ii] = cinit; st1[ii] = cinit; }
#pragma unroll
        for (int s = 0; s < 4; ++s) {
            const bf16x8 a0 = *(const bf16x8*)(Kc + c * 72 + 16 * s + 8 * h), a1 = *(const bf16x8*)(Kc + (32 + c) * 72 + 16 * s + 8 * h);
            st0 = MFMA32(a0, qf[s], st0); st1 = MFMA32(a1, qf[s], st1);
        }
        if (win && (i >= nA)) {
#pragma unroll
            for (int ii = 0; ii < 16; ++ii) { const int d0 = tq - (k0 - 256 + crow(ii, h)); if (d0 > 128 || d0 < -128) st0[ii] = -1e30f; const int d1 = d0 - 32; if (d1 > 128 || d1 < -128) st1[ii] = -1e30f; }
        }
        float mx = -1e30f;
#pragma unroll
        for (int ii = 0; ii < 16; ++ii) mx = fmaxf(mx, fmaxf(st0[ii], st1[ii]));
        mx = fmaxf(mx, __shfl_xor(mx, 32));
        float ps = 0.f;
        if (i == 0) {
            const float mnew = has_sink ? fmaxf(mx, sink2) : mx;
#pragma unroll
            for (int ii = 0; ii < 16; ++ii) { const float p0 = __builtin_amdgcn_exp2f(st0[ii] - mnew), p1 = __builtin_amdgcn_exp2f(st1[ii] - mnew); st0[ii] = p0; st1[ii] = p1; ps += p0 + p1; }
            lsum = ps + ((has_sink && h == 0) ? __builtin_amdgcn_exp2f(sink2 - mnew) : 0.f);
            m = mnew;
        } else if (__builtin_amdgcn_ballot_w64(mx > 0.f) != 0ull) {
            const float delta = fmaxf(mx, 0.f); const float alpha = __builtin_amdgcn_exp2f(-delta); m += delta;
#pragma unroll
            for (int ii = 0; ii < 16; ++ii) { const float p0 = __builtin_amdgcn_exp2f(st0[ii] - delta), p1 = __builtin_amdgcn_exp2f(st1[ii] - delta); st0[ii] = p0; st1[ii] = p1; ps += p0 + p1; }
            lsum = lsum * alpha + ps;
#pragma unroll
            for (int ii = 0; ii < 16; ++ii) { O0[ii] *= alpha; O1[ii] *= alpha; }
        } else {
#pragma unroll
            for (int ii = 0; ii < 16; ++ii) { const float p0 = __builtin_amdgcn_exp2f(st0[ii]), p1 = __builtin_amdgcn_exp2f(st1[ii]); st0[ii] = p0; st1[ii] = p1; ps += p0 + p1; }
            lsum += ps;
        }
#pragma unroll
        for (int s2 = 0; s2 < 2; ++s2) {
            const bf16x8 pb0 = pack8(st0[8 * s2], st0[8 * s2 + 1], st0[8 * s2 + 2], st0[8 * s2 + 3], st0[8 * s2 + 4], st0[8 * s2 + 5], st0[8 * s2 + 6], st0[8 * s2 + 7]);
            const bf16x8 pb1 = pack8(st1[8 * s2], st1[8 * s2 + 1], st1[8 * s2 + 2], st1[8 * s2 + 3], st1[8 * s2 + 4], st1[8 * s2 + 5], st1[8 * s2 + 6], st1[8 * s2 + 7]);
            {   const bf16_t* v0p = Vc + c * 72 + 16 * s2 + 4 * h; const bf16_t* v1p = Vc + (32 + c) * 72 + 16 * s2 + 4 * h;
                const bf16x8 a00 = cat44(*(const s16x4*)(v0p), *(const s16x4*)(v0p + 8)), a10 = cat44(*(const s16x4*)(v1p), *(const s16x4*)(v1p + 8));
                const bf16x8 a01 = cat44(*(const s16x4*)(v0p + 32), *(const s16x4*)(v0p + 40)), a11 = cat44(*(const s16x4*)(v1p + 32), *(const s16x4*)(v1p + 40));
                O0 = MFMA32(a00, pb0, O0); O1 = MFMA32(a10, pb0, O1); O0 = MFMA32(a01, pb1, O0); O1 = MFMA32(a11, pb1, O1); }
        }
        if (i + 1 < ntile) { *(u32x4*)(Kst0 + (cur ^ 1) * 9216 + lrow * 72 + 8 * lch) = kreg; *(u32x4*)(Vst0 + (cur ^ 1) * 9216 + lrow * 72 + 8 * lch) = vreg; }
        __syncthreads();
    }
    lsum += __shfl_xor(lsum, 32);
    const float inv = 1.f / lsum;
#pragma unroll
    for (int g4 = 0; g4 < 4; ++g4) {
        u32x2 w0, w1;
        w0.x = pk2(O0[4 * g4] * inv, O0[4 * g4 + 1] * inv); w0.y = pk2(O0[4 * g4 + 2] * inv, O0[4 * g4 + 3] * inv);
        w1.x = pk2(O1[4 * g4] * inv, O1[4 * g4 + 1] * inv); w1.y = pk2(O1[4 * g4 + 2] * inv, O1[4 * g4 + 3] * inv);
        *(u32x2*)(op + 8 * g4 + 4 * h) = w0; *(u32x2*)(op + 32 + 8 * g4 + 4 * h) = w1;
    }
}
#define LAS __attribute__((address_space(3)))
#define XB_TMO      128
#define XB_XCNT(j)  (256  + 64 * (j))
#define XB_XSUB(j)  (1280 + 64 * (j))
#define XB_XGEN(j)  (2304 + 64 * (j))
#define XB_TOP      3328
#define XB_TOPGEN   3392
#define XCD_BAR_WORDS 3456
#define XB_SPIN_CAP (1u << 18)

__device__ __forceinline__ unsigned xb_ld(unsigned* p)              { return __hip_atomic_load(p, __ATOMIC_RELAXED, __HIP_MEMORY_SCOPE_AGENT); }
__device__ __forceinline__ unsigned xb_add(unsigned* p, unsigned v) { return __hip_atomic_fetch_add(p, v, __ATOMIC_RELAXED, __HIP_MEMORY_SCOPE_AGENT); }
__device__ __forceinline__ unsigned xb_xcc_id() { return (unsigned)__builtin_amdgcn_s_getreg((3 << 11) | 20) & 0xFu; }
#define XB_SPIN(cond, bar) do { unsigned _sp = 0; while (cond) { __builtin_amdgcn_s_sleep(1); \
    if ((++_sp & 255u) == 0u) { if (xb_ld(&(bar)[XB_TMO])) break; if (_sp > XB_SPIN_CAP) { atomicAdd(&(bar)[XB_TMO], 1u); break; } } } } while (0)

struct XcdBarrier {
    unsigned* bar; unsigned x;
    volatile LAS unsigned* st;
};

__device__ __forceinline__ XcdBarrier xcd_barrier_post(unsigned* bar, volatile LAS unsigned* st) {
    XcdBarrier b; b.bar = bar; b.x = xb_xcc_id(); b.st = st;
    if (threadIdx.x == 0) (void)xb_add(&bar[XB_XCNT(b.x)], 1u);
    return b;
}
__device__ __forceinline__ void xcd_barrier_complete(unsigned* bar, unsigned x, unsigned& nloc, unsigned& nx) {
    const unsigned G = gridDim.x * gridDim.y * gridDim.z;
    unsigned sum, cnt, mine, sp = 0u;
    for (;;) {
        sum = 0u; cnt = 0u; mine = 0u;
#pragma unroll
        for (unsigned j = 0; j < 16; ++j) { const unsigned c = xb_ld(&bar[XB_XCNT(j)]); sum += c; cnt += (c > 0u) ? 1u : 0u; mine = (j == x) ? c : mine; }
        if (sum == G) break;
        __builtin_amdgcn_s_sleep(1);
        if ((++sp & 255u) == 0u) { if (xb_ld(&bar[XB_TMO])) break; if (sp > XB_SPIN_CAP) { atomicAdd(&bar[XB_TMO], 1u); break; } }
    }
    nloc = mine > 0u ? mine : 1u; nx = cnt > 0u ? cnt : 1u;
}

__device__ __forceinline__ void xcd_barrier(const XcdBarrier& b) {
    asm volatile("s_waitcnt vmcnt(0)" ::: "memory");
    __syncthreads();
    if (threadIdx.x == 0) {
        unsigned* bar = b.bar;
        __builtin_amdgcn_s_waitcnt(0);
        unsigned nloc = b.st[0], nx = b.st[1];
        if (nloc == 0u) { xcd_barrier_complete(bar, b.x, nloc, nx); b.st[0] = nloc; b.st[1] = nx; }
        const unsigned old = xb_add(&bar[XB_XSUB(b.x)], 1u);
        const unsigned gen = old / nloc;
        if (old + 1u == (gen + 1u) * nloc) {
            __builtin_amdgcn_fence(__ATOMIC_RELEASE, "agent");
            asm volatile("s_waitcnt vmcnt(0)" ::: "memory");
            const unsigned og = xb_add(&bar[XB_TOP], 1u);
            const unsigned tg = og / nx;
            if (og + 1u == (tg + 1u) * nx) xb_add(&bar[XB_TOPGEN], 1u);
            else XB_SPIN(xb_ld(&bar[XB_TOPGEN]) == tg, bar);
            __builtin_amdgcn_fence(__ATOMIC_ACQUIRE, "agent");
            xb_add(&bar[XB_XGEN(b.x)], 1u);
            asm volatile("s_waitcnt vmcnt(0)" ::: "memory");
        } else {
            XB_SPIN(xb_ld(&bar[XB_XGEN(b.x)]) == gen, bar);
            __builtin_amdgcn_fence(__ATOMIC_ACQUIRE, "agent");
            asm volatile("s_waitcnt vmcnt(0)" ::: "memory");
        }
    }
    __syncthreads();
}


DI void hgrn_item(const Args& a, unsigned char* lds, int l, int seq, int hd, int dir) {
    const int tid = otid(), lane = tid & 63, w = tid >> 6, h = lane >> 5, c = lane & 31;
    const bool lat = seq < 8; const int b = lat ? seq : seq - 8; const int L = lat ? 2048 : 256; const int nch = L >> 5; const int seqbase = lat ? TC + b * 2048 : b * 256;
    bf16_t* RQ = (bf16_t*)lds; bf16_t* RZ = (bf16_t*)(lds + 8704); bf16_t* RV = (bf16_t*)(lds + 17408);
    bf16_t* QS = (bf16_t*)(lds + 26112); bf16_t* KS = (bf16_t*)(lds + 34816);
    bf16_t* KST = (bf16_t*)(lds + 43520); bf16_t* VT = (bf16_t*)(lds + 53760); float* E0 = (float*)(lds + 64000); float* E1 = E0 + 128;
    const bf16_t* PROJ = (const bf16_t*)(a.ws + WS_PROJ);
    float* OF = (float*)(a.ws + WS_OF);
    const int cq = C_HQ + 128 * hd, cz = (dir ? C_HFB : C_HFF) + 128 * hd, cv = C_HI + 128 * hd;
    const int wd = w & 3;
    const int dmy = 32 * wd + c;
    const int t0 = 16 * (w >> 2) + 8 * h;
    f32x16 S[4];
    if (w < 4) {
        if (lat) { const float* sp = a.in[6] + ((((size_t)(b * DEPTH + l) * 2 + dir) * 4 + hd) * 128) * 128;
#pragma unroll
            for (int dt = 0; dt < 4; ++dt)
#pragma unroll
                for (int ii = 0; ii < 16; ++ii) S[dt][ii] = sp[(size_t)(32 * dt + crow(ii, h)) * 128 + dmy];
        } else {
#pragma unroll
            for (int dt = 0; dt < 4; ++dt)
#pragma unroll
                for (int ii = 0; ii < 16; ++ii) S[dt][ii] = 0.f;
        }
    }
    const float lbv = ((const float*)(a.ws + WS_LB))[(l * 2 + dir) * 512 + 128 * hd + dmy];
    const float omlb = 1.f - lbv;
    u32x4 rq, rz, rv;
    const int lt = tid >> 4, lcn = tid & 15;
#define HG_GLOAD(ch) do { const int p_ = 32 * (ch) + lt, pos_ = dir ? L - 1 - p_ : p_; const bf16_t* rp_ = PROJ + (size_t)(seqbase + pos_) * INW + 8 * lcn; \
        rq = *(const u32x4*)(rp_ + cq); rz = *(const u32x4*)(rp_ + cz); rv = *(const u32x4*)(rp_ + cv); } while (0)
    HG_GLOAD(0);
    for (int ch = 0; ch < nch; ++ch) {
        *(u32x4*)(RQ + lt * 136 + 8 * lcn) = rq; *(u32x4*)(RZ + lt * 136 + 8 * lcn) = rz; *(u32x4*)(RV + lt * 136 + 8 * lcn) = rv;
        __syncthreads();
        if (ch + 1 < nch) HG_GLOAD(ch + 1);
        {
            float qv[8], kv[8], gv[8]; float qtot = 0.f;
#pragma unroll
            for (int tt = 0; tt < 8; ++tt) { const int t = t0 + tt; const float qr = bf2f(RQ[t * 136 + dmy]), z = bf2f(RZ[t * 136 + dmy]);
                const float sg = sigmoidf_(z); const float f = lbv + omlb * sg; const float g = __logf(fmaxf(f, 1e-30f));
                kv[tt] = omlb * (1.f - sg); qv[tt] = qr * sigmoidf_(qr); gv[tt] = g; qtot += g; }
            const float partner = __shfl_xor(qtot, 32);
            float e[8];
            if (w < 4) { float run = h ? 0.f : -partner;
#pragma unroll
                for (int tt = 7; tt >= 0; --tt) { e[tt] = run; run -= gv[tt]; }
                if (h == 0) E0[dmy] = __expf(qtot + partner);
            } else { float run = h ? partner : 0.f;
#pragma unroll
                for (int tt = 0; tt < 8; ++tt) { run += gv[tt]; e[tt] = run; }
                if (h == 0) E1[dmy] = __expf(qtot + partner);
            }
            float ke[8];
#pragma unroll
            for (int tt = 0; tt < 8; ++tt) { const int t = t0 + tt; const float ex = __expf(e[tt]), exn = __builtin_amdgcn_rcpf(ex);
                ke[tt] = kv[tt] * exn;
                QS[t * 136 + dmy] = f2bf(qv[tt] * ex); KS[t * 136 + dmy] = f2bf(ke[tt]); }
            *(bf16x8*)(KST + dmy * 40 + t0) = pack8(ke[0], ke[1], ke[2], ke[3], ke[4], ke[5], ke[6], ke[7]);
            bf16x8 v0;
#pragma unroll
            for (int tt = 0; tt < 8; ++tt) v0[tt] = (short)RV[(t0 + tt) * 136 + dmy];
            *(bf16x8*)(VT + dmy * 40 + t0) = v0;
        }
        __syncthreads();
        if (w < 4) {
            f32x16 st;
#pragma unroll
            for (int ii = 0; ii < 16; ++ii) st[ii] = 0.f;
#pragma unroll
            for (int s = 0; s < 8; ++s) { const bf16x8 ak = *(const bf16x8*)(KS + c * 136 + 16 * s + 8 * h), bq = *(const bf16x8*)(QS + c * 136 + 16 * s + 8 * h); st = MFMA32(ak, bq, st); }
#pragma unroll
            for (int ii = 0; ii < 16; ++ii) if (crow(ii, h) > c) st[ii] = 0.f;
            f32x16 o;
#pragma unroll
            for (int ii = 0; ii < 16; ++ii) o[ii] = 0.f;
#pragma unroll
            for (int s2 = 0; s2 < 2; ++s2) {
                const bf16x8 pb = pack8(st[8 * s2], st[8 * s2 + 1], st[8 * s2 + 2], st[8 * s2 + 3], st[8 * s2 + 4], st[8 * s2 + 5], st[8 * s2 + 6], st[8 * s2 + 7]);
                const bf16_t* vp = VT + dmy * 40 + 16 * s2 + 4 * h;
                o = MFMA32(cat44(*(const s16x4*)vp, *(const s16x4*)(vp + 8)), pb, o);
            }
#pragma unroll
            for (int dt = 0; dt < 4; ++dt) {
#pragma unroll
                for (int g4 = 0; g4 < 4; ++g4) { const f32x4 ev = *(const f32x4*)(E0 + 32 * dt + 8 * g4 + 4 * h);
                    S[dt][4 * g4] *= ev[0]; S[dt][4 * g4 + 1] *= ev[1]; S[dt][4 * g4 + 2] *= ev[2]; S[dt][4 * g4 + 3] *= ev[3]; }
#pragma unroll
                for (int s2 = 0; s2 < 2; ++s2) {
                    const bf16x8 xs = pack8(S[dt][8 * s2], S[dt][8 * s2 + 1], S[dt][8 * s2 + 2], S[dt][8 * s2 + 3], S[dt][8 * s2 + 4], S[dt][8 * s2 + 5], S[dt][8 * s2 + 6], S[dt][8 * s2 + 7]);
                    const bf16_t* qb = QS + c * 136 + 32 * dt + 16 * s2 + 4 * h;
                    o = MFMA32(xs, cat44(*(const s16x4*)qb, *(const s16x4*)(qb + 8)), o);
                }
            }
            {   const int p = 32 * ch + c, pos = dir ? L - 1 - p : p;
                float* op = OF + ((size_t)dir * T + seqbase + pos) * 512 + 128 * hd + 32 * wd;
#pragma unroll
                for (int g4 = 0; g4 < 4; ++g4) { f32x4 v; v[0] = o[4 * g4]; v[1] = o[4 * g4 + 1]; v[2] = o[4 * g4 + 2]; v[3] = o[4 * g4 + 3]; *(f32x4*)(op + 8 * g4 + 4 * h) = v; } }
#pragma unroll
            for (int dt = 0; dt < 4; ++dt) {
#pragma unroll
                for (int s2 = 0; s2 < 2; ++s2) { const bf16x8 ak = *(const bf16x8*)(KST + (32 * dt + c) * 40 + 16 * s2 + 8 * h), bv = *(const bf16x8*)(VT + dmy * 40 + 16 * s2 + 8 * h);
                    S[dt] = MFMA32(ak, bv, S[dt]); }
#pragma unroll
                for (int g4 = 0; g4 < 4; ++g4) { const f32x4 ev = *(const f32x4*)(E1 + 32 * dt + 8 * g4 + 4 * h);
                    S[dt][4 * g4] *= ev[0]; S[dt][4 * g4 + 1] *= ev[1]; S[dt][4 * g4 + 2] *= ev[2]; S[dt][4 * g4 + 3] *= ev[3]; }
            }
        }
    }
#undef HG_GLOAD
    if (!lat && w < 4) { float* sp = a.out + O_NST + ((((size_t)(b * DEPTH + l) * 2 + dir) * 4 + hd) * 128) * 128;
#pragma unroll
        for (int dt = 0; dt < 4; ++dt)
#pragma unroll
            for (int ii = 0; ii < 16; ++ii) sp[(size_t)(32 * dt + crow(ii, h)) * 128 + dmy] = S[dt][ii];
    }
}

DI void phase_mixer(const Args& a, unsigned char* lds, int l, int rep) {
    unsigned* ctl = (unsigned*)(a.ws + WS_CTL) + 16 * l + 8 * rep;
    volatile int* slot = (volatile int*)(lds + LDS_MISC);
    const int tid = otid(), lane = tid & 63, w = tid >> 6, c = lane & 31;
    bf16_t* PROJ = (bf16_t*)(a.ws + WS_PROJ);
    for (;;) {
        __syncthreads();
        if (tid == 0) *slot = (int)__hip_atomic_fetch_add(ctl, 1u, __ATOMIC_RELAXED, __HIP_MEMORY_SCOPE_AGENT);
        __syncthreads();
        const int it = *slot;
        if (it >= 1856) break;
#if PROBE_MASK & 16
        if (rep && !(it < 64 || (it >= 576 && it < 832))) continue;
#endif
#if PROBE_MASK & 32
        if (rep && (it < 64 || (it >= 576 && it < 832))) continue;
#endif
#ifndef NO_HG
        if (it < 64) { hgrn_item(a, lds, l, it >> 3, (it >> 1) & 3, it & 1); continue; }
        if (it >= 576 && it < 832) { const int idx = it - 576; hgrn_item(a, lds, l, 8 + (idx >> 3), (idx >> 1) & 3, idx & 1); continue; }
#endif
        int idx, kind;
        if (it < 576) { idx = it - 64; kind = 0; } else if (it < 1344) { idx = it - 832; kind = 1; } else if (it < 1600) { idx = it - 1344; kind = 2; } else { idx = it - 1600; kind = 3; }
        const bool lat = kind < 2, isw = kind & 1;
        int b, g, qb;
        if (lat) { b = idx >> 6; g = (idx >> 5) & 1; qb = idx & 31; } else { b = idx >> 3; g = (idx >> 2) & 1; qb = idx & 3; }
        const int r = w & 3, tq = 64 * qb + 32 * (w >> 2) + c;
        const int row = (lat ? TC + b * 2048 : b * 256) + tq;
        const bf16_t* qp = PROJ + (size_t)row * INW + (isw ? C_WQ : C_AQ) + (4 * g + r) * 64;
        bf16_t* op = (bf16_t*)(a.ws + (isw ? WS_OWIN : WS_OATT)) + (size_t)row * 512 + (4 * g + r) * 64;
        const bf16_t* Kb; const bf16_t* VTb; int nk;
        if (lat) { nk = 2304; Kb = (const bf16_t*)(a.ws + (isw ? WS_KWL : WS_KAL)) + (size_t)(b * 2 + g) * 2304 * 64; VTb = (const bf16_t*)(a.ws + (isw ? WS_VWL : WS_VAL)) + (size_t)(b * 2 + g) * 64 * 2304; }
        else { nk = 256; Kb = (const bf16_t*)(a.ws + (isw ? WS_KWC : WS_KAC)) + (size_t)(b * 2 + g) * 256 * 64; VTb = (const bf16_t*)(a.ws + (isw ? WS_VWC : WS_VAC)) + (size_t)(b * 2 + g) * 64 * 256; }
        int nA = 4, lo = 0, hi = 0; bool win = false;
        if (kind == 0) nA = 36;
        if (kind == 1) { lo = qb - 2 < 0 ? 0 : qb - 2; hi = qb + 3 > 32 ? 32 : qb + 3; win = true; }
        const float sink2 = isw ? a.in[18][l * 8 + 4 * g + r] * LOG2E : 0.f;
#ifndef NO_ATT
        attn_item(lds, qp, op, Kb, VTb, nk, nA, lo, hi, win, tq, isw, sink2);
#endif
    }
}

DI void phase_hgcomb(const Args& a, int l) {
    const int tid = otid(), lane = tid & 63, w = tid >> 6;
    const int gw = obid() * 8 + w, NGW = gridDim.x * 8;
    const float* OF = (const float*)(a.ws + WS_OF); const bf16_t* PROJ = (const bf16_t*)(a.ws + WS_PROJ); bf16_t* OHG = (bf16_t*)(a.ws + WS_OHG);
    const f32x2 gn = *(const f32x2*)(a.in[17] + l * 128 + 2 * lane);
    for (int it = gw; it < T * 4; it += NGW) {
        const int row = it >> 2, hd = it & 3;
        const f32x2 x0 = *(const f32x2*)(OF + (size_t)row * 512 + 128 * hd + 2 * lane), x1 = *(const f32x2*)(OF + ((size_t)T + row) * 512 + 128 * hd + 2 * lane);
        const float s0 = x0[0] + x1[0], s1 = x0[1] + x1[1];
        const float rstd = rsqrtf(wave_sum(s0 * s0 + s1 * s1) * (1.f / 128.f) + EPS);
        const unsigned gb = *(const unsigned*)(PROJ + (size_t)row * INW + C_HG + 128 * hd + 2 * lane);
        const float g0 = bflo(gb), g1 = bfhi(gb);
        *(unsigned*)(OHG + (size_t)row * 512 + 128 * hd + 2 * lane) = pk2(s0 * rstd * gn[0] * g0 * sigmoidf_(g0), s1 * rstd * gn[1] * g1 * sigmoidf_(g1));
    }
}

template <class Epi> DI void run_gemm(unsigned char* lds, const bf16_t* A, const bf16_t* Bt, int N, int K, const Epi& E) {
    pg8::Gemm g{A, Bt, T, N, K}; pg8::StaticOrder S; S.init(T, N, (int)gridDim.x, obid());
#if STAGGER
    {
        const unsigned long long t0 = __builtin_amdgcn_s_memrealtime();
        const unsigned long long dly = (unsigned long long)((obid() >> 3) & 7) * (unsigned long long)(STAGGER * (K / 64));
        while (__builtin_amdgcn_s_memrealtime() - t0 < dly) __builtin_amdgcn_s_sleep(4);
    }
#endif
    pg8::gemm_phase<Epi, pg8::StaticOrder, false>((PG8_LAS unsigned char*)lds, g, S, E, nullptr);
}

__global__ void __launch_bounds__(512, 2) mk_fwd(Args a) {
    extern __shared__ __attribute__((aligned(16))) unsigned char lds[];
    cg::grid_group grid = cg::this_grid();
    {   volatile LAS unsigned* st = (volatile LAS unsigned*)((LAS unsigned char*)lds + LDS_MISC + 16);
        if (threadIdx.x < 2) st[threadIdx.x] = 0u;
        __syncthreads(); }
    const XcdBarrier bar = xcd_barrier_post((unsigned*)(a.ws + WS_BAR), (volatile LAS unsigned*)((LAS unsigned char*)lds + LDS_MISC + 16));
    bf16_t* HB = (bf16_t*)(a.ws + WS_HB); bf16_t* PROJ = (bf16_t*)(a.ws + WS_PROJ); bf16_t* ACT = PROJ;
    float* M32 = (float*)(a.ws + WS_OF);
    for (int ph = a.ph_lo; ph < a.ph_hi; ++ph) {
        if (ph > a.ph_lo) { if (ph == a.ph_lo + 1) grid.sync(); else xcd_barrier(bar);
#if PROBE_MASK & 8
            xcd_barrier(bar); xcd_barrier(bar);
#endif
        }
#ifndef NO_P0
        if (ph == 0) { phase_p0(a, lds); __syncthreads(); phase_wconv(a, lds, 0, 0, 13312, obid(), (int)gridDim.x); continue; }
#endif
#ifndef NO_C0
        if (ph == NPH - 1) { phase_final(a); continue; }
#endif
        const int l = (ph - 1) / 13, k = (ph - 1) % 13;
        int reps = 1;
        if ((PROBE_MASK & 1) && (k == 0 || k == 3 || k == 10 || k == 7)) reps = 2;
        if ((PROBE_MASK & 2) && (k == 1 || k == 11 || k == 4 || k == 8)) reps = 2;
        if ((PROBE_MASK & (4 | 16 | 32)) && k == 6) reps = 2;
        if ((PROBE_MASK & (64 | 128)) && (k == 1 || k == 11)) reps = 2;
        if ((PROBE_MASK & 256) && k == 4) reps = 2;
        if ((PROBE_MASK & 512) && k == 8) reps = 2;
        if ((PROBE_MASK & 1024) && (k == 2 || k == 9 || k == 12)) reps = 2;
        for (int rep = 0; rep < reps; ++rep) {
        if (rep) xcd_barrier(bar);
        const float* MODL = (const float*)(a.ws + WS_MOD) + (size_t)l * 9 * NMODW;
        const float* xa = a.out; const float* xb = a.out + (size_t)TC * DM;
        const unsigned char* wb = a.ws + WS_W + (size_t)(l & 1) * WSZ;
        const bf16_t* WFI = (const bf16_t*)(wb + W_FI); const bf16_t* WFO = (const bf16_t*)(wb + W_FO);
        if (k == 100) {}
#ifndef NO_C0
        else if (k == 0) { phase_norm(a, l, 0, l == 0); }
        else if (k == 3 || k == 10) { phase_norm(a, l, k == 3 ? 1 : 2, false); }
#endif
#ifndef NO_G_SW
        else if (k == 1 || k == 11) { run_gemm(lds, HB, k == 1 ? WFI : WFI + (size_t)5632 * 1024, 2 * DFF, ((PROBE_MASK & 128) && rep == 0) ? 512 : DM, pg8::EpiSwiglu{ACT}); }
#endif
#ifndef NO_G_RES
        else if (k == 2 || k == 9 || k == 12) {
            if (k == 2 && l == 0) { xa = a.in[0]; xb = a.in[1]; }
            const bf16_t* A = k == 9 ? HB : ACT; const bf16_t* Bt = k == 9 ? (const bf16_t*)(wb + W_OUT) : (k == 2 ? WFO : WFO + (size_t)1024 * DFF);
            const int K = k == 9 ? DM : DFF; const int gi = k == 2 ? 2 : (k == 9 ? 5 : 8);
            run_gemm(lds, A, Bt, DM, K, pg8::EpiResid{xa, xb, ((PROBE_MASK & 1024) && rep == 0) ? (float*)(a.ws + WS_OF) : a.out, MODL + gi * DM, k == 9 ? 1.0f : 0.5f});
            if (l + 1 < DEPTH && rep == reps - 1) {
                const int G = (int)gridDim.x, cb = obid();
                const int i0 = k == 2 ? 0 : (k == 9 ? 6000 : 7312), i1 = k == 2 ? 6000 : (k == 9 ? 7312 : 13312);
                if (G == 256) { if (cb >= 128) phase_wconv(a, lds, l + 1, i0, i1, cb - 128, 128); }
                else phase_wconv(a, lds, l + 1, i0, i1, cb, G);
            }
        }
#endif
#ifndef NO_G_BF
        else if (k == 4) { run_gemm(lds, HB, (const bf16_t*)(wb + W_IN), INW, DM, pg8::EpiBf16P{PROJ, INW}); }
#endif
#ifndef NO_PREP
        else if (k == 5) { phase_prep(a, l); }
#endif
#ifndef NO_MIX
        else if (k == 6) { phase_mixer(a, lds, l, rep); }
#endif
#ifndef NO_C0
        else if (k == 7) { phase_hgcomb(a, l); }
#endif
#ifndef NO_G_BR
        else if (k == 8) {
            const bf16_t* WBR = (const bf16_t*)(wb + W_BR);
            for (int kk = 0; kk < 3; ++kk) {
                const bf16_t* A = (const bf16_t*)(a.ws + (kk == 0 ? WS_OATT : (kk == 1 ? WS_OHG : WS_OWIN)));
                run_gemm(lds, A, WBR + (size_t)kk * 1024 * 512, DM, 512, pg8::EpiBranch{PROJ + C_GA + 1024 * kk, M32, HB, kk});
            }
        }
#endif
        }
    }
}

#ifndef MK_PER_PHASE
#define MK_PER_PHASE 0
#endif
extern "C" void kernel_launch(void* const* d_in, const int* in_sizes, int n_in, void* d_out, int out_size, void* d_ws, size_t ws_size, hipStream_t stream) {
    static int grid = 0;
    if (!grid) {
        if (n_in != 22 || ws_size < WS_END) { fprintf(stderr, "kernel_launch: unexpected n_in %d or ws_size %zu < %zu\n", n_in, ws_size, (size_t)WS_END); grid = -1; return; }
        int dev = 0, cus = 0, per_cu = 0;
        (void)hipGetDevice(&dev); (void)hipDeviceGetAttribute(&cus, hipDeviceAttributeMultiprocessorCount, dev);
        if (hipFuncSetAttribute((const void*)mk_fwd, hipFuncAttributeMaxDynamicSharedMemorySize, LDS_BYTES) != hipSuccess) { fprintf(stderr, "kernel_launch: hipFuncSetAttribute failed\n"); grid = -1; return; }
        (void)hipOccupancyMaxActiveBlocksPerMultiprocessor(&per_cu, mk_fwd, 512, LDS_BYTES);
        if (per_cu < 1) per_cu = 1;
        grid = cus * per_cu; if (grid > 256) grid = 256;
    }
    if (grid < 0) return;
    (void)hipMemsetAsync((char*)d_ws + WS_CTL, 0, CTL_BYTES, stream);
    Args a{};
    for (int i = 0; i < 22; ++i) a.in[i] = (const float*)d_in[i];
    a.out = (float*)d_out; a.ws = (unsigned char*)d_ws;
#if MK_PER_PHASE
    for (int ph = 0; ph < NPH; ++ph) { a.ph_lo = ph; a.ph_hi = ph + 1; hipLaunchKernelGGL(mk_fwd, dim3(grid), dim3(512), LDS_BYTES, stream, a); }
#else
    a.ph_lo = 0; a.ph_hi = NPH;
    void* args[] = {&a};
    hipError_t e = hipLaunchCooperativeKernel((void*)mk_fwd, dim3(grid), dim3(512), args, LDS_BYTES, stream);
    if (e != hipSuccess) fprintf(stderr, "cooperative launch failed: %s (grid %d)\n", hipGetErrorString(e), grid);
#endif
}
```

```cpp
#include <hip/hip_runtime.h>
#include <hip/hip_cooperative_groups.h>
#include <cstdio>
#include <cstdint>
namespace cg = cooperative_groups;

#ifndef PROBE_MASK
#define PROBE_MASK 0
#endif
#ifndef STAGGER
#define STAGGER 0
#endif
#define DI __device__ __forceinline__
typedef unsigned short bf16_t;
typedef short bf16x8 __attribute__((ext_vector_type(8)));
typedef short s16x4 __attribute__((ext_vector_type(4)));
typedef float f32x2 __attribute__((ext_vector_type(2)));
typedef float f32x4 __attribute__((ext_vector_type(4)));
typedef float f32x16 __attribute__((ext_vector_type(16)));
typedef unsigned u32x2 __attribute__((ext_vector_type(2)));
typedef unsigned u32x4 __attribute__((ext_vector_type(4)));
typedef __bf16 bf16x2n __attribute__((ext_vector_type(2)));

DI int otid() { int t = threadIdx.x; asm volatile("" : "+v"(t)); return t; }
DI int obid() { int b = blockIdx.x; asm volatile("" : "+s"(b)); return b; }
DI unsigned pk2(float lo, float hi) { f32x2 v = {lo, hi}; return __builtin_bit_cast(unsigned, __builtin_convertvector(v, bf16x2n)); }
DI float bflo(unsigned u) { return __uint_as_float(u << 16); }
DI float bfhi(unsigned u) { return __uint_as_float(u & 0xffff0000u); }
DI float bf2f(bf16_t b) { return __uint_as_float(((unsigned)b) << 16); }
DI bf16_t f2bf(float f) { return (bf16_t)(pk2(f, 0.f) & 0xffffu); }
DI float sigmoidf_(float x) { return __builtin_amdgcn_rcpf(1.f + __expf(-x)); }
DI float wave_sum(float v) {
#pragma unroll
    for (int o = 1; o < 64; o <<= 1) v += __shfl_xor(v, o);
    return v;
}
#define MFMA32(a, b, c) __builtin_amdgcn_mfma_f32_32x32x16_bf16((a), (b), (c), 0, 0, 0)
DI bf16x8 pack8(float a0, float a1, float a2, float a3, float a4, float a5, float a6, float a7) {
    u32x4 p; p.x = pk2(a0, a1); p.y = pk2(a2, a3); p.z = pk2(a4, a5); p.w = pk2(a6, a7); return __builtin_bit_cast(bf16x8, p);
}
DI bf16x8 cat44(s16x4 lo, s16x4 hi) { return __builtin_shufflevector(lo, hi, 0, 1, 2, 3, 4, 5, 6, 7); }

constexpr int DM = 1024, DEPTH = 4, TC = 8192, TL = 16384, T = 24576, DFF = 2816, INW = 7168, NMODW = 9216;
constexpr int C_AQ = 0, C_AK = 512, C_AV = 640, C_WQ = 768, C_WK = 1280, C_WV = 1408, C_HQ = 1536, C_HFF = 2048, C_HFB = 2560, C_HI = 3072, C_HG = 3584, C_GA = 4096;
constexpr float EPS = 1e-6f, LOG2E = 1.4426950408889634f;
constexpr size_t O_X = 0, O_NKA = 25165824, O_NVA = 29360128, O_NKW = 33554432, O_NVW = 37748736, O_NST = 41943040;
constexpr size_t al256(size_t x) { return (x + 255) & ~(size_t)255; }
constexpr size_t WS_CTL = 0;
constexpr size_t WS_BAR = 4096;
constexpr size_t CTL_BYTES = 32768;
constexpr size_t WS_MOD = CTL_BYTES;
constexpr size_t WS_LB = WS_MOD + al256((size_t)DEPTH * 9 * NMODW * 4);
constexpr size_t WS_ROPE = WS_LB + 16384;
constexpr size_t WSZ = (size_t)(2 * 5632 * 1024 + 2 * 1024 * 2816 + 7168 * 1024 + 3 * 1024 * 512 + 1024 * 1024) * 2;
constexpr size_t WS_W = WS_ROPE + 8192;
constexpr size_t W_FI = 0;
constexpr size_t W_FO = W_FI + (size_t)2 * 5632 * 1024 * 2;
constexpr size_t W_IN = W_FO + (size_t)2 * 1024 * 2816 * 2;
constexpr size_t W_BR = W_IN + (size_t)7168 * 1024 * 2;
constexpr size_t W_OUT = W_BR + (size_t)3 * 1024 * 512 * 2;
constexpr size_t WS_HB = WS_W + 2 * WSZ;
constexpr size_t WS_PROJ = WS_HB + (size_t)T * 1024 * 2;
constexpr size_t WS_OATT = WS_PROJ + (size_t)T * INW * 2;
constexpr size_t WS_OHG = WS_OATT + (size_t)T * 512 * 2;
constexpr size_t WS_OWIN = WS_OHG + (size_t)T * 512 * 2;
constexpr size_t WS_OF = WS_OWIN + (size_t)T * 512 * 2;
constexpr size_t WS_KAL = WS_OF + (size_t)2 * T * 512 * 4;
constexpr size_t SZ_KL = (size_t)8 * 2 * 2304 * 64 * 2, SZ_KC = (size_t)32 * 2 * 256 * 64 * 2;
constexpr size_t WS_VAL = WS_KAL + SZ_KL;
constexpr size_t WS_KWL = WS_VAL + SZ_KL;
constexpr size_t WS_VWL = WS_KWL + SZ_KL;
constexpr size_t WS_KAC = WS_VWL + SZ_KL;
constexpr size_t WS_VAC = WS_KAC + SZ_KC;
constexpr size_t WS_KWC = WS_VAC + SZ_KC;
constexpr size_t WS_VWC = WS_KWC + SZ_KC;
constexpr size_t WS_END = WS_VWC + SZ_KC;
constexpr int LDS_BYTES = 160 * 1024, LDS_MISC = 159 * 1024;
constexpr int NPH = 1 + 13 * DEPTH + 1;

struct Args { const float* in[22]; float* out; unsigned char* ws; int ph_lo, ph_hi; };

namespace pg8 {
#define PG8_LAS __attribute__((address_space(3)))
typedef unsigned short bf16_t;
typedef short bf16x8 __attribute__((ext_vector_type(8)));
typedef float f32x4 __attribute__((ext_vector_type(4)));
typedef unsigned u32x4 __attribute__((ext_vector_type(4)));
constexpr int BM = 256, BK = 64, HALF = 128, HTB = HALF * BK * 2  , STAGE_BYTES = 8 * HTB, NXCD = 8, WGM = 8;

__host__ __device__ __forceinline__ int lds_byte(int r, int c) { const int st = (r >> 4) * 2 + (c >> 5), rr = r & 15, cc = c & 31, ob = rr * 64 + cc * 2; return st * 1024 + (ob ^ (((ob >> 9) & 1) << 5)); }
__host__ __device__ __forceinline__ void stage_rc(int b, int& R, int& C) { const int st = b / 1024, sb = b % 1024, swz = sb ^ (((sb >> 9) & 1) << 5); R = (st >> 1) * 16 + swz / 64; C = (st & 1) * 32 + (swz % 64) / 2; }
__host__ __device__ __forceinline__ int perm32(int rho) { const int n = rho >> 4, i = rho & 15; return 8 * (i >> 2) + 4 * n + (i & 3); }

struct Unit { int pm, pn; };
struct Gemm { const bf16_t* A; const bf16_t* Bt; int M, N, K; };

struct StaticOrder {
    int nM, nN, nwg, G, c;
    __host__ __device__ void init(int M, int N, int G_, int c_) { nM = M / BM; nN = N / BM; nwg = nM * nN; G = G_; c = c_; }
    __host__ __device__ bool next(int i, Unit& u) const {
        const long L = (long)i * G + c; if (L >= nwg) return false;
        int wgid = (int)L; { const int q = nwg / NXCD, r = nwg % NXCD, xcd = wgid % NXCD, off = wgid / NXCD; wgid = (xcd < r ? xcd * (q + 1) : r * (q + 1) + (xcd - r) * q) + off; }
        const int nig = WGM * nN, gid = wgid / nig, fm = gid * WGM, gsz = (nM - fm) < WGM ? (nM - fm) : WGM;
        u.pm = fm + ((wgid % nig) % gsz); u.pn = (wgid % nig) / gsz; return true;
    }
    __device__ __forceinline__ void a_ready(const Unit&) const {}
    __device__ __forceinline__ void done(const Unit&) const {}
};
struct EpiBf16P {
    static constexpr bool PERM = true, AFTER_DRAIN = false;
    bf16_t* O; int ldc;
    __device__ __forceinline__ void operator()(const f32x4 (&acc)[2][2][4][2], const Unit& u, int wr, int wc, int fr, int fq) const {
        const int row0 = u.pm * BM + wr * 64 + fr, col0 = u.pn * BM + wc * 32 + 8 * fq;
#pragma unroll
        for (int ai = 0; ai < 2; ++ai)
#pragma unroll
            for (int m = 0; m < 4; ++m) { bf16_t* rowp = O + (size_t)(row0 + ai * HALF + m * 16) * ldc + col0;
#pragma unroll
                for (int bj = 0; bj < 2; ++bj) { const f32x4 v0 = acc[ai][bj][m][0], v1 = acc[ai][bj][m][1];
                    u32x4 w; w.x = pk2(v0[0], v0[1]); w.y = pk2(v0[2], v0[3]); w.z = pk2(v1[0], v1[1]); w.w = pk2(v1[2], v1[3]);
                    *(u32x4*)(rowp + bj * HALF) = w; } }
    }
};
struct EpiSwiglu {
    static constexpr bool PERM = true, AFTER_DRAIN = false;
    bf16_t* O;
    __device__ __forceinline__ void operator()(const f32x4 (&acc)[2][2][4][2], const Unit& u, int wr, int wc, int fr, int fq) const {
        const int row0 = u.pm * BM + wr * 64 + fr, col0 = u.pn * HALF + wc * 32 + 8 * fq;
#pragma unroll
        for (int ai = 0; ai < 2; ++ai)
#pragma unroll
            for (int m = 0; m < 4; ++m) { bf16_t* rowp = O + (size_t)(row0 + ai * HALF + m * 16) * DFF + col0;
                float r[8];
#pragma unroll
                for (int n = 0; n < 2; ++n)
#pragma unroll
                    for (int j = 0; j < 4; ++j) { const float g = acc[ai][0][m][n][j], up = acc[ai][1][m][n][j]; r[4 * n + j] = g * __builtin_amdgcn_rcpf(1.f + __expf(-g)) * up; }
                u32x4 w; w.x = pk2(r[0], r[1]); w.y = pk2(r[2], r[3]); w.z = pk2(r[4], r[5]); w.w = pk2(r[6], r[7]);
                *(u32x4*)rowp = w; }
    }
};
struct EpiResid {
    static constexpr bool PERM = false, AFTER_DRAIN = false;
    const float* xa; const float* xb; float* out; const float* mod; float coef;
    __device__ __forceinline__ void operator()(const f32x4 (&acc)[2][2][4][2], const Unit& u, int wr, int wc, int fr, int fq) const {
        const int row0 = u.pm * BM + wr * 64 + fr, col0 = u.pn * BM + wc * 32 + 4 * fq;
        const int trow = u.pm * BM; const int cond = trow < TC ? 8 : ((trow - TC) >> 11);
        const float* bbase = trow < TC ? xa + (size_t)row0 * DM : xb + (size_t)(row0 - TC) * DM; const float* mp = mod + (size_t)cond * NMODW;
        f32x4 g[2][2];
#pragma unroll
        for (int bj = 0; bj < 2; ++bj)
#pragma unroll
            for (int n = 0; n < 2; ++n) g[bj][n] = coef * *(const f32x4*)(mp + col0 + bj * HALF + n * 16);
#pragma unroll
        for (int ai = 0; ai < 2; ++ai) {
            f32x4 bv[4][2][2];
#pragma unroll
            for (int m = 0; m < 4; ++m)
#pragma unroll
                for (int bj = 0; bj < 2; ++bj)
#pragma unroll
                    for (int n = 0; n < 2; ++n) bv[m][bj][n] = *(const f32x4*)(bbase + (size_t)(ai * HALF + m * 16) * DM + col0 + bj * HALF + n * 16);
#pragma unroll
            for (int m = 0; m < 4; ++m) { float* op = out + (size_t)(row0 + ai * HALF + m * 16) * DM + col0;
#pragma unroll
                for (int bj = 0; bj < 2; ++bj)
#pragma unroll
                    for (int n = 0; n < 2; ++n) *(f32x4*)(op + bj * HALF + n * 16) = bv[m][bj][n] + g[bj][n] * acc[ai][bj][m][n]; }
        }
    }
};
struct EpiBranch {
    static constexpr bool PERM = true, AFTER_DRAIN = false;
    const bf16_t* gate; float* acc32; bf16_t* outbf; int mode;
    __device__ __forceinline__ void operator()(const f32x4 (&acc)[2][2][4][2], const Unit& u, int wr, int wc, int fr, int fq) const {
        const int row0 = u.pm * BM + wr * 64 + fr, col0 = u.pn * BM + wc * 32 + 8 * fq;
#pragma unroll
        for (int ai = 0; ai < 2; ++ai) {
            u32x4 gv[4][2], pv[4][2];
#pragma unroll
            for (int m = 0; m < 4; ++m)
#pragma unroll
                for (int bj = 0; bj < 2; ++bj) { const int row = row0 + ai * HALF + m * 16, c = col0 + bj * HALF;
                    gv[m][bj] = *(const u32x4*)(gate + (size_t)row * INW + c);
                    if (mode != 0) pv[m][bj] = *(const u32x4*)(outbf + (size_t)row * DM + c); else pv[m][bj] = (u32x4){0u, 0u, 0u, 0u}; }
#pragma unroll
            for (int m = 0; m < 4; ++m)
#pragma unroll
                for (int bj = 0; bj < 2; ++bj) { const int row = row0 + ai * HALF + m * 16, c = col0 + bj * HALF;
                    const u32x4 g = gv[m][bj], p = pv[m][bj];
                    float v[8];
                    v[0] = sigmoidf_(bflo(g.x)) * acc[ai][bj][m][0][0] + bflo(p.x); v[1] = sigmoidf_(bfhi(g.x)) * acc[ai][bj][m][0][1] + bfhi(p.x);
                    v[2] = sigmoidf_(bflo(g.y)) * acc[ai][bj][m][0][2] + bflo(p.y); v[3] = sigmoidf_(bfhi(g.y)) * acc[ai][bj][m][0][3] + bfhi(p.y);
                    v[4] = sigmoidf_(bflo(g.z)) * acc[ai][bj][m][1][0] + bflo(p.z); v[5] = sigmoidf_(bfhi(g.z)) * acc[ai][bj][m][1][1] + bfhi(p.z);
                    v[6] = sigmoidf_(bflo(g.w)) * acc[ai][bj][m][1][2] + bflo(p.w); v[7] = sigmoidf_(bfhi(g.w)) * acc[ai][bj][m][1][3] + bfhi(p.w);
                    u32x4 w; w.x = pk2(v[0], v[1]); w.y = pk2(v[2], v[3]); w.z = pk2(v[4], v[5]); w.w = pk2(v[6], v[7]);
                    *(u32x4*)(outbf + (size_t)row * DM + c) = w; }
        }
    }
};

template <class Epi, class Sched, bool STAMP = false>
__device__ __forceinline__ void gemm_phase(PG8_LAS unsigned char* lds, const Gemm g, const Sched& S, const Epi& E, unsigned long long* stamps) {
    const int tid = otid(), wid = __builtin_amdgcn_readfirstlane(tid >> 6), lane = tid & 63, wr = wid >> 2, wc = wid & 3, fr = lane & 15, fq = lane >> 4;
    const int K = g.K, nt = K / BK;
    int ts_lo = 0, ts_hi = 0, nts = 0; const unsigned long long rt_entry = STAMP ? (unsigned long long)wall_clock64() : 0ull;
#define PG8_STAMP() do { if (STAMP && wid == 0 && nts < 64) { const unsigned long long _c = (unsigned long long)clock64(); \
        ts_lo = (lane == nts) ? (int)(unsigned)_c : ts_lo; ts_hi = (lane == nts) ? (int)(unsigned)(_c >> 32) : ts_hi; ++nts; } } while (0)
    PG8_STAMP();
    unsigned voffA[2], voffB[2];
#pragma unroll
    for (int i = 0; i < 2; ++i) { int R, C; stage_rc(tid * 16 + i * 8192, R, C); const int Rb = Epi::PERM ? ((R & ~31) + perm32(R & 31)) : R;
        voffA[i] = (unsigned)(R * K + C) * 2u; voffB[i] = (unsigned)(Rb * K + C) * 2u; }
    const size_t kstep = (size_t)(BK * 2);
    const size_t hstep = (size_t)HALF * K * 2;
    const size_t tstep = 2 * hstep;
    const unsigned ldsw = (unsigned)wid * 1024u;
    const int aoff = lds_byte(wr * 64 + fr, fq * 8), boff = lds_byte(wc * 32 + fr, fq * 8);
#define PG8_SA(b, h) (((b) * 2 + (h)) * HTB)
#define PG8_SB(b, h) ((4 + (b) * 2 + (h)) * HTB)
#define PG8_STAGE(bufoff, gbase, voff) do { _Pragma("unroll") for (int _i = 0; _i < 2; ++_i) \
        __builtin_amdgcn_global_load_lds((const unsigned*)((const char*)(gbase) + (voff)[_i]), (PG8_LAS unsigned*)(lds + (bufoff) + ldsw + _i * 8192), 16, 0, 0); } while (0)
#define PG8_LDA(dst, b, h) do { _Pragma("unroll") for (int m = 0; m < 4; ++m) _Pragma("unroll") for (int k = 0; k < 2; ++k) dst[m][k] = *(const PG8_LAS bf16x8*)(lds + PG8_SA(b, h) + aoff + m * 2048 + k * 1024); } while (0)
#define PG8_LDB(dst, b, h) do { _Pragma("unroll") for (int n = 0; n < 2; ++n) _Pragma("unroll") for (int k = 0; k < 2; ++k) dst[n][k] = *(const PG8_LAS bf16x8*)(lds + PG8_SB(b, h) + boff + n * 2048 + k * 1024); } while (0)
#define PG8_MMA(ai, bj, At, Bt) do { __builtin_amdgcn_s_setprio(1); _Pragma("unroll") for (int m = 0; m < 4; ++m) _Pragma("unroll") for (int n = 0; n < 2; ++n) _Pragma("unroll") for (int k = 0; k < 2; ++k) \
        acc[ai][bj][m][n] = __builtin_amdgcn_mfma_f32_16x16x32_bf16(Bt[n][k], At[m][k], acc[ai][bj][m][n], 0, 0, 0); __builtin_amdgcn_s_setprio(0); } while (0)
#define PG8_WAIT_V(n) asm volatile("s_waitcnt vmcnt(" #n ")" ::: "memory")
#define PG8_WAIT_L(n) asm volatile("s_waitcnt lgkmcnt(" #n ")" ::: "memory")
#define PG8_BAR __builtin_amdgcn_s_barrier()
#define PG8_SCHED __builtin_amdgcn_sched_barrier(0)
    Unit cur, nxt; int ui = 0;
    if (!S.next(0, cur)) return;
    f32x4 acc[2][2][4][2];
#pragma unroll
    for (int a = 0; a < 2; ++a)
#pragma unroll
        for (int b = 0; b < 2; ++b)
#pragma unroll
            for (int m = 0; m < 4; ++m)
#pragma unroll
                for (int n = 0; n < 2; ++n) acc[a][b][m][n] = (f32x4){0.f, 0.f, 0.f, 0.f};
    bf16x8 At[4][2], B0[2][2], B1[2][2];
    const char* cA = (const char*)g.A + (size_t)cur.pm * tstep; const char* cB = (const char*)g.Bt + (size_t)cur.pn * tstep;
    S.a_ready(cur);
    PG8_STAGE(PG8_SB(0, 0), cB, voffB); PG8_STAGE(PG8_SA(0, 0), cA, voffA); PG8_STAGE(PG8_SB(0, 1), cB + hstep, voffB); PG8_STAGE(PG8_SA(0, 1), cA + hstep, voffA);
    if (wr == 1) PG8_BAR;
    PG8_WAIT_V(4); PG8_BAR;
    PG8_STAGE(PG8_SB(1, 0), cB + kstep, voffB); PG8_STAGE(PG8_SA(1, 0), cA + kstep, voffA); PG8_STAGE(PG8_SB(1, 1), cB + hstep + kstep, voffB);
    PG8_WAIT_V(6); PG8_BAR;
    PG8_STAMP();
    for (;;) {
        const bool has_next = S.next(ui + 1, nxt);
        const char* nA = has_next ? (const char*)g.A + (size_t)nxt.pm * tstep : cA; const char* nB = has_next ? (const char*)g.Bt + (size_t)nxt.pn * tstep : cB;
        for (int t = 0; t < nt; t += 2) {
            const bool last = (t == nt - 2);
            const char* a1 = cA + (size_t)(t + 1) * kstep;
            const char* a2 = last ? nA : cA + (size_t)(t + 2) * kstep; const char* b2 = last ? nB : cB + (size_t)(t + 2) * kstep;
            const char* a3 = a2 + kstep; const char* b3 = b2 + kstep;
            if (last && has_next) S.a_ready(nxt);
            PG8_LDB(B0, 0, 0); PG8_SCHED; PG8_LDA(At, 0, 0); PG8_STAGE(PG8_SA(1, 1), a1 + hstep, voffA);
            PG8_WAIT_L(8); PG8_BAR; PG8_WAIT_L(0); PG8_MMA(0, 0, At, B0); PG8_BAR; PG8_SCHED;
            PG8_LDB(B1, 0, 1); PG8_STAGE(PG8_SB(0, 0), b2, voffB);
            PG8_BAR; PG8_WAIT_L(0); PG8_MMA(0, 1, At, B1); PG8_BAR;
            PG8_LDA(At, 0, 1); PG8_STAGE(PG8_SA(0, 0), a2, voffA);
            PG8_BAR; PG8_WAIT_L(0); PG8_MMA(1, 0, At, B0); PG8_BAR; PG8_SCHED;
            PG8_STAGE(PG8_SB(0, 1), b2 + hstep, voffB);
            PG8_WAIT_V(6); PG8_BAR; PG8_MMA(1, 1, At, B1); PG8_BAR;
            PG8_LDB(B0, 1, 0); PG8_SCHED; PG8_LDA(At, 1, 0); PG8_STAGE(PG8_SA(0, 1), a2 + hstep, voffA);
            PG8_WAIT_L(8); PG8_BAR; PG8_WAIT_L(0); PG8_MMA(0, 0, At, B0); PG8_BAR; PG8_SCHED;
            PG8_LDB(B1, 1, 1); PG8_STAGE(PG8_SB(1, 0), b3, voffB);
            PG8_BAR; PG8_WAIT_L(0); PG8_MMA(0, 1, At, B1); PG8_BAR;
            PG8_LDA(At, 1, 1); PG8_STAGE(PG8_SA(1, 0), a3, voffA);
            PG8_BAR; PG8_WAIT_L(0); PG8_MMA(1, 0, At, B0); PG8_BAR; PG8_SCHED;
            PG8_STAGE(PG8_SB(1, 1), b3 + hstep, voffB);
            PG8_WAIT_V(6); PG8_BAR; PG8_MMA(1, 1, At, B1); PG8_BAR;
        }
        PG8_STAMP();
        if constexpr (!Epi::AFTER_DRAIN) { E(acc, cur, wr, wc, fr, fq); S.done(cur); }
        PG8_STAMP();
        if (!has_next) break;
#pragma unroll
        for (int a = 0; a < 2; ++a)
#pragma unroll
            for (int b = 0; b < 2; ++b)
#pragma unroll
                for (int m = 0; m < 4; ++m)
#pragma unroll
                    for (int n = 0; n < 2; ++n) acc[a][b][m][n] = (f32x4){0.f, 0.f, 0.f, 0.f};
        cur = nxt; cA = nA; cB = nB; ++ui;
    }
    PG8_WAIT_V(0);
    if (wr == 0) PG8_BAR;
    PG8_BAR;
    if constexpr (Epi::AFTER_DRAIN) { E.fused(acc, cur, wr, wc, fr, fq, lds, wid, lane); S.done(cur); }
    PG8_STAMP();
    if (STAMP && wid == 0) { stamps[lane] = lane < nts ? (((unsigned long long)(unsigned)ts_hi << 32) | (unsigned)ts_lo) : 0ull;
        if (lane == 62) stamps[62] = rt_entry; if (lane == 63) stamps[63] = (unsigned long long)wall_clock64(); }
#undef PG8_STAMP
#undef PG8_SA
#undef PG8_SB
#undef PG8_STAGE
#undef PG8_LDA
#undef PG8_LDB
#undef PG8_MMA
#undef PG8_WAIT_V
#undef PG8_WAIT_L
#undef PG8_BAR
#undef PG8_SCHED
}
}
DI int crow(int i, int h) { return (i & 3) + 8 * (i >> 2) + 4 * h; }
#define LDS_WAIT() asm volatile("s_waitcnt lgkmcnt(0)" ::: "memory")


DI void phase_p0(const Args& a, unsigned char* lds) {
    float* s = (float*)lds; float* red = (float*)(lds + 36864);
    const int tid = otid(), lane = tid & 63, w = tid >> 6;
    float* MOD = (float*)(a.ws + WS_MOD);
    if ((int)blockIdx.x < 144) {
        const float* c = a.in[7]; const float* cctx = a.in[8];
        for (int i = tid; i < 9 * 1024; i += 512) { const int ci = i >> 10, k = i & 1023; const float v = ci < 8 ? c[ci * 1024 + k] : cctx[k]; s[i] = v * sigmoidf_(v); }
        __syncthreads();
        for (int item = blockIdx.x; item < 144; item += gridDim.x) {
            const int l = item / 36, cc = item % 36;
            const float* W = a.in[9] + (size_t)l * 1024 * NMODW + cc * 256 + 4 * lane;
            f32x4 acc[9];
#pragma unroll
            for (int ci = 0; ci < 9; ++ci) acc[ci] = (f32x4){0.f, 0.f, 0.f, 0.f};
#pragma unroll 2
            for (int k4 = 0; k4 < 32; ++k4) {
                const int k = w * 128 + k4 * 4;
                const f32x4 w0 = *(const f32x4*)(W + (size_t)(k + 0) * NMODW), w1 = *(const f32x4*)(W + (size_t)(k + 1) * NMODW),
                            w2 = *(const f32x4*)(W + (size_t)(k + 2) * NMODW), w3 = *(const f32x4*)(W + (size_t)(k + 3) * NMODW);
#pragma unroll
                for (int ci = 0; ci < 9; ++ci) { const f32x4 sv = *(const f32x4*)(s + ci * 1024 + k); acc[ci] += sv[0] * w0 + sv[1] * w1 + sv[2] * w2 + sv[3] * w3; }
            }
#pragma unroll
            for (int ci = 0; ci < 9; ++ci) *(f32x4*)(red + ((w * 9 + ci) * 256 + 4 * lane)) = acc[ci];
            __syncthreads();
            for (int i = tid; i < 9 * 256; i += 512) { const int ci = i >> 8, col = i & 255; float v = 0.f;
#pragma unroll
                for (int ww = 0; ww < 8; ++ww) v += red[(ww * 9 + ci) * 256 + col];
                v += a.in[10][l * NMODW + cc * 256 + col];
                MOD[((size_t)l * 9 + ci) * NMODW + cc * 256 + col] = v; }
            __syncthreads();
        }
    }
    if (blockIdx.x == gridDim.x - 1) {
        float* LB = (float*)(a.ws + WS_LB); const float* lbin = a.in[16];
        for (int e = tid; e < 1024; e += 512) {
            const float x0 = lbin[e], x1 = lbin[1024 + e], x2 = lbin[2048 + e], x3 = lbin[3072 + e];
            const float mx = fmaxf(fmaxf(x0, x1), fmaxf(x2, x3));
            const float e0 = __expf(x0 - mx), e1 = __expf(x1 - mx), e2 = __expf(x2 - mx), e3 = __expf(x3 - mx); const float inv = 1.f / (e0 + e1 + e2 + e3);
            LB[e] = 0.f; LB[1024 + e] = e1 * inv; LB[2048 + e] = (e1 + e2) * inv; LB[3072 + e] = (e1 + e2 + e3) * inv;
        }
        float* cosT = (float*)(a.ws + WS_ROPE); float* sinT = cosT + 1024;
        for (int e = tid; e < 1024; e += 512) { const int pos = e >> 4, i = e & 15; const float inv = exp2f(-(float)i * (13.287712379549449f / 16.f)); const float ang = (float)pos * inv;
            cosT[e] = cosf(ang); sinT[e] = sinf(ang); }
    }
}

DI void transpose_item(const float* W, int ldw, int srccol0, int k0, bf16_t* WT, int K, int dstrow0, float* scr, int lane) {
#pragma unroll 8
    for (int i = 0; i < 32; ++i) { const int kk = 2 * i + (lane >> 5); scr[kk * 33 + (lane & 31)] = W[(size_t)(k0 + kk) * ldw + srccol0 + (lane & 31)]; }
    LDS_WAIT();
    const int c = lane & 7;
#pragma unroll
    for (int j = 0; j < 4; ++j) { const int n = (lane >> 3) + 8 * j; const float* sp = scr + (8 * c) * 33 + n;
        u32x4 o; o.x = pk2(sp[0 * 33], sp[1 * 33]); o.y = pk2(sp[2 * 33], sp[3 * 33]); o.z = pk2(sp[4 * 33], sp[5 * 33]); o.w = pk2(sp[6 * 33], sp[7 * 33]);
        *(u32x4*)(WT + (size_t)(dstrow0 + n) * K + k0 + 8 * c) = o; }
    LDS_WAIT();
}
DI void phase_wconv(const Args& a, unsigned char* lds, int l, int it0, int it1, int rank, int nrank) {
    const int tid = otid(), lane = tid & 63, w = tid >> 6;
    float* scr = (float*)(lds + w * 8448);
    unsigned char* wb = a.ws + WS_W + (size_t)(l & 1) * WSZ;
    for (int it = it0 + rank * 8 + w; it < it1; it += nrank * 8) {
        int r = it;
        if (r < 5632) { const int j = r / 2816; r -= j * 2816; const int kb = r / 176, nb = r % 176, n0 = 32 * nb, pn = n0 >> 8, loc = n0 & 255;
            const int src = (loc >> 7) * DFF + 128 * pn + (loc & 127);
            transpose_item(a.in[12] + (size_t)(l * 2 + j) * 1024 * 5632, 5632, src, 64 * kb, (bf16_t*)(wb + W_FI) + (size_t)j * 5632 * 1024, 1024, n0, scr, lane); continue; }
        r -= 5632;
        if (r < 2816) { const int j = r / 1408; r -= j * 1408; const int kb = r / 32, nb = r % 32;
            transpose_item(a.in[13] + (size_t)(l * 2 + j) * DFF * 1024, 1024, 32 * nb, 64 * kb, (bf16_t*)(wb + W_FO) + (size_t)j * 1024 * DFF, DFF, 32 * nb, scr, lane); continue; }
        r -= 2816;
        if (r < 3584) { const int kb = r / 224, nb = r % 224;
            transpose_item(a.in[14] + (size_t)l * 1024 * INW, INW, 32 * nb, 64 * kb, (bf16_t*)(wb + W_IN), 1024, 32 * nb, scr, lane); continue; }
        r -= 3584;
        if (r < 768) { const int k = r / 256; r -= k * 256; const int kb = r / 32, nb = r % 32;
            transpose_item(a.in[19] + (size_t)(l * 3 + k) * 512 * 1024, 1024, 32 * nb, 64 * kb, (bf16_t*)(wb + W_BR) + (size_t)k * 1024 * 512, 512, 32 * nb, scr, lane); continue; }
        r -= 768;
        { const int kb = r / 32, nb = r % 32;
            transpose_item(a.in[20] + (size_t)l * 1024 * 1024, 1024, 32 * nb, 64 * kb, (bf16_t*)(wb + W_OUT), 1024, 32 * nb, scr, lane); }
    }
}

DI void phase_norm(const Args& a, int l, int j, bool first) {
    const int tid = otid(), lane = tid & 63, w = tid >> 6;
    const int gw = obid() * 8 + w, NGW = gridDim.x * 8;
    const float* g = a.in[11] + (size_t)(l * 3 + j) * DM; const float* MOD = (const float*)(a.ws + WS_MOD) + (size_t)l * 9 * NMODW;
    bf16_t* HB = (bf16_t*)(a.ws + WS_HB);
    f32x4 gg[4];
#pragma unroll
    for (int jj = 0; jj < 4; ++jj) gg[jj] = *(const f32x4*)(g + 4 * lane + 256 * jj);
    for (int row = gw; row < T; row += NGW) {
        const float* xr = first ? (row < TC ? a.in[0] + (size_t)row * DM : a.in[1] + (size_t)(row - TC) * DM) : a.out + (size_t)row * DM;
        const int cond = row < TC ? 8 : ((row - TC) >> 11);
        const float* shift = MOD + (size_t)cond * NMODW + 3 * j * DM; const float* scale = shift + DM;
        f32x4 v[4]; float ss = 0.f;
#pragma unroll
        for (int jj = 0; jj < 4; ++jj) { v[jj] = *(const f32x4*)(xr + 4 * lane + 256 * jj); ss += (v[jj][0] * v[jj][0] + v[jj][1] * v[jj][1]) + (v[jj][2] * v[jj][2] + v[jj][3] * v[jj][3]); }
        const float rstd = rsqrtf(wave_sum(ss) * (1.f / DM) + EPS);
#pragma unroll
        for (int jj = 0; jj < 4; ++jj) { const f32x4 sc = *(const f32x4*)(scale + 4 * lane + 256 * jj), sh = *(const f32x4*)(shift + 4 * lane + 256 * jj);
            const f32x4 y = v[jj] * rstd * gg[jj] * (1.f + sc) + sh;
            u32x2 o; o.x = pk2(y[0], y[1]); o.y = pk2(y[2], y[3]);
            *(u32x2*)(HB + (size_t)row * DM + 4 * lane + 256 * jj) = o; }
    }
}
DI void phase_final(const Args& a) {
    const int tid = otid(), lane = tid & 63, w = tid >> 6;
    const int gw = obid() * 8 + w, NGW = gridDim.x * 8;
    const float* g = a.in[21];
    f32x4 gg[4];
#pragma unroll
    for (int jj = 0; jj < 4; ++jj) gg[jj] = *(const f32x4*)(g + 4 * lane + 256 * jj);
    for (int row = gw; row < T; row += NGW) {
        float* xr = a.out + (size_t)row * DM;
        f32x4 v[4]; float ss = 0.f;
#pragma unroll
        for (int jj = 0; jj < 4; ++jj) { v[jj] = *(const f32x4*)(xr + 4 * lane + 256 * jj); ss += (v[jj][0] * v[jj][0] + v[jj][1] * v[jj][1]) + (v[jj][2] * v[jj][2] + v[jj][3] * v[jj][3]); }
        const float rstd = rsqrtf(wave_sum(ss) * (1.f / DM) + EPS);
#pragma unroll
        for (int jj = 0; jj < 4; ++jj) *(f32x4*)(xr + 4 * lane + 256 * jj) = v[jj] * rstd * gg[jj];
    }
}

DI void phase_prep(const Args& a, int l, bool dry) {
    const int tid = otid(), lane = tid & 63, w = tid >> 6;
    const int gw = obid() * 8 + w, NGW = gridDim.x * 8;
    bf16_t* PROJ = (bf16_t*)(a.ws + WS_PROJ);
    const float* cosT = (const float*)(a.ws + WS_ROPE); const float* sinT = cosT + 1024;
    const float qg = a.in[15][(l * 2 + 0) * 64 + lane], kg = a.in[15][(l * 2 + 1) * 64 + lane];
    bf16_t* KAL = (bf16_t*)(a.ws + WS_KAL); bf16_t* VAL = (bf16_t*)(a.ws + WS_VAL); bf16_t* KWL = (bf16_t*)(a.ws + WS_KWL); bf16_t* VWL = (bf16_t*)(a.ws + WS_VWL);
    bf16_t* KAC = (bf16_t*)(a.ws + WS_KAC); bf16_t* VAC = (bf16_t*)(a.ws + WS_VAC); bf16_t* KWC = (bf16_t*)(a.ws + WS_KWC); bf16_t* VWC = (bf16_t*)(a.ws + WS_VWC);
    for (int r = gw; r < T + 2048; r += NGW) {
        if (r < T) {
            const bool lat = r >= TC; int b, t;
            if (lat) { b = (r - TC) >> 11; t = (r - TC) & 2047; } else { b = r >> 8; t = r & 255; }
            float cs = 1.f, sn = 0.f;
            if (lat) { const int pos = (lane & 32) ? (t & 63) : (t >> 6); cs = cosT[pos * 16 + (lane & 15)]; sn = sinT[pos * 16 + (lane & 15)]; if (!(lane & 16)) sn = -sn; }
            bf16_t* pr = PROJ + (size_t)r * INW;
            bf16_t raw[24];
#pragma unroll
            for (int hh = 0; hh < 24; ++hh) raw[hh] = pr[64 * hh + lane];
#pragma unroll
            for (int h = 0; h < 8; ++h) {
                const float x = bf2f(raw[h]); const float ss = wave_sum(x * x);
                float y = x * rsqrtf(ss * (1.f / 64.f) + EPS) * qg;
                if (lat) { const float p = __shfl_xor(y, 16); y = y * cs + p * sn; }
                if (!dry) pr[C_AQ + 64 * h + lane] = f2bf(y * (0.125f * LOG2E));
            }
#pragma unroll
            for (int h = 0; h < 8; ++h) {
                float y = bf2f(raw[12 + h]);
                if (lat) { const float p = __shfl_xor(y, 16); y = y * cs + p * sn; }
                if (!dry) pr[C_WQ + 64 * h + lane] = f2bf(y * (0.125f * LOG2E));
            }
#pragma unroll
            for (int g2 = 0; g2 < 2; ++g2) {
                const float x = bf2f(raw[8 + g2]); const float ss = wave_sum(x * x);
                float y = x * rsqrtf(ss * (1.f / 64.f) + EPS) * kg;
                if (lat) { const float p = __shfl_xor(y, 16); y = y * cs + p * sn; }
                const bf16_t vbits = raw[10 + g2];
                float yw = bf2f(raw[20 + g2]);
                if (lat) { const float p = __shfl_xor(yw, 16); yw = yw * cs + p * sn; }
                const bf16_t wvbits = raw[22 + g2];
                if (lat) {
                    KAL[((size_t)(b * 2 + g2) * 2304 + 256 + t) * 64 + lane] = f2bf(y);
                    VAL[((size_t)(b * 2 + g2) * 64 + lane) * 2304 + 256 + t] = vbits;
                    KWL[((size_t)(b * 2 + g2) * 2304 + 256 + t) * 64 + lane] = f2bf(yw);
                    VWL[((size_t)(b * 2 + g2) * 64 + lane) * 2304 + 256 + t] = wvbits;
                } else {
                    KAC[((size_t)(b * 2 + g2) * 256 + t) * 64 + lane] = f2bf(y);
                    VAC[((size_t)(b * 2 + g2) * 64 + lane) * 256 + t] = vbits;
                    KWC[((size_t)(b * 2 + g2) * 256 + t) * 64 + lane] = f2bf(yw);
                    VWC[((size_t)(b * 2 + g2) * 64 + lane) * 256 + t] = wvbits;
                    const size_t oi = ((((size_t)b * DEPTH + l) * 256 + t) * 2 + g2) * 64 + lane;
                    a.out[O_NKA + oi] = y; a.out[O_NVA + oi] = bf2f(vbits); a.out[O_NKW + oi] = yw; a.out[O_NVW + oi] = bf2f(wvbits);
                }
            }
        } else {
            const int idx = r - T, b = idx >> 8, p = idx & 255;
#pragma unroll
            for (int g2 = 0; g2 < 2; ++g2) {
                const size_t ci = ((((size_t)b * DEPTH + l) * 256 + p) * 2 + g2) * 64 + lane;
                KAL[((size_t)(b * 2 + g2) * 2304 + p) * 64 + lane] = f2bf(a.in[2][ci]);
                VAL[((size_t)(b * 2 + g2) * 64 + lane) * 2304 + p] = f2bf(a.in[3][ci]);
                KWL[((size_t)(b * 2 + g2) * 2304 + p) * 64 + lane] = f2bf(a.in[4][ci]);
                VWL[((size_t)(b * 2 + g2) * 64 + lane) * 2304 + p] = f2bf(a.in[5][ci]);
            }
        }
    }
}

DI void attn_item(unsigned char* lds, const bf16_t* qp, bf16_t* op, const bf16_t* Kb, const bf16_t* VTb, int nk, int nA, int lo, int hi, bool win, int tq, bool has_sink, float sink2, bool nomax) {
    const int tid = otid(), lane = tid & 63, h = lane >> 5, c = lane & 31;
    const int n64 = nA + (hi - lo), nit = (n64 + 1) >> 1;
    constexpr int STG = 17664;
    bf16_t* Kst0 = (bf16_t*)lds; bf16_t* Vst0 = (bf16_t*)lds + 9216;
    int qoff = (tid >> 6) * 2048 + lane * 8;
    bf16_t* qpark = (bf16_t*)lds + 2 * STG;
#pragma unroll
    for (int s = 0; s < 4; ++s) *(bf16x8*)(qpark + qoff + s * 512) = *(const bf16x8*)(qp + 16 * s + 8 * h);
    f32x16 O0, O1;
#pragma unroll
    for (int i = 0; i < 16; ++i) { O0[i] = 0.f; O1[i] = 0.f; }
    float m = 0.f, lsum = 0.f;
    const int lrow = tid >> 3, lch = tid & 7;
    u32x4 kR, vR;
#define AT_KEY0(j) (((j) < nA ? (j) : 4 + lo + ((j) - nA)) * 64)
#define AT_LOAD(it, sub) do { const int j_ = (2 * (it) + (sub) < n64) ? 2 * (it) + (sub) : 2 * (it); const int k_ = AT_KEY0(j_); \
        kR = *(const u32x4*)(Kb + (size_t)(k_ + lrow) * 64 + 8 * lch); vR = *(const u32x4*)(VTb + (size_t)lrow * nk + k_ + 8 * lch); } while (0)
#define AT_STORE(stg, sub) do { bf16_t* kd_ = Kst0 + (stg) * STG; bf16_t* vd_ = Vst0 + (stg) * STG; \
        *(u32x4*)(kd_ + (64 * (sub) + lrow) * 72 + 8 * lch) = kR; \
        *(u32x2*)(vd_ + lrow * 132 + 64 * (sub) + 8 * lch) = (u32x2){vR.x, vR.y}; *(u32x2*)(vd_ + lrow * 132 + 64 * (sub) + 8 * lch + 4) = (u32x2){vR.z, vR.w}; } while (0)
    AT_LOAD(0, 0); AT_STORE(0, 0); AT_LOAD(0, 1); AT_STORE(0, 1);
    __syncthreads();
    for (int i = 0; i < nit; ++i) {
        const int cur = i & 1;
        if (i + 1 < nit) AT_LOAD(i + 1, 0);
        const bf16_t* Kc = Kst0 + cur * STG; const bf16_t* Vc = Vst0 + cur * STG;
        f32x16 st[4];
        const float cinit = -m;
#pragma unroll
        for (int t = 0; t < 4; ++t)
#pragma unroll
            for (int ii = 0; ii < 16; ++ii) st[t][ii] = cinit;
        asm volatile("" : "+v"(qoff));
#pragma unroll
        for (int s = 0; s < 4; ++s) { const bf16x8 qv = *(const bf16x8*)(qpark + qoff + s * 512);
#pragma unroll
            for (int t = 0; t < 4; ++t) { const bf16x8 ak = *(const bf16x8*)(Kc + (32 * t + c) * 72 + 16 * s + 8 * h); st[t] = MFMA32(ak, qv, st[t]); } }
        float ps = 0.f;
        if (nomax) {
#pragma unroll
            for (int t = 0; t < 4; ++t)
#pragma unroll
                for (int ii = 0; ii < 16; ++ii) { const float p = __builtin_amdgcn_exp2f(st[t][ii]); st[t][ii] = p; ps += p; }
            lsum += ps;
        } else {
            const int ja = 2 * i, jb = 2 * i + 1;
            if (win && ja >= nA) { const int k0 = AT_KEY0(ja);
#pragma unroll
                for (int t = 0; t < 2; ++t)
#pragma unroll
                    for (int ii = 0; ii < 16; ++ii) { const int dd = tq - (k0 - 256 + 32 * t + crow(ii, h)); if (dd > 128 || dd < -128) st[t][ii] = -1e30f; } }
            if (jb >= n64) {
#pragma unroll
                for (int t = 2; t < 4; ++t)
#pragma unroll
                    for (int ii = 0; ii < 16; ++ii) st[t][ii] = -1e30f;
            } else if (win && jb >= nA) { const int k0 = AT_KEY0(jb);
#pragma unroll
                for (int t = 2; t < 4; ++t)
#pragma unroll
                    for (int ii = 0; ii < 16; ++ii) { const int dd = tq - (k0 - 256 + 32 * (t - 2) + crow(ii, h)); if (dd > 128 || dd < -128) st[t][ii] = -1e30f; } }
            float mx = -1e30f;
#pragma unroll
            for (int ii = 0; ii < 16; ++ii) mx = fmaxf(mx, fmaxf(fmaxf(st[0][ii], st[1][ii]), fmaxf(st[2][ii], st[3][ii])));
            mx = fmaxf(mx, __shfl_xor(mx, 32));
            if (i == 0) {
                const float mnew = has_sink ? fmaxf(mx, sink2) : mx;
#pragma unroll
                for (int t = 0; t < 4; ++t)
#pragma unroll
                    for (int ii = 0; ii < 16; ++ii) { const float p = __builtin_amdgcn_exp2f(st[t][ii] - mnew); st[t][ii] = p; ps += p; }
                lsum = ps + ((has_sink && h == 0) ? __builtin_amdgcn_exp2f(sink2 - mnew) : 0.f);
                m = mnew;
            } else if (__builtin_amdgcn_ballot_w64(mx > 0.f) != 0ull) {
                const float delta = fmaxf(mx, 0.f); const float alpha = __builtin_amdgcn_exp2f(-delta); m += delta;
#pragma unroll
                for (int t = 0; t < 4; ++t)
#pragma unroll
                    for (int ii = 0; ii < 16; ++ii) { const float p = __builtin_amdgcn_exp2f(st[t][ii] - delta); st[t][ii] = p; ps += p; }
                lsum = lsum * alpha + ps;
#pragma unroll
                for (int ii = 0; ii < 16; ++ii) { O0[ii] *= alpha; O1[ii] *= alpha; }
            } else {
#pragma unroll
                for (int t = 0; t < 4; ++t)
#pragma unroll
                    for (int ii = 0; ii < 16; ++ii) { const float p = __builtin_amdgcn_exp2f(st[t][ii]); st[t][ii] = p; ps += p; }
                lsum += ps;
            }
        }
        if (i + 1 < nit) { AT_STORE(cur ^ 1, 0); AT_LOAD(i + 1, 1); }
#pragma unroll
        for (int t = 0; t < 4; ++t)
#pragma unroll
            for (int s2 = 0; s2 < 2; ++s2) {
                const bf16x8 pb = pack8(st[t][8 * s2], st[t][8 * s2 + 1], st[t][8 * s2 + 2], st[t][8 * s2 + 3], st[t][8 * s2 + 4], st[t][8 * s2 + 5], st[t][8 * s2 + 6], st[t][8 * s2 + 7]);
                const bf16_t* v0p = Vc + c * 132 + 32 * t + 16 * s2 + 4 * h; const bf16_t* v1p = Vc + (32 + c) * 132 + 32 * t + 16 * s2 + 4 * h;
                O0 = MFMA32(cat44(*(const s16x4*)(v0p), *(const s16x4*)(v0p + 8)), pb, O0);
                O1 = MFMA32(cat44(*(const s16x4*)(v1p), *(const s16x4*)(v1p + 8)), pb, O1);
            }
        if (i + 1 < nit) AT_STORE(cur ^ 1, 1);
        __syncthreads();
    }
#undef AT_KEY0
#undef AT_LOAD
#undef AT_STORE
    lsum += __shfl_xor(lsum, 32);
    const float inv = 1.f / lsum;
#pragma unroll
    for (int g4 = 0; g4 < 4; ++g4) {
        u32x2 w0, w1;
        w0.x = pk2(O0[4 * g4] * inv, O0[4 * g4 + 1] * inv); w0.y = pk2(O0[4 * g4 + 2] * inv, O0[4 * g4 + 3] * inv);
        w1.x = pk2(O1[4 * g4] * inv, O1[4 * g4 + 1] * inv); w1.y = pk2(O1[4 * g4 + 2] * inv, O1[4 * g4 + 3] * inv);
        *(u32x2*)(op + 8 * g4 + 4 * h) = w0; *(u32x2*)(op + 32 + 8 * g4 + 4 * h) = w1;
    }
}
#define LAS __attribute__((address_space(3)))
#define XB_TMO      128
#define XB_XCNT(j)  (256  + 64 * (j))
#define XB_XSUB(j)  (1280 + 64 * (j))
#define XB_XGEN(j)  (2304 + 64 * (j))
#define XB_TOP      3328
#define XB_TOPGEN   3392
#define XCD_BAR_WORDS 3456
#define XB_SPIN_CAP (1u << 18)

__device__ __forceinline__ unsigned xb_ld(unsigned* p)              { return __hip_atomic_load(p, __ATOMIC_RELAXED, __HIP_MEMORY_SCOPE_AGENT); }
__device__ __forceinline__ unsigned xb_add(unsigned* p, unsigned v) { return __hip_atomic_fetch_add(p, v, __ATOMIC_RELAXED, __HIP_MEMORY_SCOPE_AGENT); }
__device__ __forceinline__ unsigned xb_xcc_id() { return (unsigned)__builtin_amdgcn_s_getreg((3 << 11) | 20) & 0xFu; }
#define XB_SPIN(cond, bar) do { unsigned _sp = 0; while (cond) { __builtin_amdgcn_s_sleep(1); \
    if ((++_sp & 255u) == 0u) { if (xb_ld(&(bar)[XB_TMO])) break; if (_sp > XB_SPIN_CAP) { atomicAdd(&(bar)[XB_TMO], 1u); break; } } } } while (0)

struct XcdBarrier {
    unsigned* bar; unsigned x;
    volatile LAS unsigned* st;
};

__device__ __forceinline__ XcdBarrier xcd_barrier_post(unsigned* bar, volatile LAS unsigned* st) {
    XcdBarrier b; b.bar = bar; b.x = xb_xcc_id(); b.st = st;
    if (threadIdx.x == 0) (void)xb_add(&bar[XB_XCNT(b.x)], 1u);
    return b;
}
__device__ __forceinline__ void xcd_barrier_complete(unsigned* bar, unsigned x, unsigned& nloc, unsigned& nx) {
    const unsigned G = gridDim.x * gridDim.y * gridDim.z;
    unsigned sum, cnt, mine, sp = 0u;
    for (;;) {
        sum = 0u; cnt = 0u; mine = 0u;
#pragma unroll
        for (unsigned j = 0; j < 16; ++j) { const unsigned c = xb_ld(&bar[XB_XCNT(j)]); sum += c; cnt += (c > 0u) ? 1u : 0u; mine = (j == x) ? c : mine; }
        if (sum == G) break;
        __builtin_amdgcn_s_sleep(1);
        if ((++sp & 255u) == 0u) { if (xb_ld(&bar[XB_TMO])) break; if (sp > XB_SPIN_CAP) { atomicAdd(&bar[XB_TMO], 1u); break; } }
    }
    nloc = mine > 0u ? mine : 1u; nx = cnt > 0u ? cnt : 1u;
}

__device__ __forceinline__ void xcd_barrier(const XcdBarrier& b) {
    asm volatile("s_waitcnt vmcnt(0)" ::: "memory");
    __syncthreads();
    if (threadIdx.x == 0) {
        unsigned* bar = b.bar;
        __builtin_amdgcn_s_waitcnt(0);
        unsigned nloc = b.st[0], nx = b.st[1];
        if (nloc == 0u) { xcd_barrier_complete(bar, b.x, nloc, nx); b.st[0] = nloc; b.st[1] = nx; }
        const unsigned old = xb_add(&bar[XB_XSUB(b.x)], 1u);
        const unsigned gen = old / nloc;
        if (old + 1u == (gen + 1u) * nloc) {
            __builtin_amdgcn_fence(__ATOMIC_RELEASE, "agent");
            asm volatile("s_waitcnt vmcnt(0)" ::: "memory");
            const unsigned og = xb_add(&bar[XB_TOP], 1u);
            const unsigned tg = og / nx;
            if (og + 1u == (tg + 1u) * nx) xb_add(&bar[XB_TOPGEN], 1u);
            else XB_SPIN(xb_ld(&bar[XB_TOPGEN]) == tg, bar);
            __builtin_amdgcn_fence(__ATOMIC_ACQUIRE, "agent");
            xb_add(&bar[XB_XGEN(b.x)], 1u);
            asm volatile("s_waitcnt vmcnt(0)" ::: "memory");
        } else {
            XB_SPIN(xb_ld(&bar[XB_XGEN(b.x)]) == gen, bar);
            __builtin_amdgcn_fence(__ATOMIC_ACQUIRE, "agent");
            asm volatile("s_waitcnt vmcnt(0)" ::: "memory");
        }
    }
    __syncthreads();
}


DI void hgrn_item(const Args& a, unsigned char* lds, int l, int seq, int hd, int dir) {
    const int tid = otid(), lane = tid & 63, w = tid >> 6, h = lane >> 5, c = lane & 31;
    const bool lat = seq < 8; const int b = lat ? seq : seq - 8; const int L = lat ? 2048 : 256; const int nch = L >> 5; const int seqbase = lat ? TC + b * 2048 : b * 256;
    bf16_t* RQ = (bf16_t*)lds; bf16_t* RZ = (bf16_t*)(lds + 8704); bf16_t* RV = (bf16_t*)(lds + 17408);
    bf16_t* QS = (bf16_t*)(lds + 26112); bf16_t* KS = (bf16_t*)(lds + 34816);
    bf16_t* KST = (bf16_t*)(lds + 43520); bf16_t* VT = (bf16_t*)(lds + 53760); float* E0 = (float*)(lds + 64000); float* E1 = E0 + 128;
    const bf16_t* PROJ = (const bf16_t*)(a.ws + WS_PROJ);
    float* OF = (float*)(a.ws + WS_OF);
    const int cq = C_HQ + 128 * hd, cz = (dir ? C_HFB : C_HFF) + 128 * hd, cv = C_HI + 128 * hd;
    const int wd = w & 3;
    const int dmy = 32 * wd + c;
    const int t0 = 16 * (w >> 2) + 8 * h;
    f32x16 S[4];
    if (w < 4) {
        if (lat) { const float* sp = a.in[6] + ((((size_t)(b * DEPTH + l) * 2 + dir) * 4 + hd) * 128) * 128;
#pragma unroll
            for (int dt = 0; dt < 4; ++dt)
#pragma unroll
                for (int ii = 0; ii < 16; ++ii) S[dt][ii] = sp[(size_t)(32 * dt + crow(ii, h)) * 128 + dmy];
        } else {
#pragma unroll
            for (int dt = 0; dt < 4; ++dt)
#pragma unroll
                for (int ii = 0; ii < 16; ++ii) S[dt][ii] = 0.f;
        }
    }
    const float lbv = ((const float*)(a.ws + WS_LB))[(l * 2 + dir) * 512 + 128 * hd + dmy];
    const float omlb = 1.f - lbv;
    u32x4 rq, rz, rv;
    const int lt = tid >> 4, lcn = tid & 15;
#define HG_GLOAD(ch) do { const int p_ = 32 * (ch) + lt, pos_ = dir ? L - 1 - p_ : p_; const bf16_t* rp_ = PROJ + (size_t)(seqbase + pos_) * INW + 8 * lcn; \
        rq = *(const u32x4*)(rp_ + cq); rz = *(const u32x4*)(rp_ + cz); rv = *(const u32x4*)(rp_ + cv); } while (0)
    HG_GLOAD(0);
    for (int ch = 0; ch < nch; ++ch) {
        *(u32x4*)(RQ + lt * 136 + 8 * lcn) = rq; *(u32x4*)(RZ + lt * 136 + 8 * lcn) = rz; *(u32x4*)(RV + lt * 136 + 8 * lcn) = rv;
        __syncthreads();
        if (ch + 1 < nch) HG_GLOAD(ch + 1);
        {
            float qv[8], kv[8], gv[8]; float qtot = 0.f;
#pragma unroll
            for (int tt = 0; tt < 8; ++tt) { const int t = t0 + tt; const float qr = bf2f(RQ[t * 136 + dmy]), z = bf2f(RZ[t * 136 + dmy]);
                const float sg = sigmoidf_(z); const float f = lbv + omlb * sg; const float g = __logf(fmaxf(f, 1e-30f));
                kv[tt] = omlb * (1.f - sg); qv[tt] = qr * sigmoidf_(qr); gv[tt] = g; qtot += g; }
            const float partner = __shfl_xor(qtot, 32);
            float e[8];
            if (w < 4) { float run = h ? 0.f : -partner;
#pragma unroll
                for (int tt = 7; tt >= 0; --tt) { e[tt] = run; run -= gv[tt]; }
                if (h == 0) E0[dmy] = __expf(qtot + partner);
            } else { float run = h ? partner : 0.f;
#pragma unroll
                for (int tt = 0; tt < 8; ++tt) { run += gv[tt]; e[tt] = run; }
                if (h == 0) E1[dmy] = __expf(qtot + partner);
            }
            float ke[8];
#pragma unroll
            for (int tt = 0; tt < 8; ++tt) { const int t = t0 + tt; const float ex = __expf(e[tt]), exn = __builtin_amdgcn_rcpf(ex);
                ke[tt] = kv[tt] * exn;
                QS[t * 136 + dmy] = f2bf(qv[tt] * ex); KS[t * 136 + dmy] = f2bf(ke[tt]); }
            *(bf16x8*)(KST + dmy * 40 + t0) = pack8(ke[0], ke[1], ke[2], ke[3], ke[4], ke[5], ke[6], ke[7]);
            bf16x8 v0;
#pragma unroll
            for (int tt = 0; tt < 8; ++tt) v0[tt] = (short)RV[(t0 + tt) * 136 + dmy];
            *(bf16x8*)(VT + dmy * 40 + t0) = v0;
        }
        __syncthreads();
        if (w < 4) {
            f32x16 st;
#pragma unroll
            for (int ii = 0; ii < 16; ++ii) st[ii] = 0.f;
#pragma unroll
            for (int s = 0; s < 8; ++s) { const bf16x8 ak = *(const bf16x8*)(KS + c * 136 + 16 * s + 8 * h), bq = *(const bf16x8*)(QS + c * 136 + 16 * s + 8 * h); st = MFMA32(ak, bq, st); }
#pragma unroll
            for (int ii = 0; ii < 16; ++ii) if (crow(ii, h) > c) st[ii] = 0.f;
            f32x16 o;
#pragma unroll
            for (int ii = 0; ii < 16; ++ii) o[ii] = 0.f;
#pragma unroll
            for (int s2 = 0; s2 < 2; ++s2) {
                const bf16x8 pb = pack8(st[8 * s2], st[8 * s2 + 1], st[8 * s2 + 2], st[8 * s2 + 3], st[8 * s2 + 4], st[8 * s2 + 5], st[8 * s2 + 6], st[8 * s2 + 7]);
                const bf16_t* vp = VT + dmy * 40 + 16 * s2 + 4 * h;
                o = MFMA32(cat44(*(const s16x4*)vp, *(const s16x4*)(vp + 8)), pb, o);
            }
#pragma unroll
            for (int dt = 0; dt < 4; ++dt) {
#pragma unroll
                for (int g4 = 0; g4 < 4; ++g4) { const f32x4 ev = *(const f32x4*)(E0 + 32 * dt + 8 * g4 + 4 * h);
                    S[dt][4 * g4] *= ev[0]; S[dt][4 * g4 + 1] *= ev[1]; S[dt][4 * g4 + 2] *= ev[2]; S[dt][4 * g4 + 3] *= ev[3]; }
#pragma unroll
                for (int s2 = 0; s2 < 2; ++s2) {
                    const bf16x8 xs = pack8(S[dt][8 * s2], S[dt][8 * s2 + 1], S[dt][8 * s2 + 2], S[dt][8 * s2 + 3], S[dt][8 * s2 + 4], S[dt][8 * s2 + 5], S[dt][8 * s2 + 6], S[dt][8 * s2 + 7]);
                    const bf16_t* qb = QS + c * 136 + 32 * dt + 16 * s2 + 4 * h;
                    o = MFMA32(xs, cat44(*(const s16x4*)qb, *(const s16x4*)(qb + 8)), o);
                }
            }
            {   const int p = 32 * ch + c, pos = dir ? L - 1 - p : p;
                float* op = OF + ((size_t)dir * T + seqbase + pos) * 512 + 128 * hd + 32 * wd;
#pragma unroll
                for (int g4 = 0; g4 < 4; ++g4) { f32x4 v; v[0] = o[4 * g4]; v[1] = o[4 * g4 + 1]; v[2] = o[4 * g4 + 2]; v[3] = o[4 * g4 + 3]; *(f32x4*)(op + 8 * g4 + 4 * h) = v; } }
#pragma unroll
            for (int dt = 0; dt < 4; ++dt) {
#pragma unroll
                for (int s2 = 0; s2 < 2; ++s2) { const bf16x8 ak = *(const bf16x8*)(KST + (32 * dt + c) * 40 + 16 * s2 + 8 * h), bv = *(const bf16x8*)(VT + dmy * 40 + 16 * s2 + 8 * h);
                    S[dt] = MFMA32(ak, bv, S[dt]); }
#pragma unroll
                for (int g4 = 0; g4 < 4; ++g4) { const f32x4 ev = *(const f32x4*)(E1 + 32 * dt + 8 * g4 + 4 * h);
                    S[dt][4 * g4] *= ev[0]; S[dt][4 * g4 + 1] *= ev[1]; S[dt][4 * g4 + 2] *= ev[2]; S[dt][4 * g4 + 3] *= ev[3]; }
            }
        }
    }
#undef HG_GLOAD
    if (!lat && w < 4) { float* sp = a.out + O_NST + ((((size_t)(b * DEPTH + l) * 2 + dir) * 4 + hd) * 128) * 128;
#pragma unroll
        for (int dt = 0; dt < 4; ++dt)
#pragma unroll
            for (int ii = 0; ii < 16; ++ii) sp[(size_t)(32 * dt + crow(ii, h)) * 128 + dmy] = S[dt][ii];
    }
}

DI void phase_mixer(const Args& a, unsigned char* lds, int l, int rep) {
    unsigned* ctl = (unsigned*)(a.ws + WS_CTL) + 16 * l + 8 * rep;
    volatile int* slot = (volatile int*)(lds + LDS_MISC);
    const int tid = otid(), lane = tid & 63, w = tid >> 6, c = lane & 31;
    bf16_t* PROJ = (bf16_t*)(a.ws + WS_PROJ);
    for (;;) {
        __syncthreads();
        if (tid == 0) *slot = (int)__hip_atomic_fetch_add(ctl, 1u, __ATOMIC_RELAXED, __HIP_MEMORY_SCOPE_AGENT);
        __syncthreads();
        const int it = *slot;
        if (it >= 1856) break;
#if PROBE_MASK & 16
        if (rep && !(it < 64 || (it >= 576 && it < 832))) continue;
#endif
#if PROBE_MASK & 32
        if (rep && (it < 64 || (it >= 576 && it < 832))) continue;
#endif
#ifndef NO_HG
        if (it < 64) { hgrn_item(a, lds, l, it >> 3, (it >> 1) & 3, it & 1); continue; }
        if (it >= 576 && it < 832) { const int idx = it - 576; hgrn_item(a, lds, l, 8 + (idx >> 3), (idx >> 1) & 3, idx & 1); continue; }
#endif
        int idx, kind;
        if (it < 576) { idx = it - 64; kind = 0; } else if (it < 1344) { idx = it - 832; kind = 1; } else if (it < 1600) { idx = it - 1344; kind = 2; } else { idx = it - 1600; kind = 3; }
        const bool lat = kind < 2, isw = kind & 1;
        int b, g, qb;
        if (lat) { b = idx >> 6; g = (idx >> 5) & 1; qb = idx & 31; } else { b = idx >> 3; g = (idx >> 2) & 1; qb = idx & 3; }
        const int r = w & 3, tq = 64 * qb + 32 * (w >> 2) + c;
        const int row = (lat ? TC + b * 2048 : b * 256) + tq;
        const bf16_t* qp = PROJ + (size_t)row * INW + (isw ? C_WQ : C_AQ) + (4 * g + r) * 64;
        bf16_t* op = (bf16_t*)(a.ws + (isw ? WS_OWIN : WS_OATT)) + (size_t)row * 512 + (4 * g + r) * 64;
        const bf16_t* Kb; const bf16_t* VTb; int nk;
        if (lat) { nk = 2304; Kb = (const bf16_t*)(a.ws + (isw ? WS_KWL : WS_KAL)) + (size_t)(b * 2 + g) * 2304 * 64; VTb = (const bf16_t*)(a.ws + (isw ? WS_VWL : WS_VAL)) + (size_t)(b * 2 + g) * 64 * 2304; }
        else { nk = 256; Kb = (const bf16_t*)(a.ws + (isw ? WS_KWC : WS_KAC)) + (size_t)(b * 2 + g) * 256 * 64; VTb = (const bf16_t*)(a.ws + (isw ? WS_VWC : WS_VAC)) + (size_t)(b * 2 + g) * 64 * 256; }
        int nA = 4, lo = 0, hi = 0; bool win = false;
        if (kind == 0) nA = 36;
        if (kind == 1) { lo = qb - 2 < 0 ? 0 : qb - 2; hi = qb + 3 > 32 ? 32 : qb + 3; win = true; }
        const float sink2 = isw ? a.in[18][l * 8 + 4 * g + r] * LOG2E : 0.f;
#ifndef NO_ATT
        attn_item(lds, qp, op, Kb, VTb, nk, nA, lo, hi, win, tq, isw, sink2, !isw);
#endif
    }
}

DI void phase_hgcomb(const Args& a, int l) {
    const int tid = otid(), lane = tid & 63, w = tid >> 6;
    const int gw = obid() * 8 + w, NGW = gridDim.x * 8;
    const float* OF = (const float*)(a.ws + WS_OF); const bf16_t* PROJ = (const bf16_t*)(a.ws + WS_PROJ); bf16_t* OHG = (bf16_t*)(a.ws + WS_OHG);
    const f32x2 gn = *(const f32x2*)(a.in[17] + l * 128 + 2 * lane);
    for (int it = gw; it < T * 4; it += NGW) {
        const int row = it >> 2, hd = it & 3;
        const f32x2 x0 = *(const f32x2*)(OF + (size_t)row * 512 + 128 * hd + 2 * lane), x1 = *(const f32x2*)(OF + ((size_t)T + row) * 512 + 128 * hd + 2 * lane);
        const float s0 = x0[0] + x1[0], s1 = x0[1] + x1[1];
        const float rstd = rsqrtf(wave_sum(s0 * s0 + s1 * s1) * (1.f / 128.f) + EPS);
        const unsigned gb = *(const unsigned*)(PROJ + (size_t)row * INW + C_HG + 128 * hd + 2 * lane);
        const float g0 = bflo(gb), g1 = bfhi(gb);
        *(unsigned*)(OHG + (size_t)row * 512 + 128 * hd + 2 * lane) = pk2(s0 * rstd * gn[0] * g0 * sigmoidf_(g0), s1 * rstd * gn[1] * g1 * sigmoidf_(g1));
    }
}

template <class Epi> DI void run_gemm(unsigned char* lds, const bf16_t* A, const bf16_t* Bt, int N, int K, const Epi& E) {
    pg8::Gemm g{A, Bt, T, N, K}; pg8::StaticOrder S; S.init(T, N, (int)gridDim.x, obid());
#if STAGGER
    {
        const unsigned long long t0 = __builtin_amdgcn_s_memrealtime();
        const unsigned long long dly = (unsigned long long)((obid() >> 3) & 7) * (unsigned long long)(STAGGER * (K / 64));
        while (__builtin_amdgcn_s_memrealtime() - t0 < dly) __builtin_amdgcn_s_sleep(4);
    }
#endif
    pg8::gemm_phase<Epi, pg8::StaticOrder, false>((PG8_LAS unsigned char*)lds, g, S, E, nullptr);
}

__global__ void __launch_bounds__(512, 2) mk_fwd(Args a) {
    extern __shared__ __attribute__((aligned(16))) unsigned char lds[];
    cg::grid_group grid = cg::this_grid();
    {   volatile LAS unsigned* st = (volatile LAS unsigned*)((LAS unsigned char*)lds + LDS_MISC + 16);
        if (threadIdx.x < 2) st[threadIdx.x] = 0u;
        __syncthreads(); }
    const XcdBarrier bar = xcd_barrier_post((unsigned*)(a.ws + WS_BAR), (volatile LAS unsigned*)((LAS unsigned char*)lds + LDS_MISC + 16));
    bf16_t* HB = (bf16_t*)(a.ws + WS_HB); bf16_t* PROJ = (bf16_t*)(a.ws + WS_PROJ); bf16_t* ACT = PROJ;
    float* M32 = (float*)(a.ws + WS_OF);
    for (int ph = a.ph_lo; ph < a.ph_hi; ++ph) {
        if (ph > a.ph_lo) { if (ph == a.ph_lo + 1) grid.sync(); else xcd_barrier(bar);
#if PROBE_MASK & 8
            xcd_barrier(bar); xcd_barrier(bar);
#endif
        }
#ifndef NO_P0
        if (ph == 0) { phase_p0(a, lds); __syncthreads(); phase_wconv(a, lds, 0, 0, 13312, obid(), (int)gridDim.x); continue; }
#endif
#ifndef NO_C0
        if (ph == NPH - 1) { phase_final(a); continue; }
#endif
        const int l = (ph - 1) / 13, k = (ph - 1) % 13;
        int reps = 1;
        if ((PROBE_MASK & 1) && (k == 0 || k == 3 || k == 10 || k == 7)) reps = 2;
        if ((PROBE_MASK & 2) && (k == 1 || k == 11 || k == 4 || k == 8)) reps = 2;
        if ((PROBE_MASK & (4 | 16 | 32)) && k == 6) reps = 2;
        if ((PROBE_MASK & (64 | 128)) && (k == 1 || k == 11)) reps = 2;
        if ((PROBE_MASK & 256) && k == 4) reps = 2;
        if ((PROBE_MASK & 2048) && k == 5) reps = 2;
        if ((PROBE_MASK & 512) && k == 8) reps = 2;
        if ((PROBE_MASK & 1024) && (k == 2 || k == 9 || k == 12)) reps = 2;
        for (int rep = 0; rep < reps; ++rep) {
        if (rep) xcd_barrier(bar);
        const float* MODL = (const float*)(a.ws + WS_MOD) + (size_t)l * 9 * NMODW;
        const float* xa = a.out; const float* xb = a.out + (size_t)TC * DM;
        const unsigned char* wb = a.ws + WS_W + (size_t)(l & 1) * WSZ;
        const bf16_t* WFI = (const bf16_t*)(wb + W_FI); const bf16_t* WFO = (const bf16_t*)(wb + W_FO);
        if (k == 100) {}
#ifndef NO_C0
        else if (k == 0) { phase_norm(a, l, 0, l == 0); }
        else if (k == 3 || k == 10) { phase_norm(a, l, k == 3 ? 1 : 2, false); }
#endif
#ifndef NO_G_SW
        else if (k == 1 || k == 11) { run_gemm(lds, HB, k == 1 ? WFI : WFI + (size_t)5632 * 1024, 2 * DFF, ((PROBE_MASK & 128) && rep == 0) ? 512 : DM, pg8::EpiSwiglu{ACT}); }
#endif
#ifndef NO_G_RES
        else if (k == 2 || k == 9 || k == 12) {
            if (k == 2 && l == 0) { xa = a.in[0]; xb = a.in[1]; }
            const bf16_t* A = k == 9 ? HB : ACT; const bf16_t* Bt = k == 9 ? (const bf16_t*)(wb + W_OUT) : (k == 2 ? WFO : WFO + (size_t)1024 * DFF);
            const int K = k == 9 ? DM : DFF; const int gi = k == 2 ? 2 : (k == 9 ? 5 : 8);
            run_gemm(lds, A, Bt, DM, K, pg8::EpiResid{xa, xb, ((PROBE_MASK & 1024) && rep == 0) ? (float*)(a.ws + WS_OF) : a.out, MODL + gi * DM, k == 9 ? 1.0f : 0.5f});
            if (l + 1 < DEPTH && rep == reps - 1) {
                const int G = (int)gridDim.x, cb = obid();
                const int i0 = k == 2 ? 0 : (k == 9 ? 6000 : 7312), i1 = k == 2 ? 6000 : (k == 9 ? 7312 : 13312);
                if (G == 256) { if (cb >= 128) phase_wconv(a, lds, l + 1, i0, i1, cb - 128, 128); }
                else phase_wconv(a, lds, l + 1, i0, i1, cb, G);
            }
        }
#endif
#ifndef NO_G_BF
        else if (k == 4) { run_gemm(lds, HB, (const bf16_t*)(wb + W_IN), INW, DM, pg8::EpiBf16P{PROJ, INW}); }
#endif
#ifndef NO_PREP
        else if (k == 5) { phase_prep(a, l, (PROBE_MASK & 2048) && rep == 0); }
#endif
#ifndef NO_MIX
        else if (k == 6) { phase_mixer(a, lds, l, rep); }
#endif
#ifndef NO_C0
        else if (k == 7) { phase_hgcomb(a, l); }
#endif
#ifndef NO_G_BR
        else if (k == 8) {
            const bf16_t* WBR = (const bf16_t*)(wb + W_BR);
            for (int kk = 0; kk < 3; ++kk) {
                const bf16_t* A = (const bf16_t*)(a.ws + (kk == 0 ? WS_OATT : (kk == 1 ? WS_OHG : WS_OWIN)));
                run_gemm(lds, A, WBR + (size_t)kk * 1024 * 512, DM, 512, pg8::EpiBranch{PROJ + C_GA + 1024 * kk, M32, HB, kk});
            }
        }
#endif
        }
    }
}

#ifndef MK_PER_PHASE
#define MK_PER_PHASE 0
#endif
extern "C" void kernel_launch(void* const* d_in, const int* in_sizes, int n_in, void* d_out, int out_size, void* d_ws, size_t ws_size, hipStream_t stream) {
    static int grid = 0;
    if (!grid) {
        if (n_in != 22 || ws_size < WS_END) { fprintf(stderr, "kernel_launch: unexpected n_in %d or ws_size %zu < %zu\n", n_in, ws_size, (size_t)WS_END); grid = -1; return; }
        int dev = 0, cus = 0, per_cu = 0;
        (void)hipGetDevice(&dev); (void)hipDeviceGetAttribute(&cus, hipDeviceAttributeMultiprocessorCount, dev);
        if (hipFuncSetAttribute((const void*)mk_fwd, hipFuncAttributeMaxDynamicSharedMemorySize, LDS_BYTES) != hipSuccess) { fprintf(stderr, "kernel_launch: hipFuncSetAttribute failed\n"); grid = -1; return; }
        (void)hipOccupancyMaxActiveBlocksPerMultiprocessor(&per_cu, mk_fwd, 512, LDS_BYTES);
        if (per_cu < 1) per_cu = 1;
        grid = cus * per_cu; if (grid > 256) grid = 256;
    }
    if (grid < 0) return;
    (void)hipMemsetAsync((char*)d_ws + WS_CTL, 0, CTL_BYTES, stream);
    Args a{};
    for (int i = 0; i < 22; ++i) a.in[i] = (const float*)d_in[i];
    a.out = (float*)d_out; a.ws = (unsigned char*)d_ws;
#if MK_PER_PHASE
    for (int ph = 0; ph < NPH; ++ph) { a.ph_lo = ph; a.ph_hi = ph + 1; hipLaunchKernelGGL(mk_fwd, dim3(grid), dim3(512), LDS_BYTES, stream, a); }
#else
    a.ph_lo = 0; a.ph_hi = NPH;
    void* args[] = {&a};
    hipError_t e = hipLaunchCooperativeKernel((void*)mk_fwd, dim3(grid), dim3(512), args, LDS_BYTES, stream);
    if (e != hipSuccess) fprintf(stderr, "cooperative launch failed: %s (grid %d)\n", hipGetErrorString(e), grid);
#endif
}
```

```cpp
#include <hip/hip_runtime.h>
#include <hip/hip_cooperative_groups.h>
#include <cstdio>
#include <cstdint>
namespace cg = cooperative_groups;

#ifndef PROBE_MASK
#define PROBE_MASK 0
#endif
#ifndef STAGGER
#define STAGGER 0
#endif
#define DI __device__ __forceinline__
typedef unsigned short bf16_t;
typedef short bf16x8 __attribute__((ext_vector_type(8)));
typedef short s16x4 __attribute__((ext_vector_type(4)));
typedef float f32x2 __attribute__((ext_vector_type(2)));
typedef float f32x4 __attribute__((ext_vector_type(4)));
typedef float f32x16 __attribute__((ext_vector_type(16)));
typedef unsigned u32x2 __attribute__((ext_vector_type(2)));
typedef unsigned u32x4 __attribute__((ext_vector_type(4)));
typedef __bf16 bf16x2n __attribute__((ext_vector_type(2)));

DI int otid() { int t = threadIdx.x; asm volatile("" : "+v"(t)); return t; }
DI int obid() { int b = blockIdx.x; asm volatile("" : "+s"(b)); return b; }
DI unsigned pk2(float lo, float hi) { f32x2 v = {lo, hi}; return __builtin_bit_cast(unsigned, __builtin_convertvector(v, bf16x2n)); }
DI float bflo(unsigned u) { return __uint_as_float(u << 16); }
DI float bfhi(unsigned u) { return __uint_as_float(u & 0xffff0000u); }
DI float bf2f(bf16_t b) { return __uint_as_float(((unsigned)b) << 16); }
DI bf16_t f2bf(float f) { return (bf16_t)(pk2(f, 0.f) & 0xffffu); }
DI float sigmoidf_(float x) { return __builtin_amdgcn_rcpf(1.f + __expf(-x)); }
DI float wave_sum(float v) {
#pragma unroll
    for (int o = 1; o < 64; o <<= 1) v += __shfl_xor(v, o);
    return v;
}
#define MFMA32(a, b, c) __builtin_amdgcn_mfma_f32_32x32x16_bf16((a), (b), (c), 0, 0, 0)
DI bf16x8 pack8(float a0, float a1, float a2, float a3, float a4, float a5, float a6, float a7) {
    u32x4 p; p.x = pk2(a0, a1); p.y = pk2(a2, a3); p.z = pk2(a4, a5); p.w = pk2(a6, a7); return __builtin_bit_cast(bf16x8, p);
}
DI bf16x8 cat44(s16x4 lo, s16x4 hi) { return __builtin_shufflevector(lo, hi, 0, 1, 2, 3, 4, 5, 6, 7); }

constexpr int DM = 1024, DEPTH = 4, TC = 8192, TL = 16384, T = 24576, DFF = 2816, INW = 7168, NMODW = 9216;
constexpr int C_AQ = 0, C_AK = 512, C_AV = 640, C_WQ = 768, C_WK = 1280, C_WV = 1408, C_HQ = 1536, C_HFF = 2048, C_HFB = 2560, C_HI = 3072, C_HG = 3584, C_GA = 4096;
constexpr float EPS = 1e-6f, LOG2E = 1.4426950408889634f;
constexpr size_t O_X = 0, O_NKA = 25165824, O_NVA = 29360128, O_NKW = 33554432, O_NVW = 37748736, O_NST = 41943040;
constexpr size_t al256(size_t x) { return (x + 255) & ~(size_t)255; }
constexpr size_t WS_CTL = 0;
constexpr size_t WS_BAR = 4096;
constexpr size_t CTL_BYTES = 32768;
constexpr size_t WS_MOD = CTL_BYTES;
constexpr size_t WS_LB = WS_MOD + al256((size_t)DEPTH * 9 * NMODW * 4);
constexpr size_t WS_ROPE = WS_LB + 16384;
constexpr size_t WSZ = (size_t)(2 * 5632 * 1024 + 2 * 1024 * 2816 + 7168 * 1024 + 3 * 1024 * 512 + 1024 * 1024) * 2;
constexpr size_t WS_W = WS_ROPE + 8192;
constexpr size_t W_FI = 0;
constexpr size_t W_FO = W_FI + (size_t)2 * 5632 * 1024 * 2;
constexpr size_t W_IN = W_FO + (size_t)2 * 1024 * 2816 * 2;
constexpr size_t W_BR = W_IN + (size_t)7168 * 1024 * 2;
constexpr size_t W_OUT = W_BR + (size_t)3 * 1024 * 512 * 2;
constexpr size_t WS_HB = WS_W + 2 * WSZ;
constexpr size_t WS_PROJ = WS_HB + (size_t)T * 1024 * 2;
constexpr size_t WS_OATT = WS_PROJ + (size_t)T * INW * 2;
constexpr size_t WS_OHG = WS_OATT + (size_t)T * 512 * 2;
constexpr size_t WS_OWIN = WS_OHG + (size_t)T * 512 * 2;
constexpr size_t WS_OF = WS_OWIN + (size_t)T * 512 * 2;
constexpr size_t WS_KAL = WS_OF + (size_t)2 * T * 512 * 4;
constexpr size_t SZ_KL = (size_t)8 * 2 * 2304 * 64 * 2, SZ_KC = (size_t)32 * 2 * 256 * 64 * 2;
constexpr size_t WS_VAL = WS_KAL + SZ_KL;
constexpr size_t WS_KWL = WS_VAL + SZ_KL;
constexpr size_t WS_VWL = WS_KWL + SZ_KL;
constexpr size_t WS_KAC = WS_VWL + SZ_KL;
constexpr size_t WS_VAC = WS_KAC + SZ_KC;
constexpr size_t WS_KWC = WS_VAC + SZ_KC;
constexpr size_t WS_VWC = WS_KWC + SZ_KC;
constexpr size_t WS_END = WS_VWC + SZ_KC;
constexpr int LDS_BYTES = 160 * 1024, LDS_MISC = 159 * 1024;
constexpr int NPH = 1 + 13 * DEPTH + 1;

struct Args { const float* in[22]; float* out; unsigned char* ws; int ph_lo, ph_hi; };

namespace pg8 {
#define PG8_LAS __attribute__((address_space(3)))
typedef unsigned short bf16_t;
typedef short bf16x8 __attribute__((ext_vector_type(8)));
typedef float f32x4 __attribute__((ext_vector_type(4)));
typedef unsigned u32x4 __attribute__((ext_vector_type(4)));
constexpr int BM = 256, BK = 64, HALF = 128, HTB = HALF * BK * 2  , STAGE_BYTES = 8 * HTB, NXCD = 8, WGM = 8;

__host__ __device__ __forceinline__ int lds_byte(int r, int c) { const int st = (r >> 4) * 2 + (c >> 5), rr = r & 15, cc = c & 31, ob = rr * 64 + cc * 2; return st * 1024 + (ob ^ (((ob >> 9) & 1) << 5)); }
__host__ __device__ __forceinline__ void stage_rc(int b, int& R, int& C) { const int st = b / 1024, sb = b % 1024, swz = sb ^ (((sb >> 9) & 1) << 5); R = (st >> 1) * 16 + swz / 64; C = (st & 1) * 32 + (swz % 64) / 2; }
__host__ __device__ __forceinline__ int perm32(int rho) { const int n = rho >> 4, i = rho & 15; return 8 * (i >> 2) + 4 * n + (i & 3); }

struct Unit { int pm, pn; };
struct Gemm { const bf16_t* A; const bf16_t* Bt; int M, N, K; };

struct StaticOrder {
    int nM, nN, nwg, G, c;
    __host__ __device__ void init(int M, int N, int G_, int c_) { nM = M / BM; nN = N / BM; nwg = nM * nN; G = G_; c = c_; }
    __host__ __device__ bool next(int i, Unit& u) const {
        const long L = (long)i * G + c; if (L >= nwg) return false;
        int wgid = (int)L; { const int q = nwg / NXCD, r = nwg % NXCD, xcd = wgid % NXCD, off = wgid / NXCD; wgid = (xcd < r ? xcd * (q + 1) : r * (q + 1) + (xcd - r) * q) + off; }
        const int nig = WGM * nN, gid = wgid / nig, fm = gid * WGM, gsz = (nM - fm) < WGM ? (nM - fm) : WGM;
        u.pm = fm + ((wgid % nig) % gsz); u.pn = (wgid % nig) / gsz; return true;
    }
    __device__ __forceinline__ void a_ready(const Unit&) const {}
    __device__ __forceinline__ void done(const Unit&) const {}
};
struct EpiBf16P {
    static constexpr bool PERM = true, AFTER_DRAIN = false;
    bf16_t* O; int ldc;
    __device__ __forceinline__ void operator()(const f32x4 (&acc)[2][2][4][2], const Unit& u, int wr, int wc, int fr, int fq) const {
        const int row0 = u.pm * BM + wr * 64 + fr, col0 = u.pn * BM + wc * 32 + 8 * fq;
#pragma unroll
        for (int ai = 0; ai < 2; ++ai)
#pragma unroll
            for (int m = 0; m < 4; ++m) { bf16_t* rowp = O + (size_t)(row0 + ai * HALF + m * 16) * ldc + col0;
#pragma unroll
                for (int bj = 0; bj < 2; ++bj) { const f32x4 v0 = acc[ai][bj][m][0], v1 = acc[ai][bj][m][1];
                    u32x4 w; w.x = pk2(v0[0], v0[1]); w.y = pk2(v0[2], v0[3]); w.z = pk2(v1[0], v1[1]); w.w = pk2(v1[2], v1[3]);
                    *(u32x4*)(rowp + bj * HALF) = w; } }
    }
};
struct EpiSwiglu {
    static constexpr bool PERM = true, AFTER_DRAIN = false;
    bf16_t* O;
    __device__ __forceinline__ void operator()(const f32x4 (&acc)[2][2][4][2], const Unit& u, int wr, int wc, int fr, int fq) const {
        const int row0 = u.pm * BM + wr * 64 + fr, col0 = u.pn * HALF + wc * 32 + 8 * fq;
#pragma unroll
        for (int ai = 0; ai < 2; ++ai)
#pragma unroll
            for (int m = 0; m < 4; ++m) { bf16_t* rowp = O + (size_t)(row0 + ai * HALF + m * 16) * DFF + col0;
                float r[8];
#pragma unroll
                for (int n = 0; n < 2; ++n)
#pragma unroll
                    for (int j = 0; j < 4; ++j) { const float g = acc[ai][0][m][n][j], up = acc[ai][1][m][n][j]; r[4 * n + j] = g * __builtin_amdgcn_rcpf(1.f + __expf(-g)) * up; }
                u32x4 w; w.x = pk2(r[0], r[1]); w.y = pk2(r[2], r[3]); w.z = pk2(r[4], r[5]); w.w = pk2(r[6], r[7]);
                *(u32x4*)rowp = w; }
    }
};
struct EpiResid {
    static constexpr bool PERM = false, AFTER_DRAIN = false;
    const float* xa; const float* xb; float* out; const float* mod; float coef;
    __device__ __forceinline__ void operator()(const f32x4 (&acc)[2][2][4][2], const Unit& u, int wr, int wc, int fr, int fq) const {
        const int row0 = u.pm * BM + wr * 64 + fr, col0 = u.pn * BM + wc * 32 + 4 * fq;
        const int trow = u.pm * BM; const int cond = trow < TC ? 8 : ((trow - TC) >> 11);
        const float* bbase = trow < TC ? xa + (size_t)row0 * DM : xb + (size_t)(row0 - TC) * DM; const float* mp = mod + (size_t)cond * NMODW;
        f32x4 g[2][2];
#pragma unroll
        for (int bj = 0; bj < 2; ++bj)
#pragma unroll
            for (int n = 0; n < 2; ++n) g[bj][n] = coef * *(const f32x4*)(mp + col0 + bj * HALF + n * 16);
#pragma unroll
        for (int ai = 0; ai < 2; ++ai) {
            f32x4 bv[4][2][2];
#pragma unroll
            for (int m = 0; m < 4; ++m)
#pragma unroll
                for (int bj = 0; bj < 2; ++bj)
#pragma unroll
                    for (int n = 0; n < 2; ++n) bv[m][bj][n] = *(const f32x4*)(bbase + (size_t)(ai * HALF + m * 16) * DM + col0 + bj * HALF + n * 16);
#pragma unroll
            for (int m = 0; m < 4; ++m) { float* op = out + (size_t)(row0 + ai * HALF + m * 16) * DM + col0;
#pragma unroll
                for (int bj = 0; bj < 2; ++bj)
#pragma unroll
                    for (int n = 0; n < 2; ++n) *(f32x4*)(op + bj * HALF + n * 16) = bv[m][bj][n] + g[bj][n] * acc[ai][bj][m][n]; }
        }
    }
};
struct EpiBranch {
    static constexpr bool PERM = true, AFTER_DRAIN = false;
    const bf16_t* gate; float* acc32; bf16_t* outbf; int mode;
    __device__ __forceinline__ void operator()(const f32x4 (&acc)[2][2][4][2], const Unit& u, int wr, int wc, int fr, int fq) const {
        const int row0 = u.pm * BM + wr * 64 + fr, col0 = u.pn * BM + wc * 32 + 8 * fq;
#pragma unroll
        for (int ai = 0; ai < 2; ++ai) {
            u32x4 gv[4][2], pv[4][2];
#pragma unroll
            for (int m = 0; m < 4; ++m)
#pragma unroll
                for (int bj = 0; bj < 2; ++bj) { const int row = row0 + ai * HALF + m * 16, c = col0 + bj * HALF;
                    gv[m][bj] = *(const u32x4*)(gate + (size_t)row * INW + c);
                    if (mode != 0) pv[m][bj] = *(const u32x4*)(outbf + (size_t)row * DM + c); else pv[m][bj] = (u32x4){0u, 0u, 0u, 0u}; }
#pragma unroll
            for (int m = 0; m < 4; ++m)
#pragma unroll
                for (int bj = 0; bj < 2; ++bj) { const int row = row0 + ai * HALF + m * 16, c = col0 + bj * HALF;
                    const u32x4 g = gv[m][bj], p = pv[m][bj];
                    float v[8];
                    v[0] = sigmoidf_(bflo(g.x)) * acc[ai][bj][m][0][0] + bflo(p.x); v[1] = sigmoidf_(bfhi(g.x)) * acc[ai][bj][m][0][1] + bfhi(p.x);
                    v[2] = sigmoidf_(bflo(g.y)) * acc[ai][bj][m][0][2] + bflo(p.y); v[3] = sigmoidf_(bfhi(g.y)) * acc[ai][bj][m][0][3] + bfhi(p.y);
                    v[4] = sigmoidf_(bflo(g.z)) * acc[ai][bj][m][1][0] + bflo(p.z); v[5] = sigmoidf_(bfhi(g.z)) * acc[ai][bj][m][1][1] + bfhi(p.z);
                    v[6] = sigmoidf_(bflo(g.w)) * acc[ai][bj][m][1][2] + bflo(p.w); v[7] = sigmoidf_(bfhi(g.w)) * acc[ai][bj][m][1][3] + bfhi(p.w);
                    u32x4 w; w.x = pk2(v[0], v[1]); w.y = pk2(v[2], v[3]); w.z = pk2(v[4], v[5]); w.w = pk2(v[6], v[7]);
                    *(u32x4*)(outbf + (size_t)row * DM + c) = w; }
        }
    }
};

template <class Epi, class Sched, bool STAMP = false>
__device__ __forceinline__ void gemm_phase(PG8_LAS unsigned char* lds, const Gemm g, const Sched& S, const Epi& E, unsigned long long* stamps) {
    const int tid = otid(), wid = __builtin_amdgcn_readfirstlane(tid >> 6), lane = tid & 63, wr = wid >> 2, wc = wid & 3, fr = lane & 15, fq = lane >> 4;
    const int K = g.K, nt = K / BK;
    int ts_lo = 0, ts_hi = 0, nts = 0; const unsigned long long rt_entry = STAMP ? (unsigned long long)wall_clock64() : 0ull;
#define PG8_STAMP() do { if (STAMP && wid == 0 && nts < 64) { const unsigned long long _c = (unsigned long long)clock64(); \
        ts_lo = (lane == nts) ? (int)(unsigned)_c : ts_lo; ts_hi = (lane == nts) ? (int)(unsigned)(_c >> 32) : ts_hi; ++nts; } } while (0)
    PG8_STAMP();
    unsigned voffA[2], voffB[2];
#pragma unroll
    for (int i = 0; i < 2; ++i) { int R, C; stage_rc(tid * 16 + i * 8192, R, C); const int Rb = Epi::PERM ? ((R & ~31) + perm32(R & 31)) : R;
        voffA[i] = (unsigned)(R * K + C) * 2u; voffB[i] = (unsigned)(Rb * K + C) * 2u; }
    const size_t kstep = (size_t)(BK * 2);
    const size_t hstep = (size_t)HALF * K * 2;
    const size_t tstep = 2 * hstep;
    const unsigned ldsw = (unsigned)wid * 1024u;
    const int aoff = lds_byte(wr * 64 + fr, fq * 8), boff = lds_byte(wc * 32 + fr, fq * 8);
#define PG8_SA(b, h) (((b) * 2 + (h)) * HTB)
#define PG8_SB(b, h) ((4 + (b) * 2 + (h)) * HTB)
#define PG8_STAGE(bufoff, gbase, voff) do { _Pragma("unroll") for (int _i = 0; _i < 2; ++_i) \
        __builtin_amdgcn_global_load_lds((const unsigned*)((const char*)(gbase) + (voff)[_i]), (PG8_LAS unsigned*)(lds + (bufoff) + ldsw + _i * 8192), 16, 0, 0); } while (0)
#define PG8_LDA(dst, b, h) do { _Pragma("unroll") for (int m = 0; m < 4; ++m) _Pragma("unroll") for (int k = 0; k < 2; ++k) dst[m][k] = *(const PG8_LAS bf16x8*)(lds + PG8_SA(b, h) + aoff + m * 2048 + k * 1024); } while (0)
#define PG8_LDB(dst, b, h) do { _Pragma("unroll") for (int n = 0; n < 2; ++n) _Pragma("unroll") for (int k = 0; k < 2; ++k) dst[n][k] = *(const PG8_LAS bf16x8*)(lds + PG8_SB(b, h) + boff + n * 2048 + k * 1024); } while (0)
#define PG8_MMA(ai, bj, At, Bt) do { __builtin_amdgcn_s_setprio(1); _Pragma("unroll") for (int m = 0; m < 4; ++m) _Pragma("unroll") for (int n = 0; n < 2; ++n) _Pragma("unroll") for (int k = 0; k < 2; ++k) \
        acc[ai][bj][m][n] = __builtin_amdgcn_mfma_f32_16x16x32_bf16(Bt[n][k], At[m][k], acc[ai][bj][m][n], 0, 0, 0); __builtin_amdgcn_s_setprio(0); } while (0)
#define PG8_WAIT_V(n) asm volatile("s_waitcnt vmcnt(" #n ")" ::: "memory")
#define PG8_WAIT_L(n) asm volatile("s_waitcnt lgkmcnt(" #n ")" ::: "memory")
#define PG8_BAR __builtin_amdgcn_s_barrier()
#define PG8_SCHED __builtin_amdgcn_sched_barrier(0)
    Unit cur, nxt; int ui = 0;
    if (!S.next(0, cur)) return;
    f32x4 acc[2][2][4][2];
#pragma unroll
    for (int a = 0; a < 2; ++a)
#pragma unroll
        for (int b = 0; b < 2; ++b)
#pragma unroll
            for (int m = 0; m < 4; ++m)
#pragma unroll
                for (int n = 0; n < 2; ++n) acc[a][b][m][n] = (f32x4){0.f, 0.f, 0.f, 0.f};
    bf16x8 At[4][2], B0[2][2], B1[2][2];
    const char* cA = (const char*)g.A + (size_t)cur.pm * tstep; const char* cB = (const char*)g.Bt + (size_t)cur.pn * tstep;
    S.a_ready(cur);
    PG8_STAGE(PG8_SB(0, 0), cB, voffB); PG8_STAGE(PG8_SA(0, 0), cA, voffA); PG8_STAGE(PG8_SB(0, 1), cB + hstep, voffB); PG8_STAGE(PG8_SA(0, 1), cA + hstep, voffA);
    if (wr == 1) PG8_BAR;
    PG8_WAIT_V(4); PG8_BAR;
    PG8_STAGE(PG8_SB(1, 0), cB + kstep, voffB); PG8_STAGE(PG8_SA(1, 0), cA + kstep, voffA); PG8_STAGE(PG8_SB(1, 1), cB + hstep + kstep, voffB);
    PG8_WAIT_V(6); PG8_BAR;
    PG8_STAMP();
    for (;;) {
        const bool has_next = S.next(ui + 1, nxt);
        const char* nA = has_next ? (const char*)g.A + (size_t)nxt.pm * tstep : cA; const char* nB = has_next ? (const char*)g.Bt + (size_t)nxt.pn * tstep : cB;
        for (int t = 0; t < nt; t += 2) {
            const bool last = (t == nt - 2);
            const char* a1 = cA + (size_t)(t + 1) * kstep;
            const char* a2 = last ? nA : cA + (size_t)(t + 2) * kstep; const char* b2 = last ? nB : cB + (size_t)(t + 2) * kstep;
            const char* a3 = a2 + kstep; const char* b3 = b2 + kstep;
            if (last && has_next) S.a_ready(nxt);
            PG8_LDB(B0, 0, 0); PG8_SCHED; PG8_LDA(At, 0, 0); PG8_STAGE(PG8_SA(1, 1), a1 + hstep, voffA);
            PG8_WAIT_L(8); PG8_BAR; PG8_WAIT_L(0); PG8_MMA(0, 0, At, B0); PG8_BAR; PG8_SCHED;
            PG8_LDB(B1, 0, 1); PG8_STAGE(PG8_SB(0, 0), b2, voffB);
            PG8_BAR; PG8_WAIT_L(0); PG8_MMA(0, 1, At, B1); PG8_BAR;
            PG8_LDA(At, 0, 1); PG8_STAGE(PG8_SA(0, 0), a2, voffA);
            PG8_BAR; PG8_WAIT_L(0); PG8_MMA(1, 0, At, B0); PG8_BAR; PG8_SCHED;
            PG8_STAGE(PG8_SB(0, 1), b2 + hstep, voffB);
            PG8_WAIT_V(6); PG8_BAR; PG8_MMA(1, 1, At, B1); PG8_BAR;
            PG8_LDB(B0, 1, 0); PG8_SCHED; PG8_LDA(At, 1, 0); PG8_STAGE(PG8_SA(0, 1), a2 + hstep, voffA);
            PG8_WAIT_L(8); PG8_BAR; PG8_WAIT_L(0); PG8_MMA(0, 0, At, B0); PG8_BAR; PG8_SCHED;
            PG8_LDB(B1, 1, 1); PG8_STAGE(PG8_SB(1, 0), b3, voffB);
            PG8_BAR; PG8_WAIT_L(0); PG8_MMA(0, 1, At, B1); PG8_BAR;
            PG8_LDA(At, 1, 1); PG8_STAGE(PG8_SA(1, 0), a3, voffA);
            PG8_BAR; PG8_WAIT_L(0); PG8_MMA(1, 0, At, B0); PG8_BAR; PG8_SCHED;
            PG8_STAGE(PG8_SB(1, 1), b3 + hstep, voffB);
            PG8_WAIT_V(6); PG8_BAR; PG8_MMA(1, 1, At, B1); PG8_BAR;
        }
        PG8_STAMP();
        if constexpr (!Epi::AFTER_DRAIN) { E(acc, cur, wr, wc, fr, fq); S.done(cur); }
        PG8_STAMP();
        if (!has_next) break;
#pragma unroll
        for (int a = 0; a < 2; ++a)
#pragma unroll
            for (int b = 0; b < 2; ++b)
#pragma unroll
                for (int m = 0; m < 4; ++m)
#pragma unroll
                    for (int n = 0; n < 2; ++n) acc[a][b][m][n] = (f32x4){0.f, 0.f, 0.f, 0.f};
        cur = nxt; cA = nA; cB = nB; ++ui;
    }
    PG8_WAIT_V(0);
    if (wr == 0) PG8_BAR;
    PG8_BAR;
    if constexpr (Epi::AFTER_DRAIN) { E.fused(acc, cur, wr, wc, fr, fq, lds, wid, lane); S.done(cur); }
    PG8_STAMP();
    if (STAMP && wid == 0) { stamps[lane] = lane < nts ? (((unsigned long long)(unsigned)ts_hi << 32) | (unsigned)ts_lo) : 0ull;
        if (lane == 62) stamps[62] = rt_entry; if (lane == 63) stamps[63] = (unsigned long long)wall_clock64(); }
#undef PG8_STAMP
#undef PG8_SA
#undef PG8_SB
#undef PG8_STAGE
#undef PG8_LDA
#undef PG8_LDB
#undef PG8_MMA
#undef PG8_WAIT_V
#undef PG8_WAIT_L
#undef PG8_BAR
#undef PG8_SCHED
}
}
DI int crow(int i, int h) { return (i & 3) + 8 * (i >> 2) + 4 * h; }
#define LDS_WAIT() asm volatile("s_waitcnt lgkmcnt(0)" ::: "memory")


DI void phase_p0(const Args& a, unsigned char* lds) {
    float* s = (float*)lds; float* red = (float*)(lds + 36864);
    const int tid = otid(), lane = tid & 63, w = tid >> 6;
    float* MOD = (float*)(a.ws + WS_MOD);
    if ((int)blockIdx.x < 144) {
        const float* c = a.in[7]; const float* cctx = a.in[8];
        for (int i = tid; i < 9 * 1024; i += 512) { const int ci = i >> 10, k = i & 1023; const float v = ci < 8 ? c[ci * 1024 + k] : cctx[k]; s[i] = v * sigmoidf_(v); }
        __syncthreads();
        for (int item = blockIdx.x; item < 144; item += gridDim.x) {
            const int l = item / 36, cc = item % 36;
            const float* W = a.in[9] + (size_t)l * 1024 * NMODW + cc * 256 + 4 * lane;
            f32x4 acc[9];
#pragma unroll
            for (int ci = 0; ci < 9; ++ci) acc[ci] = (f32x4){0.f, 0.f, 0.f, 0.f};
#pragma unroll 2
            for (int k4 = 0; k4 < 32; ++k4) {
                const int k = w * 128 + k4 * 4;
                const f32x4 w0 = *(const f32x4*)(W + (size_t)(k + 0) * NMODW), w1 = *(const f32x4*)(W + (size_t)(k + 1) * NMODW),
                            w2 = *(const f32x4*)(W + (size_t)(k + 2) * NMODW), w3 = *(const f32x4*)(W + (size_t)(k + 3) * NMODW);
#pragma unroll
                for (int ci = 0; ci < 9; ++ci) { const f32x4 sv = *(const f32x4*)(s + ci * 1024 + k); acc[ci] += sv[0] * w0 + sv[1] * w1 + sv[2] * w2 + sv[3] * w3; }
            }
#pragma unroll
            for (int ci = 0; ci < 9; ++ci) *(f32x4*)(red + ((w * 9 + ci) * 256 + 4 * lane)) = acc[ci];
            __syncthreads();
            for (int i = tid; i < 9 * 256; i += 512) { const int ci = i >> 8, col = i & 255; float v = 0.f;
#pragma unroll
                for (int ww = 0; ww < 8; ++ww) v += red[(ww * 9 + ci) * 256 + col];
                v += a.in[10][l * NMODW + cc * 256 + col];
                MOD[((size_t)l * 9 + ci) * NMODW + cc * 256 + col] = v; }
            __syncthreads();
        }
    }
    if (blockIdx.x == gridDim.x - 1) {
        float* LB = (float*)(a.ws + WS_LB); const float* lbin = a.in[16];
        for (int e = tid; e < 1024; e += 512) {
            const float x0 = lbin[e], x1 = lbin[1024 + e], x2 = lbin[2048 + e], x3 = lbin[3072 + e];
            const float mx = fmaxf(fmaxf(x0, x1), fmaxf(x2, x3));
            const float e0 = __expf(x0 - mx), e1 = __expf(x1 - mx), e2 = __expf(x2 - mx), e3 = __expf(x3 - mx); const float inv = 1.f / (e0 + e1 + e2 + e3);
            LB[e] = 0.f; LB[1024 + e] = e1 * inv; LB[2048 + e] = (e1 + e2) * inv; LB[3072 + e] = (e1 + e2 + e3) * inv;
        }
        float* cosT = (float*)(a.ws + WS_ROPE); float* sinT = cosT + 1024;
        for (int e = tid; e < 1024; e += 512) { const int pos = e >> 4, i = e & 15; const float inv = exp2f(-(float)i * (13.287712379549449f / 16.f)); const float ang = (float)pos * inv;
            cosT[e] = cosf(ang); sinT[e] = sinf(ang); }
    }
}

DI void transpose_item(const float* W, int ldw, int srccol0, int k0, bf16_t* WT, int K, int dstrow0, float* scr, int lane) {
#pragma unroll 8
    for (int i = 0; i < 32; ++i) { const int kk = 2 * i + (lane >> 5); scr[kk * 33 + (lane & 31)] = W[(size_t)(k0 + kk) * ldw + srccol0 + (lane & 31)]; }
    LDS_WAIT();
    const int c = lane & 7;
#pragma unroll
    for (int j = 0; j < 4; ++j) { const int n = (lane >> 3) + 8 * j; const float* sp = scr + (8 * c) * 33 + n;
        u32x4 o; o.x = pk2(sp[0 * 33], sp[1 * 33]); o.y = pk2(sp[2 * 33], sp[3 * 33]); o.z = pk2(sp[4 * 33], sp[5 * 33]); o.w = pk2(sp[6 * 33], sp[7 * 33]);
        *(u32x4*)(WT + (size_t)(dstrow0 + n) * K + k0 + 8 * c) = o; }
    LDS_WAIT();
}
DI void phase_wconv(const Args& a, unsigned char* lds, int l, int it0, int it1, int rank, int nrank) {
    const int tid = otid(), lane = tid & 63, w = tid >> 6;
    float* scr = (float*)(lds + w * 8448);
    unsigned char* wb = a.ws + WS_W + (size_t)(l & 1) * WSZ;
    for (int it = it0 + rank * 8 + w; it < it1; it += nrank * 8) {
        int r = it;
        if (r < 5632) { const int j = r / 2816; r -= j * 2816; const int kb = r / 176, nb = r % 176, n0 = 32 * nb, pn = n0 >> 8, loc = n0 & 255;
            const int src = (loc >> 7) * DFF + 128 * pn + (loc & 127);
            transpose_item(a.in[12] + (size_t)(l * 2 + j) * 1024 * 5632, 5632, src, 64 * kb, (bf16_t*)(wb + W_FI) + (size_t)j * 5632 * 1024, 1024, n0, scr, lane); continue; }
        r -= 5632;
        if (r < 2816) { const int j = r / 1408; r -= j * 1408; const int kb = r / 32, nb = r % 32;
            transpose_item(a.in[13] + (size_t)(l * 2 + j) * DFF * 1024, 1024, 32 * nb, 64 * kb, (bf16_t*)(wb + W_FO) + (size_t)j * 1024 * DFF, DFF, 32 * nb, scr, lane); continue; }
        r -= 2816;
        if (r < 3584) { const int kb = r / 224, nb = r % 224;
            transpose_item(a.in[14] + (size_t)l * 1024 * INW, INW, 32 * nb, 64 * kb, (bf16_t*)(wb + W_IN), 1024, 32 * nb, scr, lane); continue; }
        r -= 3584;
        if (r < 768) { const int k = r / 256; r -= k * 256; const int kb = r / 32, nb = r % 32;
            transpose_item(a.in[19] + (size_t)(l * 3 + k) * 512 * 1024, 1024, 32 * nb, 64 * kb, (bf16_t*)(wb + W_BR) + (size_t)k * 1024 * 512, 512, 32 * nb, scr, lane); continue; }
        r -= 768;
        { const int kb = r / 32, nb = r % 32;
            transpose_item(a.in[20] + (size_t)l * 1024 * 1024, 1024, 32 * nb, 64 * kb, (bf16_t*)(wb + W_OUT), 1024, 32 * nb, scr, lane); }
    }
}

DI void phase_norm(const Args& a, int l, int j, bool first) {
    const int tid = otid(), lane = tid & 63, w = tid >> 6;
    const int gw = obid() * 8 + w, NGW = gridDim.x * 8;
    const float* g = a.in[11] + (size_t)(l * 3 + j) * DM; const float* MOD = (const float*)(a.ws + WS_MOD) + (size_t)l * 9 * NMODW;
    bf16_t* HB = (bf16_t*)(a.ws + WS_HB);
    f32x4 gg[4];
#pragma unroll
    for (int jj = 0; jj < 4; ++jj) gg[jj] = *(const f32x4*)(g + 4 * lane + 256 * jj);
    for (int row = gw; row < T; row += NGW) {
        const float* xr = first ? (row < TC ? a.in[0] + (size_t)row * DM : a.in[1] + (size_t)(row - TC) * DM) : a.out + (size_t)row * DM;
        const int cond = row < TC ? 8 : ((row - TC) >> 11);
        const float* shift = MOD + (size_t)cond * NMODW + 3 * j * DM; const float* scale = shift + DM;
        f32x4 v[4]; float ss = 0.f;
#pragma unroll
        for (int jj = 0; jj < 4; ++jj) { v[jj] = *(const f32x4*)(xr + 4 * lane + 256 * jj); ss += (v[jj][0] * v[jj][0] + v[jj][1] * v[jj][1]) + (v[jj][2] * v[jj][2] + v[jj][3] * v[jj][3]); }
        const float rstd = rsqrtf(wave_sum(ss) * (1.f / DM) + EPS);
#pragma unroll
        for (int jj = 0; jj < 4; ++jj) { const f32x4 sc = *(const f32x4*)(scale + 4 * lane + 256 * jj), sh = *(const f32x4*)(shift + 4 * lane + 256 * jj);
            const f32x4 y = v[jj] * rstd * gg[jj] * (1.f + sc) + sh;
            u32x2 o; o.x = pk2(y[0], y[1]); o.y = pk2(y[2], y[3]);
            *(u32x2*)(HB + (size_t)row * DM + 4 * lane + 256 * jj) = o; }
    }
}
DI void phase_final(const Args& a) {
    const int tid = otid(), lane = tid & 63, w = tid >> 6;
    const int gw = obid() * 8 + w, NGW = gridDim.x * 8;
    const float* g = a.in[21];
    f32x4 gg[4];
#pragma unroll
    for (int jj = 0; jj < 4; ++jj) gg[jj] = *(const f32x4*)(g + 4 * lane + 256 * jj);
    for (int row = gw; row < T; row += NGW) {
        float* xr = a.out + (size_t)row * DM;
        f32x4 v[4]; float ss = 0.f;
#pragma unroll
        for (int jj = 0; jj < 4; ++jj) { v[jj] = *(const f32x4*)(xr + 4 * lane + 256 * jj); ss += (v[jj][0] * v[jj][0] + v[jj][1] * v[jj][1]) + (v[jj][2] * v[jj][2] + v[jj][3] * v[jj][3]); }
        const float rstd = rsqrtf(wave_sum(ss) * (1.f / DM) + EPS);
#pragma unroll
        for (int jj = 0; jj < 4; ++jj) *(f32x4*)(xr + 4 * lane + 256 * jj) = v[jj] * rstd * gg[jj];
    }
}

DI void phase_prep(const Args& a, int l, bool dry) {
    const int tid = otid(), lane = tid & 63, w = tid >> 6;
    const int gw = obid() * 8 + w, NGW = gridDim.x * 8;
    bf16_t* PROJ = (bf16_t*)(a.ws + WS_PROJ);
    const float* cosT = (const float*)(a.ws + WS_ROPE); const float* sinT = cosT + 1024;
    const float qg = a.in[15][(l * 2 + 0) * 64 + lane], kg = a.in[15][(l * 2 + 1) * 64 + lane];
    bf16_t* KAL = (bf16_t*)(a.ws + WS_KAL); bf16_t* VAL = (bf16_t*)(a.ws + WS_VAL); bf16_t* KWL = (bf16_t*)(a.ws + WS_KWL); bf16_t* VWL = (bf16_t*)(a.ws + WS_VWL);
    bf16_t* KAC = (bf16_t*)(a.ws + WS_KAC); bf16_t* VAC = (bf16_t*)(a.ws + WS_VAC); bf16_t* KWC = (bf16_t*)(a.ws + WS_KWC); bf16_t* VWC = (bf16_t*)(a.ws + WS_VWC);
    for (int r = gw; r < T + 2048; r += NGW) {
        if (r < T) {
            const bool lat = r >= TC; int b, t;
            if (lat) { b = (r - TC) >> 11; t = (r - TC) & 2047; } else { b = r >> 8; t = r & 255; }
            float cs = 1.f, sn = 0.f;
            if (lat) { const int pos = (lane & 32) ? (t & 63) : (t >> 6); cs = cosT[pos * 16 + (lane & 15)]; sn = sinT[pos * 16 + (lane & 15)]; if (!(lane & 16)) sn = -sn; }
            bf16_t* pr = PROJ + (size_t)r * INW;
            bf16_t raw[24];
#pragma unroll
            for (int hh = 0; hh < 24; ++hh) raw[hh] = pr[64 * hh + lane];
#pragma unroll
            for (int h = 0; h < 8; ++h) {
                const float x = bf2f(raw[h]); const float ss = wave_sum(x * x);
                float y = x * rsqrtf(ss * (1.f / 64.f) + EPS) * qg;
                if (lat) { const float p = __shfl_xor(y, 16); y = y * cs + p * sn; }
                if (!dry) pr[C_AQ + 64 * h + lane] = f2bf(y * (0.125f * LOG2E));
            }
#pragma unroll
            for (int h = 0; h < 8; ++h) {
                float y = bf2f(raw[12 + h]);
                if (lat) { const float p = __shfl_xor(y, 16); y = y * cs + p * sn; }
                if (!dry) pr[C_WQ + 64 * h + lane] = f2bf(y * (0.125f * LOG2E));
            }
#pragma unroll
            for (int g2 = 0; g2 < 2; ++g2) {
                const float x = bf2f(raw[8 + g2]); const float ss = wave_sum(x * x);
                float y = x * rsqrtf(ss * (1.f / 64.f) + EPS) * kg;
                if (lat) { const float p = __shfl_xor(y, 16); y = y * cs + p * sn; }
                const bf16_t vbits = raw[10 + g2];
                float yw = bf2f(raw[20 + g2]);
                if (lat) { const float p = __shfl_xor(yw, 16); yw = yw * cs + p * sn; }
                const bf16_t wvbits = raw[22 + g2];
                if (lat) {
                    KAL[((size_t)(b * 2 + g2) * 2304 + 256 + t) * 64 + lane] = f2bf(y);
                    VAL[((size_t)(b * 2 + g2) * 64 + lane) * 2304 + 256 + t] = vbits;
                    KWL[((size_t)(b * 2 + g2) * 2304 + 256 + t) * 64 + lane] = f2bf(yw);
                    VWL[((size_t)(b * 2 + g2) * 64 + lane) * 2304 + 256 + t] = wvbits;
                } else {
                    KAC[((size_t)(b * 2 + g2) * 256 + t) * 64 + lane] = f2bf(y);
                    VAC[((size_t)(b * 2 + g2) * 64 + lane) * 256 + t] = vbits;
                    KWC[((size_t)(b * 2 + g2) * 256 + t) * 64 + lane] = f2bf(yw);
                    VWC[((size_t)(b * 2 + g2) * 64 + lane) * 256 + t] = wvbits;
                    const size_t oi = ((((size_t)b * DEPTH + l) * 256 + t) * 2 + g2) * 64 + lane;
                    a.out[O_NKA + oi] = y; a.out[O_NVA + oi] = bf2f(vbits); a.out[O_NKW + oi] = yw; a.out[O_NVW + oi] = bf2f(wvbits);
                }
            }
        } else {
            const int idx = r - T, b = idx >> 8, p = idx & 255;
#pragma unroll
            for (int g2 = 0; g2 < 2; ++g2) {
                const size_t ci = ((((size_t)b * DEPTH + l) * 256 + p) * 2 + g2) * 64 + lane;
                KAL[((size_t)(b * 2 + g2) * 2304 + p) * 64 + lane] = f2bf(a.in[2][ci]);
                VAL[((size_t)(b * 2 + g2) * 64 + lane) * 2304 + p] = f2bf(a.in[3][ci]);
                KWL[((size_t)(b * 2 + g2) * 2304 + p) * 64 + lane] = f2bf(a.in[4][ci]);
                VWL[((size_t)(b * 2 + g2) * 64 + lane) * 2304 + p] = f2bf(a.in[5][ci]);
            }
        }
    }
}

DI void attn_item(unsigned char* lds, const bf16_t* qp, bf16_t* op, const bf16_t* Kb, const bf16_t* VTb, int nk, int nA, int lo, int hi, bool win, int tq, bool has_sink, float sink2, bool nomax) {
    const int tid = otid(), lane = tid & 63, h = lane >> 5, c = lane & 31;
    const int n64 = nA + (hi - lo), nit = (n64 + 1) >> 1;
    constexpr int STG = 17664;
    bf16_t* Kst0 = (bf16_t*)lds; bf16_t* Vst0 = (bf16_t*)lds + 9216;
    int qoff = (tid >> 6) * 2048 + lane * 8;
    bf16_t* qpark = (bf16_t*)lds + 2 * STG;
#pragma unroll
    for (int s = 0; s < 4; ++s) *(bf16x8*)(qpark + qoff + s * 512) = *(const bf16x8*)(qp + 16 * s + 8 * h);
    f32x16 O0, O1;
#pragma unroll
    for (int i = 0; i < 16; ++i) { O0[i] = 0.f; O1[i] = 0.f; }
    float m = 0.f, lsum = 0.f;
    const int lrow = tid >> 3, lch = tid & 7;
    u32x4 kR, vR;
#define AT_KEY0(j) (((j) < nA ? (j) : 4 + lo + ((j) - nA)) * 64)
#define AT_LOAD(it, sub) do { const int j_ = (2 * (it) + (sub) < n64) ? 2 * (it) + (sub) : 2 * (it); const int k_ = AT_KEY0(j_); \
        kR = *(const u32x4*)(Kb + (size_t)(k_ + lrow) * 64 + 8 * lch); vR = *(const u32x4*)(VTb + (size_t)lrow * nk + k_ + 8 * lch); } while (0)
#define AT_STORE(stg, sub) do { bf16_t* kd_ = Kst0 + (stg) * STG; bf16_t* vd_ = Vst0 + (stg) * STG; \
        *(u32x4*)(kd_ + (64 * (sub) + lrow) * 72 + 8 * lch) = kR; \
        *(u32x2*)(vd_ + lrow * 132 + 64 * (sub) + 8 * lch) = (u32x2){vR.x, vR.y}; *(u32x2*)(vd_ + lrow * 132 + 64 * (sub) + 8 * lch + 4) = (u32x2){vR.z, vR.w}; } while (0)
    AT_LOAD(0, 0); AT_STORE(0, 0); AT_LOAD(0, 1); AT_STORE(0, 1);
    __syncthreads();
    for (int i = 0; i < nit; ++i) {
        const int cur = i & 1;
        if (i + 1 < nit) AT_LOAD(i + 1, 0);
        const bf16_t* Kc = Kst0 + cur * STG; const bf16_t* Vc = Vst0 + cur * STG;
        f32x16 st[4];
        const float cinit = -m;
#pragma unroll
        for (int t = 0; t < 4; ++t)
#pragma unroll
            for (int ii = 0; ii < 16; ++ii) st[t][ii] = cinit;
        asm volatile("" : "+v"(qoff));
#pragma unroll
        for (int s = 0; s < 4; ++s) { const bf16x8 qv = *(const bf16x8*)(qpark + qoff + s * 512);
#pragma unroll
            for (int t = 0; t < 4; ++t) { const bf16x8 ak = *(const bf16x8*)(Kc + (32 * t + c) * 72 + 16 * s + 8 * h); st[t] = MFMA32(ak, qv, st[t]); } }
        float ps = 0.f;
        if (nomax) {
#pragma unroll
            for (int t = 0; t < 4; ++t)
#pragma unroll
                for (int ii = 0; ii < 16; ++ii) { const float p = __builtin_amdgcn_exp2f(st[t][ii]); st[t][ii] = p; ps += p; }
            lsum += ps;
        } else {
            const int ja = 2 * i, jb = 2 * i + 1;
            if (win && ja >= nA) { const int k0 = AT_KEY0(ja);
#pragma unroll
                for (int t = 0; t < 2; ++t)
#pragma unroll
                    for (int ii = 0; ii < 16; ++ii) { const int dd = tq - (k0 - 256 + 32 * t + crow(ii, h)); if (dd > 128 || dd < -128) st[t][ii] = -1e30f; } }
            if (jb >= n64) {
#pragma unroll
                for (int t = 2; t < 4; ++t)
#pragma unroll
                    for (int ii = 0; ii < 16; ++ii) st[t][ii] = -1e30f;
            } else if (win && jb >= nA) { const int k0 = AT_KEY0(jb);
#pragma unroll
                for (int t = 2; t < 4; ++t)
#pragma unroll
                    for (int ii = 0; ii < 16; ++ii) { const int dd = tq - (k0 - 256 + 32 * (t - 2) + crow(ii, h)); if (dd > 128 || dd < -128) st[t][ii] = -1e30f; } }
            float mx = -1e30f;
#pragma unroll
            for (int ii = 0; ii < 16; ++ii) mx = fmaxf(mx, fmaxf(fmaxf(st[0][ii], st[1][ii]), fmaxf(st[2][ii], st[3][ii])));
            mx = fmaxf(mx, __shfl_xor(mx, 32));
            if (i == 0) {
                const float mnew = has_sink ? fmaxf(mx, sink2) : mx;
#pragma unroll
                for (int t = 0; t < 4; ++t)
#pragma unroll
                    for (int ii = 0; ii < 16; ++ii) { const float p = __builtin_amdgcn_exp2f(st[t][ii] - mnew); st[t][ii] = p; ps += p; }
                lsum = ps + ((has_sink && h == 0) ? __builtin_amdgcn_exp2f(sink2 - mnew) : 0.f);
                m = mnew;
            } else if (__builtin_amdgcn_ballot_w64(mx > 0.f) != 0ull) {
                const float delta = fmaxf(mx, 0.f); const float alpha = __builtin_amdgcn_exp2f(-delta); m += delta;
#pragma unroll
                for (int t = 0; t < 4; ++t)
#pragma unroll
                    for (int ii = 0; ii < 16; ++ii) { const float p = __builtin_amdgcn_exp2f(st[t][ii] - delta); st[t][ii] = p; ps += p; }
                lsum = lsum * alpha + ps;
#pragma unroll
                for (int ii = 0; ii < 16; ++ii) { O0[ii] *= alpha; O1[ii] *= alpha; }
            } else {
#pragma unroll
                for (int t = 0; t < 4; ++t)
#pragma unroll
                    for (int ii = 0; ii < 16; ++ii) { const float p = __builtin_amdgcn_exp2f(st[t][ii]); st[t][ii] = p; ps += p; }
                lsum += ps;
            }
        }
        if (i + 1 < nit) { AT_STORE(cur ^ 1, 0); AT_LOAD(i + 1, 1); }
#pragma unroll
        for (int t = 0; t < 4; ++t)
#pragma unroll
            for (int s2 = 0; s2 < 2; ++s2) {
                const bf16x8 pb = pack8(st[t][8 * s2], st[t][8 * s2 + 1], st[t][8 * s2 + 2], st[t][8 * s2 + 3], st[t][8 * s2 + 4], st[t][8 * s2 + 5], st[t][8 * s2 + 6], st[t][8 * s2 + 7]);
                const bf16_t* v0p = Vc + c * 132 + 32 * t + 16 * s2 + 4 * h; const bf16_t* v1p = Vc + (32 + c) * 132 + 32 * t + 16 * s2 + 4 * h;
                O0 = MFMA32(cat44(*(const s16x4*)(v0p), *(const s16x4*)(v0p + 8)), pb, O0);
                O1 = MFMA32(cat44(*(const s16x4*)(v1p), *(const s16x4*)(v1p + 8)), pb, O1);
            }
        if (i + 1 < nit) AT_STORE(cur ^ 1, 1);
        __syncthreads();
    }
#undef AT_KEY0
#undef AT_LOAD
#undef AT_STORE
    lsum += __shfl_xor(lsum, 32);
    const float inv = 1.f / lsum;
#pragma unroll
    for (int g4 = 0; g4 < 4; ++g4) {
        u32x2 w0, w1;
        w0.x = pk2(O0[4 * g4] * inv, O0[4 * g4 + 1] * inv); w0.y = pk2(O0[4 * g4 + 2] * inv, O0[4 * g4 + 3] * inv);
        w1.x = pk2(O1[4 * g4] * inv, O1[4 * g4 + 1] * inv); w1.y = pk2(O1[4 * g4 + 2] * inv, O1[4 * g4 + 3] * inv);
        *(u32x2*)(op + 8 * g4 + 4 * h) = w0; *(u32x2*)(op + 32 + 8 * g4 + 4 * h) = w1;
    }
}
#define LAS __attribute__((address_space(3)))
#define XB_TMO      128
#define XB_XCNT(j)  (256  + 64 * (j))
#define XB_XSUB(j)  (1280 + 64 * (j))
#define XB_XGEN(j)  (2304 + 64 * (j))
#define XB_TOP      3328
#define XB_TOPGEN   3392
#define XCD_BAR_WORDS 3456
#define XB_SPIN_CAP (1u << 18)

__device__ __forceinline__ unsigned xb_ld(unsigned* p)              { return __hip_atomic_load(p, __ATOMIC_RELAXED, __HIP_MEMORY_SCOPE_AGENT); }
__device__ __forceinline__ unsigned xb_add(unsigned* p, unsigned v) { return __hip_atomic_fetch_add(p, v, __ATOMIC_RELAXED, __HIP_MEMORY_SCOPE_AGENT); }
__device__ __forceinline__ unsigned xb_xcc_id() { return (unsigned)__builtin_amdgcn_s_getreg((3 << 11) | 20) & 0xFu; }
#define XB_SPIN(cond, bar) do { unsigned _sp = 0; while (cond) { __builtin_amdgcn_s_sleep(1); \
    if ((++_sp & 255u) == 0u) { if (xb_ld(&(bar)[XB_TMO])) break; if (_sp > XB_SPIN_CAP) { atomicAdd(&(bar)[XB_TMO], 1u); break; } } } } while (0)

struct XcdBarrier {
    unsigned* bar; unsigned x;
    volatile LAS unsigned* st;
};

__device__ __forceinline__ XcdBarrier xcd_barrier_post(unsigned* bar, volatile LAS unsigned* st) {
    XcdBarrier b; b.bar = bar; b.x = xb_xcc_id(); b.st = st;
    if (threadIdx.x == 0) (void)xb_add(&bar[XB_XCNT(b.x)], 1u);
    return b;
}
__device__ __forceinline__ void xcd_barrier_complete(unsigned* bar, unsigned x, unsigned& nloc, unsigned& nx) {
    const unsigned G = gridDim.x * gridDim.y * gridDim.z;
    unsigned sum, cnt, mine, sp = 0u;
    for (;;) {
        sum = 0u; cnt = 0u; mine = 0u;
#pragma unroll
        for (unsigned j = 0; j < 16; ++j) { const unsigned c = xb_ld(&bar[XB_XCNT(j)]); sum += c; cnt += (c > 0u) ? 1u : 0u; mine = (j == x) ? c : mine; }
        if (sum == G) break;
        __builtin_amdgcn_s_sleep(1);
        if ((++sp & 255u) == 0u) { if (xb_ld(&bar[XB_TMO])) break; if (sp > XB_SPIN_CAP) { atomicAdd(&bar[XB_TMO], 1u); break; } }
    }
    nloc = mine > 0u ? mine : 1u; nx = cnt > 0u ? cnt : 1u;
}

__device__ __forceinline__ void xcd_barrier(const XcdBarrier& b) {
    asm volatile("s_waitcnt vmcnt(0)" ::: "memory");
    __syncthreads();
    if (threadIdx.x == 0) {
        unsigned* bar = b.bar;
        __builtin_amdgcn_s_waitcnt(0);
        unsigned nloc = b.st[0], nx = b.st[1];
        if (nloc == 0u) { xcd_barrier_complete(bar, b.x, nloc, nx); b.st[0] = nloc; b.st[1] = nx; }
        const unsigned old = xb_add(&bar[XB_XSUB(b.x)], 1u);
        const unsigned gen = old / nloc;
        if (old + 1u == (gen + 1u) * nloc) {
            __builtin_amdgcn_fence(__ATOMIC_RELEASE, "agent");
            asm volatile("s_waitcnt vmcnt(0)" ::: "memory");
            const unsigned og = xb_add(&bar[XB_TOP], 1u);
            const unsigned tg = og / nx;
            if (og + 1u == (tg + 1u) * nx) xb_add(&bar[XB_TOPGEN], 1u);
            else XB_SPIN(xb_ld(&bar[XB_TOPGEN]) == tg, bar);
            __builtin_amdgcn_fence(__ATOMIC_ACQUIRE, "agent");
            xb_add(&bar[XB_XGEN(b.x)], 1u);
            asm volatile("s_waitcnt vmcnt(0)" ::: "memory");
        } else {
            XB_SPIN(xb_ld(&bar[XB_XGEN(b.x)]) == gen, bar);
            __builtin_amdgcn_fence(__ATOMIC_ACQUIRE, "agent");
            asm volatile("s_waitcnt vmcnt(0)" ::: "memory");
        }
    }
    __syncthreads();
}


DI void hgrn_item(const Args& a, unsigned char* lds, int l, int seq, int hd, int dir) {
    const int tid = otid(), lane = tid & 63, w = tid >> 6, h = lane >> 5, c = lane & 31;
    const bool lat = seq < 8; const int b = lat ? seq : seq - 8; const int L = lat ? 2048 : 256; const int nch = L >> 5; const int seqbase = lat ? TC + b * 2048 : b * 256;
    bf16_t* RQ = (bf16_t*)lds; bf16_t* RZ = (bf16_t*)(lds + 8704); bf16_t* RV = (bf16_t*)(lds + 17408);
    bf16_t* QS = (bf16_t*)(lds + 26112); bf16_t* KS = (bf16_t*)(lds + 34816);
    bf16_t* KST = (bf16_t*)(lds + 43520); bf16_t* VT = (bf16_t*)(lds + 53760); float* E0 = (float*)(lds + 64000); float* E1 = E0 + 128;
    const bf16_t* PROJ = (const bf16_t*)(a.ws + WS_PROJ);
    float* OF = (float*)(a.ws + WS_OF);
    const int cq = C_HQ + 128 * hd, cz = (dir ? C_HFB : C_HFF) + 128 * hd, cv = C_HI + 128 * hd;
    const int wd = w & 3;
    const int dmy = 32 * wd + c;
    const int t0 = 16 * (w >> 2) + 8 * h;
    f32x16 S[4];
    if (w < 4) {
        if (lat) { const float* sp = a.in[6] + ((((size_t)(b * DEPTH + l) * 2 + dir) * 4 + hd) * 128) * 128;
#pragma unroll
            for (int dt = 0; dt < 4; ++dt)
#pragma unroll
                for (int ii = 0; ii < 16; ++ii) S[dt][ii] = sp[(size_t)(32 * dt + crow(ii, h)) * 128 + dmy];
        } else {
#pragma unroll
            for (int dt = 0; dt < 4; ++dt)
#pragma unroll
                for (int ii = 0; ii < 16; ++ii) S[dt][ii] = 0.f;
        }
    }
    const float lbv = ((const float*)(a.ws + WS_LB))[(l * 2 + dir) * 512 + 128 * hd + dmy];
    const float omlb = 1.f - lbv;
    u32x4 rq, rz, rv;
    const int lt = tid >> 4, lcn = tid & 15;
#define HG_GLOAD(ch) do { const int p_ = 32 * (ch) + lt, pos_ = dir ? L - 1 - p_ : p_; const bf16_t* rp_ = PROJ + (size_t)(seqbase + pos_) * INW + 8 * lcn; \
        rq = *(const u32x4*)(rp_ + cq); rz = *(const u32x4*)(rp_ + cz); rv = *(const u32x4*)(rp_ + cv); } while (0)
    HG_GLOAD(0);
    for (int ch = 0; ch < nch; ++ch) {
        *(u32x4*)(RQ + lt * 136 + 8 * lcn) = rq; *(u32x4*)(RZ + lt * 136 + 8 * lcn) = rz; *(u32x4*)(RV + lt * 136 + 8 * lcn) = rv;
        __syncthreads();
        if (ch + 1 < nch) HG_GLOAD(ch + 1);
        {
            float qv[8], kv[8], gv[8]; float qtot = 0.f;
#pragma unroll
            for (int tt = 0; tt < 8; ++tt) { const int t = t0 + tt; const float qr = bf2f(RQ[t * 136 + dmy]), z = bf2f(RZ[t * 136 + dmy]);
                const float sg = sigmoidf_(z); const float f = lbv + omlb * sg; const float g = __logf(fmaxf(f, 1e-30f));
                kv[tt] = omlb * (1.f - sg); qv[tt] = qr * sigmoidf_(qr); gv[tt] = g; qtot += g; }
            const float partner = __shfl_xor(qtot, 32);
            float e[8];
            if (w < 4) { float run = h ? 0.f : -partner;
#pragma unroll
                for (int tt = 7; tt >= 0; --tt) { e[tt] = run; run -= gv[tt]; }
                if (h == 0) E0[dmy] = __expf(qtot + partner);
            } else { float run = h ? partner : 0.f;
#pragma unroll
                for (int tt = 0; tt < 8; ++tt) { run += gv[tt]; e[tt] = run; }
                if (h == 0) E1[dmy] = __expf(qtot + partner);
            }
            float ke[8];
#pragma unroll
            for (int tt = 0; tt < 8; ++tt) { const int t = t0 + tt; const float ex = __expf(fminf(fmaxf(e[tt], -80.f), 80.f)), exn = __builtin_amdgcn_rcpf(ex);
                ke[tt] = kv[tt] * exn;
                QS[t * 136 + dmy] = f2bf(qv[tt] * ex); KS[t * 136 + dmy] = f2bf(ke[tt]); }
            *(bf16x8*)(KST + dmy * 40 + t0) = pack8(ke[0], ke[1], ke[2], ke[3], ke[4], ke[5], ke[6], ke[7]);
            bf16x8 v0;
#pragma unroll
            for (int tt = 0; tt < 8; ++tt) v0[tt] = (short)RV[(t0 + tt) * 136 + dmy];
            *(bf16x8*)(VT + dmy * 40 + t0) = v0;
        }
        __syncthreads();
        if (w < 4) {
            f32x16 st;
#pragma unroll
            for (int ii = 0; ii < 16; ++ii) st[ii] = 0.f;
#pragma unroll
            for (int s = 0; s < 8; ++s) { const bf16x8 ak = *(const bf16x8*)(KS + c * 136 + 16 * s + 8 * h), bq = *(const bf16x8*)(QS + c * 136 + 16 * s + 8 * h); st = MFMA32(ak, bq, st); }
#pragma unroll
            for (int ii = 0; ii < 16; ++ii) if (crow(ii, h) > c) st[ii] = 0.f;
            f32x16 o;
#pragma unroll
            for (int ii = 0; ii < 16; ++ii) o[ii] = 0.f;
#pragma unroll
            for (int s2 = 0; s2 < 2; ++s2) {
                const bf16x8 pb = pack8(st[8 * s2], st[8 * s2 + 1], st[8 * s2 + 2], st[8 * s2 + 3], st[8 * s2 + 4], st[8 * s2 + 5], st[8 * s2 + 6], st[8 * s2 + 7]);
                const bf16_t* vp = VT + dmy * 40 + 16 * s2 + 4 * h;
                o = MFMA32(cat44(*(const s16x4*)vp, *(const s16x4*)(vp + 8)), pb, o);
            }
#pragma unroll
            for (int dt = 0; dt < 4; ++dt) {
#pragma unroll
                for (int g4 = 0; g4 < 4; ++g4) { const f32x4 ev = *(const f32x4*)(E0 + 32 * dt + 8 * g4 + 4 * h);
                    S[dt][4 * g4] *= ev[0]; S[dt][4 * g4 + 1] *= ev[1]; S[dt][4 * g4 + 2] *= ev[2]; S[dt][4 * g4 + 3] *= ev[3]; }
#pragma unroll
                for (int s2 = 0; s2 < 2; ++s2) {
                    const bf16x8 xs = pack8(S[dt][8 * s2], S[dt][8 * s2 + 1], S[dt][8 * s2 + 2], S[dt][8 * s2 + 3], S[dt][8 * s2 + 4], S[dt][8 * s2 + 5], S[dt][8 * s2 + 6], S[dt][8 * s2 + 7]);
                    const bf16_t* qb = QS + c * 136 + 32 * dt + 16 * s2 + 4 * h;
                    o = MFMA32(xs, cat44(*(const s16x4*)qb, *(const s16x4*)(qb + 8)), o);
                }
            }
            {   const int p = 32 * ch + c, pos = dir ? L - 1 - p : p;
                float* op = OF + ((size_t)dir * T + seqbase + pos) * 512 + 128 * hd + 32 * wd;
#pragma unroll
                for (int g4 = 0; g4 < 4; ++g4) { f32x4 v; v[0] = o[4 * g4]; v[1] = o[4 * g4 + 1]; v[2] = o[4 * g4 + 2]; v[3] = o[4 * g4 + 3]; *(f32x4*)(op + 8 * g4 + 4 * h) = v; } }
#pragma unroll
            for (int dt = 0; dt < 4; ++dt) {
#pragma unroll
                for (int s2 = 0; s2 < 2; ++s2) { const bf16x8 ak = *(const bf16x8*)(KST + (32 * dt + c) * 40 + 16 * s2 + 8 * h), bv = *(const bf16x8*)(VT + dmy * 40 + 16 * s2 + 8 * h);
                    S[dt] = MFMA32(ak, bv, S[dt]); }
#pragma unroll
                for (int g4 = 0; g4 < 4; ++g4) { const f32x4 ev = *(const f32x4*)(E1 + 32 * dt + 8 * g4 + 4 * h);
                    S[dt][4 * g4] *= ev[0]; S[dt][4 * g4 + 1] *= ev[1]; S[dt][4 * g4 + 2] *= ev[2]; S[dt][4 * g4 + 3] *= ev[3]; }
            }
        }
    }
#undef HG_GLOAD
    if (!lat && w < 4) { float* sp = a.out + O_NST + ((((size_t)(b * DEPTH + l) * 2 + dir) * 4 + hd) * 128) * 128;
#pragma unroll
        for (int dt = 0; dt < 4; ++dt)
#pragma unroll
            for (int ii = 0; ii < 16; ++ii) sp[(size_t)(32 * dt + crow(ii, h)) * 128 + dmy] = S[dt][ii];
    }
}

DI void phase_mixer(const Args& a, unsigned char* lds, int l, int rep) {
    unsigned* ctl = (unsigned*)(a.ws + WS_CTL) + 16 * l + 8 * rep;
    volatile int* slot = (volatile int*)(lds + LDS_MISC);
    const int tid = otid(), lane = tid & 63, w = tid >> 6, c = lane & 31;
    bf16_t* PROJ = (bf16_t*)(a.ws + WS_PROJ);
    for (;;) {
        __syncthreads();
        if (tid == 0) *slot = (int)__hip_atomic_fetch_add(ctl, 1u, __ATOMIC_RELAXED, __HIP_MEMORY_SCOPE_AGENT);
        __syncthreads();
        const int it = *slot;
        if (it >= 1856) break;
#if PROBE_MASK & 16
        if (rep && !(it < 64 || (it >= 576 && it < 832))) continue;
#endif
#if PROBE_MASK & 32
        if (rep && (it < 64 || (it >= 576 && it < 832))) continue;
#endif
#ifndef NO_HG
        if (it < 64) { hgrn_item(a, lds, l, it >> 3, (it >> 1) & 3, it & 1); continue; }
        if (it >= 576 && it < 832) { const int idx = it - 576; hgrn_item(a, lds, l, 8 + (idx >> 3), (idx >> 1) & 3, idx & 1); continue; }
#endif
        int idx, kind;
        if (it < 576) { idx = it - 64; kind = 0; } else if (it < 1344) { idx = it - 832; kind = 1; } else if (it < 1600) { idx = it - 1344; kind = 2; } else { idx = it - 1600; kind = 3; }
        const bool lat = kind < 2, isw = kind & 1;
        int b, g, qb;
        if (lat) { b = idx >> 6; g = (idx >> 5) & 1; qb = idx & 31; } else { b = idx >> 3; g = (idx >> 2) & 1; qb = idx & 3; }
        const int r = w & 3, tq = 64 * qb + 32 * (w >> 2) + c;
        const int row = (lat ? TC + b * 2048 : b * 256) + tq;
        const bf16_t* qp = PROJ + (size_t)row * INW + (isw ? C_WQ : C_AQ) + (4 * g + r) * 64;
        bf16_t* op = (bf16_t*)(a.ws + (isw ? WS_OWIN : WS_OATT)) + (size_t)row * 512 + (4 * g + r) * 64;
        const bf16_t* Kb; const bf16_t* VTb; int nk;
        if (lat) { nk = 2304; Kb = (const bf16_t*)(a.ws + (isw ? WS_KWL : WS_KAL)) + (size_t)(b * 2 + g) * 2304 * 64; VTb = (const bf16_t*)(a.ws + (isw ? WS_VWL : WS_VAL)) + (size_t)(b * 2 + g) * 64 * 2304; }
        else { nk = 256; Kb = (const bf16_t*)(a.ws + (isw ? WS_KWC : WS_KAC)) + (size_t)(b * 2 + g) * 256 * 64; VTb = (const bf16_t*)(a.ws + (isw ? WS_VWC : WS_VAC)) + (size_t)(b * 2 + g) * 64 * 256; }
        int nA = 4, lo = 0, hi = 0; bool win = false;
        if (kind == 0) nA = 36;
        if (kind == 1) { lo = qb - 2 < 0 ? 0 : qb - 2; hi = qb + 3 > 32 ? 32 : qb + 3; win = true; }
        const float sink2 = isw ? a.in[18][l * 8 + 4 * g + r] * LOG2E : 0.f;
#ifndef NO_ATT
        attn_item(lds, qp, op, Kb, VTb, nk, nA, lo, hi, win, tq, isw, sink2, !isw);
#endif
    }
}

DI void phase_hgcomb(const Args& a, int l) {
    const int tid = otid(), lane = tid & 63, w = tid >> 6;
    const int gw = obid() * 8 + w, NGW = gridDim.x * 8;
    const float* OF = (const float*)(a.ws + WS_OF); const bf16_t* PROJ = (const bf16_t*)(a.ws + WS_PROJ); bf16_t* OHG = (bf16_t*)(a.ws + WS_OHG);
    const f32x2 gn = *(const f32x2*)(a.in[17] + l * 128 + 2 * lane);
    for (int it = gw; it < T * 4; it += NGW) {
        const int row = it >> 2, hd = it & 3;
        const f32x2 x0 = *(const f32x2*)(OF + (size_t)row * 512 + 128 * hd + 2 * lane), x1 = *(const f32x2*)(OF + ((size_t)T + row) * 512 + 128 * hd + 2 * lane);
        const float s0 = x0[0] + x1[0], s1 = x0[1] + x1[1];
        const float rstd = rsqrtf(wave_sum(s0 * s0 + s1 * s1) * (1.f / 128.f) + EPS);
        const unsigned gb = *(const unsigned*)(PROJ + (size_t)row * INW + C_HG + 128 * hd + 2 * lane);
        const float g0 = bflo(gb), g1 = bfhi(gb);
        *(unsigned*)(OHG + (size_t)row * 512 + 128 * hd + 2 * lane) = pk2(s0 * rstd * gn[0] * g0 * sigmoidf_(g0), s1 * rstd * gn[1] * g1 * sigmoidf_(g1));
    }
}

template <class Epi> DI void run_gemm(unsigned char* lds, const bf16_t* A, const bf16_t* Bt, int N, int K, const Epi& E) {
    pg8::Gemm g{A, Bt, T, N, K}; pg8::StaticOrder S; S.init(T, N, (int)gridDim.x, obid());
#if STAGGER
    {
        const unsigned long long t0 = __builtin_amdgcn_s_memrealtime();
        const unsigned long long dly = (unsigned long long)((obid() >> 3) & 7) * (unsigned long long)(STAGGER * (K / 64));
        while (__builtin_amdgcn_s_memrealtime() - t0 < dly) __builtin_amdgcn_s_sleep(4);
    }
#endif
    pg8::gemm_phase<Epi, pg8::StaticOrder, false>((PG8_LAS unsigned char*)lds, g, S, E, nullptr);
}

__global__ void __launch_bounds__(512, 2) mk_fwd(Args a) {
    extern __shared__ __attribute__((aligned(16))) unsigned char lds[];
    cg::grid_group grid = cg::this_grid();
    {   volatile LAS unsigned* st = (volatile LAS unsigned*)((LAS unsigned char*)lds + LDS_MISC + 16);
        if (threadIdx.x < 2) st[threadIdx.x] = 0u;
        __syncthreads(); }
    const XcdBarrier bar = xcd_barrier_post((unsigned*)(a.ws + WS_BAR), (volatile LAS unsigned*)((LAS unsigned char*)lds + LDS_MISC + 16));
    bf16_t* HB = (bf16_t*)(a.ws + WS_HB); bf16_t* PROJ = (bf16_t*)(a.ws + WS_PROJ); bf16_t* ACT = PROJ;
    float* M32 = (float*)(a.ws + WS_OF);
    for (int ph = a.ph_lo; ph < a.ph_hi; ++ph) {
        if (ph > a.ph_lo) { if (ph == a.ph_lo + 1) grid.sync(); else xcd_barrier(bar);
#if PROBE_MASK & 8
            xcd_barrier(bar); xcd_barrier(bar);
#endif
        }
#ifndef NO_P0
        if (ph == 0) { phase_p0(a, lds); __syncthreads(); phase_wconv(a, lds, 0, 0, 13312, obid(), (int)gridDim.x); continue; }
#endif
#ifndef NO_C0
        if (ph == NPH - 1) { phase_final(a); continue; }
#endif
        const int l = (ph - 1) / 13, k = (ph - 1) % 13;
        int reps = 1;
        if ((PROBE_MASK & 1) && (k == 0 || k == 3 || k == 10 || k == 7)) reps = 2;
        if ((PROBE_MASK & 2) && (k == 1 || k == 11 || k == 4 || k == 8)) reps = 2;
        if ((PROBE_MASK & (4 | 16 | 32)) && k == 6) reps = 2;
        if ((PROBE_MASK & (64 | 128)) && (k == 1 || k == 11)) reps = 2;
        if ((PROBE_MASK & 256) && k == 4) reps = 2;
        if ((PROBE_MASK & 2048) && k == 5) reps = 2;
        if ((PROBE_MASK & 512) && k == 8) reps = 2;
        if ((PROBE_MASK & 1024) && (k == 2 || k == 9 || k == 12)) reps = 2;
        for (int rep = 0; rep < reps; ++rep) {
        if (rep) xcd_barrier(bar);
        const float* MODL = (const float*)(a.ws + WS_MOD) + (size_t)l * 9 * NMODW;
        const float* xa = a.out; const float* xb = a.out + (size_t)TC * DM;
        const unsigned char* wb = a.ws + WS_W + (size_t)(l & 1) * WSZ;
        const bf16_t* WFI = (const bf16_t*)(wb + W_FI); const bf16_t* WFO = (const bf16_t*)(wb + W_FO);
        if (k == 100) {}
#ifndef NO_C0
        else if (k == 0) { phase_norm(a, l, 0, l == 0); }
        else if (k == 3 || k == 10) { phase_norm(a, l, k == 3 ? 1 : 2, false); }
#endif
#ifndef NO_G_SW
        else if (k == 1 || k == 11) { run_gemm(lds, HB, k == 1 ? WFI : WFI + (size_t)5632 * 1024, 2 * DFF, ((PROBE_MASK & 128) && rep == 0) ? 512 : DM, pg8::EpiSwiglu{ACT}); }
#endif
#ifndef NO_G_RES
        else if (k == 2 || k == 9 || k == 12) {
            if (k == 2 && l == 0) { xa = a.in[0]; xb = a.in[1]; }
            const bf16_t* A = k == 9 ? HB : ACT; const bf16_t* Bt = k == 9 ? (const bf16_t*)(wb + W_OUT) : (k == 2 ? WFO : WFO + (size_t)1024 * DFF);
            const int K = k == 9 ? DM : DFF; const int gi = k == 2 ? 2 : (k == 9 ? 5 : 8);
            run_gemm(lds, A, Bt, DM, K, pg8::EpiResid{xa, xb, ((PROBE_MASK & 1024) && rep == 0) ? (float*)(a.ws + WS_OF) : a.out, MODL + gi * DM, k == 9 ? 1.0f : 0.5f});
            if (l + 1 < DEPTH && rep == reps - 1) {
                const int G = (int)gridDim.x, cb = obid();
                const int i0 = k == 2 ? 0 : (k == 9 ? 6000 : 7312), i1 = k == 2 ? 6000 : (k == 9 ? 7312 : 13312);
                if (G == 256) { if (cb >= 128) phase_wconv(a, lds, l + 1, i0, i1, cb - 128, 128); }
                else phase_wconv(a, lds, l + 1, i0, i1, cb, G);
            }
        }
#endif
#ifndef NO_G_BF
        else if (k == 4) { run_gemm(lds, HB, (const bf16_t*)(wb + W_IN), INW, DM, pg8::EpiBf16P{PROJ, INW}); }
#endif
#ifndef NO_PREP
        else if (k == 5) { phase_prep(a, l, (PROBE_MASK & 2048) && rep == 0); }
#endif
#ifndef NO_MIX
        else if (k == 6) { phase_mixer(a, lds, l, rep); }
#endif
#ifndef NO_C0
        else if (k == 7) { phase_hgcomb(a, l); }
#endif
#ifndef NO_G_BR
        else if (k == 8) {
            const bf16_t* WBR = (const bf16_t*)(wb + W_BR);
            for (int kk = 0; kk < 3; ++kk) {
                const bf16_t* A = (const bf16_t*)(a.ws + (kk == 0 ? WS_OATT : (kk == 1 ? WS_OHG : WS_OWIN)));
                run_gemm(lds, A, WBR + (size_t)kk * 1024 * 512, DM, 512, pg8::EpiBranch{PROJ + C_GA + 1024 * kk, M32, HB, kk});
            }
        }
#endif
        }
    }
}

#ifndef MK_PER_PHASE
#define MK_PER_PHASE 0
#endif
extern "C" void kernel_launch(void* const* d_in, const int* in_sizes, int n_in, void* d_out, int out_size, void* d_ws, size_t ws_size, hipStream_t stream) {
    static int grid = 0;
    if (!grid) {
        if (n_in != 22 || ws_size < WS_END) { fprintf(stderr, "kernel_launch: unexpected n_in %d or ws_size %zu < %zu\n", n_in, ws_size, (size_t)WS_END); grid = -1; return; }
        int dev = 0, cus = 0, per_cu = 0;
        (void)hipGetDevice(&dev); (void)hipDeviceGetAttribute(&cus, hipDeviceAttributeMultiprocessorCount, dev);
        if (hipFuncSetAttribute((const void*)mk_fwd, hipFuncAttributeMaxDynamicSharedMemorySize, LDS_BYTES) != hipSuccess) { fprintf(stderr, "kernel_launch: hipFuncSetAttribute failed\n"); grid = -1; return; }
        (void)hipOccupancyMaxActiveBlocksPerMultiprocessor(&per_cu, mk_fwd, 512, LDS_BYTES);
        if (per_cu < 1) per_cu = 1;
        grid = cus * per_cu; if (grid > 256) grid = 256;
    }
    if (grid < 0) return;
    (void)hipMemsetAsync((char*)d_ws + WS_CTL, 0, CTL_BYTES, stream);
    Args a{};
    for (int i = 0; i < 22; ++i) a.in[i] = (const float*)d_in[i];
    a.out = (float*)d_out; a.ws = (unsigned char*)d_ws;
#if MK_PER_PHASE
    for (int ph = 0; ph < NPH; ++ph) { a.ph_lo = ph; a.ph_hi = ph + 1; hipLaunchKernelGGL(mk_fwd, dim3(grid), dim3(512), LDS_BYTES, stream, a); }
#else
    a.ph_lo = 0; a.ph_hi = NPH;
    void* args[] = {&a};
    hipError_t e = hipLaunchCooperativeKernel((void*)mk_fwd, dim3(grid), dim3(512), args, LDS_BYTES, stream);
    if (e != hipSuccess) fprintf(stderr, "cooperative launch failed: %s (grid %d)\n", hipGetErrorString(e), grid);
#endif
}
```

```cpp
#include <hip/hip_runtime.h>
#include <hip/hip_cooperative_groups.h>
#include <cstdio>
#include <cstdint>
namespace cg = cooperative_groups;

#ifndef PROBE_MASK
#define PROBE_MASK 0
#endif
#ifndef STAGGER
#define STAGGER 0
#endif
#define DI __device__ __forceinline__
typedef unsigned short bf16_t;
typedef short bf16x8 __attribute__((ext_vector_type(8)));
typedef short s16x4 __attribute__((ext_vector_type(4)));
typedef float f32x2 __attribute__((ext_vector_type(2)));
typedef float f32x4 __attribute__((ext_vector_type(4)));
typedef float f32x16 __attribute__((ext_vector_type(16)));
typedef unsigned u32x2 __attribute__((ext_vector_type(2)));
typedef unsigned u32x4 __attribute__((ext_vector_type(4)));
typedef __bf16 bf16x2n __attribute__((ext_vector_type(2)));

DI int otid() { int t = threadIdx.x; asm volatile("" : "+v"(t)); return t; }
DI int obid() { int b = blockIdx.x; asm volatile("" : "+s"(b)); return b; }
DI unsigned pk2(float lo, float hi) { f32x2 v = {lo, hi}; return __builtin_bit_cast(unsigned, __builtin_convertvector(v, bf16x2n)); }
DI float bflo(unsigned u) { return __uint_as_float(u << 16); }
DI float bfhi(unsigned u) { return __uint_as_float(u & 0xffff0000u); }
DI float bf2f(bf16_t b) { return __uint_as_float(((unsigned)b) << 16); }
DI bf16_t f2bf(float f) { return (bf16_t)(pk2(f, 0.f) & 0xffffu); }
DI float sigmoidf_(float x) { return __builtin_amdgcn_rcpf(1.f + __expf(-x)); }
DI float wave_sum(float v) {
#pragma unroll
    for (int o = 1; o < 64; o <<= 1) v += __shfl_xor(v, o);
    return v;
}
#define MFMA32(a, b, c) __builtin_amdgcn_mfma_f32_32x32x16_bf16((a), (b), (c), 0, 0, 0)
DI bf16x8 pack8(float a0, float a1, float a2, float a3, float a4, float a5, float a6, float a7) {
    u32x4 p; p.x = pk2(a0, a1); p.y = pk2(a2, a3); p.z = pk2(a4, a5); p.w = pk2(a6, a7); return __builtin_bit_cast(bf16x8, p);
}
DI bf16x8 cat44(s16x4 lo, s16x4 hi) { return __builtin_shufflevector(lo, hi, 0, 1, 2, 3, 4, 5, 6, 7); }

constexpr int DM = 1024, DEPTH = 4, TC = 8192, TL = 16384, T = 24576, DFF = 2816, INW = 7168, NMODW = 9216;
constexpr int C_AQ = 0, C_AK = 512, C_AV = 640, C_WQ = 768, C_WK = 1280, C_WV = 1408, C_HQ = 1536, C_HFF = 2048, C_HFB = 2560, C_HI = 3072, C_HG = 3584, C_GA = 4096;
constexpr float EPS = 1e-6f, LOG2E = 1.4426950408889634f;
constexpr size_t O_X = 0, O_NKA = 25165824, O_NVA = 29360128, O_NKW = 33554432, O_NVW = 37748736, O_NST = 41943040;
constexpr size_t al256(size_t x) { return (x + 255) & ~(size_t)255; }
constexpr size_t WS_CTL = 0;
constexpr size_t WS_BAR = 4096;
constexpr size_t CTL_BYTES = 32768;
constexpr size_t WS_MOD = CTL_BYTES;
constexpr size_t WS_LB = WS_MOD + al256((size_t)DEPTH * 9 * NMODW * 4);
constexpr size_t WS_ROPE = WS_LB + 16384;
constexpr size_t WSZ = (size_t)(2 * 5632 * 1024 + 2 * 1024 * 2816 + 7168 * 1024 + 3 * 1024 * 512 + 1024 * 1024) * 2;
constexpr size_t WS_W = WS_ROPE + 8192;
constexpr size_t W_FI = 0;
constexpr size_t W_FO = W_FI + (size_t)2 * 5632 * 1024 * 2;
constexpr size_t W_IN = W_FO + (size_t)2 * 1024 * 2816 * 2;
constexpr size_t W_BR = W_IN + (size_t)7168 * 1024 * 2;
constexpr size_t W_OUT = W_BR + (size_t)3 * 1024 * 512 * 2;
constexpr size_t WS_XB = WS_W + WSZ;
constexpr size_t WS_HB = WS_XB + (size_t)T * 1024 * 2;
constexpr size_t WS_PROJ = WS_HB + (size_t)T * 1024 * 2;
constexpr size_t WS_OATT = WS_PROJ + (size_t)T * INW * 2;
constexpr size_t WS_OHG = WS_OATT + (size_t)T * 512 * 2;
constexpr size_t WS_OWIN = WS_OHG + (size_t)T * 512 * 2;
constexpr size_t WS_OF = WS_OWIN + (size_t)T * 512 * 2;
constexpr size_t WS_KAL = WS_OF + (size_t)2 * T * 512 * 4;
constexpr size_t SZ_KL = (size_t)8 * 2 * 2304 * 64 * 2, SZ_KC = (size_t)32 * 2 * 256 * 64 * 2;
constexpr size_t WS_VAL = WS_KAL + SZ_KL;
constexpr size_t WS_KWL = WS_VAL + SZ_KL;
constexpr size_t WS_VWL = WS_KWL + SZ_KL;
constexpr size_t WS_KAC = WS_VWL + SZ_KL;
constexpr size_t WS_VAC = WS_KAC + SZ_KC;
constexpr size_t WS_KWC = WS_VAC + SZ_KC;
constexpr size_t WS_VWC = WS_KWC + SZ_KC;
constexpr size_t WS_END = WS_VWC + SZ_KC;
constexpr int LDS_BYTES = 160 * 1024, LDS_MISC = 159 * 1024;
constexpr int NPH = 1 + 13 * DEPTH + 1;

struct Args { const float* in[22]; float* out; unsigned char* ws; int ph_lo, ph_hi; };

namespace pg8 {
#define PG8_LAS __attribute__((address_space(3)))
typedef unsigned short bf16_t;
typedef short bf16x8 __attribute__((ext_vector_type(8)));
typedef float f32x4 __attribute__((ext_vector_type(4)));
typedef unsigned u32x4 __attribute__((ext_vector_type(4)));
constexpr int BM = 256, BK = 64, HALF = 128, HTB = HALF * BK * 2  , STAGE_BYTES = 8 * HTB, NXCD = 8, WGM = 8;

__host__ __device__ __forceinline__ int lds_byte(int r, int c) { const int st = (r >> 4) * 2 + (c >> 5), rr = r & 15, cc = c & 31, ob = rr * 64 + cc * 2; return st * 1024 + (ob ^ (((ob >> 9) & 1) << 5)); }
__host__ __device__ __forceinline__ void stage_rc(int b, int& R, int& C) { const int st = b / 1024, sb = b % 1024, swz = sb ^ (((sb >> 9) & 1) << 5); R = (st >> 1) * 16 + swz / 64; C = (st & 1) * 32 + (swz % 64) / 2; }
__host__ __device__ __forceinline__ int perm32(int rho) { const int n = rho >> 4, i = rho & 15; return 8 * (i >> 2) + 4 * n + (i & 3); }

struct Unit { int pm, pn; };
struct Gemm { const bf16_t* A; const bf16_t* Bt; int M, N, K; };

struct StaticOrder {
    int nM, nN, nwg, G, c;
    __host__ __device__ void init(int M, int N, int G_, int c_) { nM = M / BM; nN = N / BM; nwg = nM * nN; G = G_; c = c_; }
    __host__ __device__ bool next(int i, Unit& u) const {
        const long L = (long)i * G + c; if (L >= nwg) return false;
        int wgid = (int)L; { const int q = nwg / NXCD, r = nwg % NXCD, xcd = wgid % NXCD, off = wgid / NXCD; wgid = (xcd < r ? xcd * (q + 1) : r * (q + 1) + (xcd - r) * q) + off; }
        const int nig = WGM * nN, gid = wgid / nig, fm = gid * WGM, gsz = (nM - fm) < WGM ? (nM - fm) : WGM;
        u.pm = fm + ((wgid % nig) % gsz); u.pn = (wgid % nig) / gsz; return true;
    }
    __device__ __forceinline__ void a_ready(const Unit&) const {}
    __device__ __forceinline__ void done(const Unit&) const {}
};
struct EpiBf16P {
    static constexpr bool PERM = true, AFTER_DRAIN = false;
    bf16_t* O; int ldc;
    __device__ __forceinline__ void operator()(const f32x4 (&acc)[2][2][4][2], const Unit& u, int wr, int wc, int fr, int fq) const {
        const int row0 = u.pm * BM + wr * 64 + fr, col0 = u.pn * BM + wc * 32 + 8 * fq;
#pragma unroll
        for (int ai = 0; ai < 2; ++ai)
#pragma unroll
            for (int m = 0; m < 4; ++m) { bf16_t* rowp = O + (size_t)(row0 + ai * HALF + m * 16) * ldc + col0;
#pragma unroll
                for (int bj = 0; bj < 2; ++bj) { const f32x4 v0 = acc[ai][bj][m][0], v1 = acc[ai][bj][m][1];
                    u32x4 w; w.x = pk2(v0[0], v0[1]); w.y = pk2(v0[2], v0[3]); w.z = pk2(v1[0], v1[1]); w.w = pk2(v1[2], v1[3]);
                    *(u32x4*)(rowp + bj * HALF) = w; } }
    }
};
struct EpiSwiglu {
    static constexpr bool PERM = true, AFTER_DRAIN = false;
    bf16_t* O;
    __device__ __forceinline__ void operator()(const f32x4 (&acc)[2][2][4][2], const Unit& u, int wr, int wc, int fr, int fq) const {
        const int row0 = u.pm * BM + wr * 64 + fr, col0 = u.pn * HALF + wc * 32 + 8 * fq;
#pragma unroll
        for (int ai = 0; ai < 2; ++ai)
#pragma unroll
            for (int m = 0; m < 4; ++m) { bf16_t* rowp = O + (size_t)(row0 + ai * HALF + m * 16) * DFF + col0;
                float r[8];
#pragma unroll
                for (int n = 0; n < 2; ++n)
#pragma unroll
                    for (int j = 0; j < 4; ++j) { const float g = acc[ai][0][m][n][j], up = acc[ai][1][m][n][j]; r[4 * n + j] = g * __builtin_amdgcn_rcpf(1.f + __expf(-g)) * up; }
                u32x4 w; w.x = pk2(r[0], r[1]); w.y = pk2(r[2], r[3]); w.z = pk2(r[4], r[5]); w.w = pk2(r[6], r[7]);
                *(u32x4*)rowp = w; }
    }
};
struct EpiResid {
    static constexpr bool PERM = true, AFTER_DRAIN = false;
    const float* in0; const float* in1; unsigned char* ws; float* out; int l_; int k_;
    __device__ __forceinline__ void operator()(const f32x4 (&acc)[2][2][4][2], const Unit& u, int wr, int wc, int fr, int fq) const {
        int l = __builtin_amdgcn_readfirstlane(l_), k = __builtin_amdgcn_readfirstlane(k_); asm volatile("" : "+s"(l), "+s"(k));
        const int mode = (k == 2 && l == 0) ? 1 : ((k == 12 && l == DEPTH - 1) ? 2 : 0);
        const float coef = k == 9 ? 1.0f : 0.5f; const float* mod = (const float*)(ws + WS_MOD) + (size_t)l * 9 * NMODW + (k == 2 ? 2 : (k == 9 ? 5 : 8)) * DM;
        bf16_t* xb = (bf16_t*)(ws + WS_XB);
        const int row0 = u.pm * BM + wr * 64 + fr, col0 = u.pn * BM + wc * 32 + 8 * fq;
        const int trow = u.pm * BM; const int cond = trow < TC ? 8 : ((trow - TC) >> 11);
        const float* mp = mod + (size_t)cond * NMODW;
        f32x4 g[2][2];
#pragma unroll
        for (int bj = 0; bj < 2; ++bj)
#pragma unroll
            for (int n = 0; n < 2; ++n) g[bj][n] = coef * *(const f32x4*)(mp + col0 + bj * HALF + 4 * n);
        if (mode == 1) {
            const float* bbase = trow < TC ? in0 + (size_t)row0 * DM : in1 + (size_t)(row0 - TC) * DM;
#pragma unroll
            for (int ai = 0; ai < 2; ++ai) {
                f32x4 bv[4][2][2];
#pragma unroll
                for (int m = 0; m < 4; ++m)
#pragma unroll
                    for (int bj = 0; bj < 2; ++bj)
#pragma unroll
                        for (int n = 0; n < 2; ++n) bv[m][bj][n] = *(const f32x4*)(bbase + (size_t)(ai * HALF + m * 16) * DM + col0 + bj * HALF + 4 * n);
#pragma unroll
                for (int m = 0; m < 4; ++m) { const size_t ro = (size_t)(row0 + ai * HALF + m * 16) * DM + col0;
#pragma unroll
                    for (int bj = 0; bj < 2; ++bj) {
                        const f32x4 x0 = bv[m][bj][0] + g[bj][0] * acc[ai][bj][m][0], x1 = bv[m][bj][1] + g[bj][1] * acc[ai][bj][m][1];
                        u32x4 w; w.x = pk2(x0[0], x0[1]); w.y = pk2(x0[2], x0[3]); w.z = pk2(x1[0], x1[1]); w.w = pk2(x1[2], x1[3]); *(u32x4*)(xb + ro + bj * HALF) = w; } }
            }
        } else {
#pragma unroll
            for (int ai = 0; ai < 2; ++ai) {
                u32x4 raw[4][2];
#pragma unroll
                for (int m = 0; m < 4; ++m)
#pragma unroll
                    for (int bj = 0; bj < 2; ++bj) raw[m][bj] = *(const u32x4*)(xb + (size_t)(row0 + ai * HALF + m * 16) * DM + col0 + bj * HALF);
#pragma unroll
                for (int m = 0; m < 4; ++m) { const size_t ro = (size_t)(row0 + ai * HALF + m * 16) * DM + col0;
#pragma unroll
                    for (int bj = 0; bj < 2; ++bj) { const u32x4 r = raw[m][bj];
                        const f32x4 x0 = (f32x4){bflo(r.x), bfhi(r.x), bflo(r.y), bfhi(r.y)} + g[bj][0] * acc[ai][bj][m][0], x1 = (f32x4){bflo(r.z), bfhi(r.z), bflo(r.w), bfhi(r.w)} + g[bj][1] * acc[ai][bj][m][1];
                        if (mode == 2) { *(f32x4*)(out + ro + bj * HALF) = x0; *(f32x4*)(out + ro + bj * HALF + 4) = x1; }
                        else { u32x4 w; w.x = pk2(x0[0], x0[1]); w.y = pk2(x0[2], x0[3]); w.z = pk2(x1[0], x1[1]); w.w = pk2(x1[2], x1[3]); *(u32x4*)(xb + ro + bj * HALF) = w; } } }
            }
        }
    }
};
struct EpiBranch {
    static constexpr bool PERM = true, AFTER_DRAIN = false;
    const bf16_t* gate; float* acc32; bf16_t* outbf; int mode;
    __device__ __forceinline__ void operator()(const f32x4 (&acc)[2][2][4][2], const Unit& u, int wr, int wc, int fr, int fq) const {
        const int row0 = u.pm * BM + wr * 64 + fr, col0 = u.pn * BM + wc * 32 + 8 * fq;
#pragma unroll
        for (int ai = 0; ai < 2; ++ai) {
            u32x4 gv[4][2], pv[4][2];
#pragma unroll
            for (int m = 0; m < 4; ++m)
#pragma unroll
                for (int bj = 0; bj < 2; ++bj) { const int row = row0 + ai * HALF + m * 16, c = col0 + bj * HALF;
                    gv[m][bj] = *(const u32x4*)(gate + (size_t)row * INW + c);
                    if (mode != 0) pv[m][bj] = *(const u32x4*)(outbf + (size_t)row * DM + c); else pv[m][bj] = (u32x4){0u, 0u, 0u, 0u}; }
#pragma unroll
            for (int m = 0; m < 4; ++m)
#pragma unroll
                for (int bj = 0; bj < 2; ++bj) { const int row = row0 + ai * HALF + m * 16, c = col0 + bj * HALF;
                    const u32x4 g = gv[m][bj], p = pv[m][bj];
                    float v[8];
                    v[0] = sigmoidf_(bflo(g.x)) * acc[ai][bj][m][0][0] + bflo(p.x); v[1] = sigmoidf_(bfhi(g.x)) * acc[ai][bj][m][0][1] + bfhi(p.x);
                    v[2] = sigmoidf_(bflo(g.y)) * acc[ai][bj][m][0][2] + bflo(p.y); v[3] = sigmoidf_(bfhi(g.y)) * acc[ai][bj][m][0][3] + bfhi(p.y);
                    v[4] = sigmoidf_(bflo(g.z)) * acc[ai][bj][m][1][0] + bflo(p.z); v[5] = sigmoidf_(bfhi(g.z)) * acc[ai][bj][m][1][1] + bfhi(p.z);
                    v[6] = sigmoidf_(bflo(g.w)) * acc[ai][bj][m][1][2] + bflo(p.w); v[7] = sigmoidf_(bfhi(g.w)) * acc[ai][bj][m][1][3] + bfhi(p.w);
                    u32x4 w; w.x = pk2(v[0], v[1]); w.y = pk2(v[2], v[3]); w.z = pk2(v[4], v[5]); w.w = pk2(v[6], v[7]);
                    *(u32x4*)(outbf + (size_t)row * DM + c) = w; }
        }
    }
};

template <class Epi, class Sched, bool STAMP = false>
__device__ __forceinline__ void gemm_phase(PG8_LAS unsigned char* lds, const Gemm g, const Sched& S, const Epi& E, unsigned long long* stamps) {
    const int tid = otid(), wid = __builtin_amdgcn_readfirstlane(tid >> 6), lane = tid & 63, wr = wid >> 2, wc = wid & 3, fr = lane & 15, fq = lane >> 4;
    const int K = g.K, nt = K / BK;
    int ts_lo = 0, ts_hi = 0, nts = 0; const unsigned long long rt_entry = STAMP ? (unsigned long long)wall_clock64() : 0ull;
#define PG8_STAMP() do { if (STAMP && wid == 0 && nts < 64) { const unsigned long long _c = (unsigned long long)clock64(); \
        ts_lo = (lane == nts) ? (int)(unsigned)_c : ts_lo; ts_hi = (lane == nts) ? (int)(unsigned)(_c >> 32) : ts_hi; ++nts; } } while (0)
    PG8_STAMP();
    unsigned voffA[2], voffB[2];
#pragma unroll
    for (int i = 0; i < 2; ++i) { int R, C; stage_rc(tid * 16 + i * 8192, R, C); const int Rb = Epi::PERM ? ((R & ~31) + perm32(R & 31)) : R;
        voffA[i] = (unsigned)(R * K + C) * 2u; voffB[i] = (unsigned)(Rb * K + C) * 2u; }
    const size_t kstep = (size_t)(BK * 2);
    const size_t hstep = (size_t)HALF * K * 2;
    const size_t tstep = 2 * hstep;
    const unsigned ldsw = (unsigned)wid * 1024u;
    const int aoff = lds_byte(wr * 64 + fr, fq * 8), boff = lds_byte(wc * 32 + fr, fq * 8);
#define PG8_SA(b, h) (((b) * 2 + (h)) * HTB)
#define PG8_SB(b, h) ((4 + (b) * 2 + (h)) * HTB)
#define PG8_STAGE(bufoff, gbase, voff) do { _Pragma("unroll") for (int _i = 0; _i < 2; ++_i) \
        __builtin_amdgcn_global_load_lds((const unsigned*)((const char*)(gbase) + (voff)[_i]), (PG8_LAS unsigned*)(lds + (bufoff) + ldsw + _i * 8192), 16, 0, 0); } while (0)
#define PG8_LDA(dst, b, h) do { _Pragma("unroll") for (int m = 0; m < 4; ++m) _Pragma("unroll") for (int k = 0; k < 2; ++k) dst[m][k] = *(const PG8_LAS bf16x8*)(lds + PG8_SA(b, h) + aoff + m * 2048 + k * 1024); } while (0)
#define PG8_LDB(dst, b, h) do { _Pragma("unroll") for (int n = 0; n < 2; ++n) _Pragma("unroll") for (int k = 0; k < 2; ++k) dst[n][k] = *(const PG8_LAS bf16x8*)(lds + PG8_SB(b, h) + boff + n * 2048 + k * 1024); } while (0)
#define PG8_MMA(ai, bj, At, Bt) do { __builtin_amdgcn_s_setprio(1); _Pragma("unroll") for (int m = 0; m < 4; ++m) _Pragma("unroll") for (int n = 0; n < 2; ++n) _Pragma("unroll") for (int k = 0; k < 2; ++k) \
        acc[ai][bj][m][n] = __builtin_amdgcn_mfma_f32_16x16x32_bf16(Bt[n][k], At[m][k], acc[ai][bj][m][n], 0, 0, 0); __builtin_amdgcn_s_setprio(0); } while (0)
#define PG8_WAIT_V(n) asm volatile("s_waitcnt vmcnt(" #n ")" ::: "memory")
#define PG8_WAIT_L(n) asm volatile("s_waitcnt lgkmcnt(" #n ")" ::: "memory")
#define PG8_BAR __builtin_amdgcn_s_barrier()
#define PG8_SCHED __builtin_amdgcn_sched_barrier(0)
    Unit cur, nxt; int ui = 0;
    if (!S.next(0, cur)) return;
    f32x4 acc[2][2][4][2];
#pragma unroll
    for (int a = 0; a < 2; ++a)
#pragma unroll
        for (int b = 0; b < 2; ++b)
#pragma unroll
            for (int m = 0; m < 4; ++m)
#pragma unroll
                for (int n = 0; n < 2; ++n) acc[a][b][m][n] = (f32x4){0.f, 0.f, 0.f, 0.f};
    bf16x8 At[4][2], B0[2][2], B1[2][2];
    const char* cA = (const char*)g.A + (size_t)cur.pm * tstep; const char* cB = (const char*)g.Bt + (size_t)cur.pn * tstep;
    S.a_ready(cur);
    PG8_STAGE(PG8_SB(0, 0), cB, voffB); PG8_STAGE(PG8_SA(0, 0), cA, voffA); PG8_STAGE(PG8_SB(0, 1), cB + hstep, voffB); PG8_STAGE(PG8_SA(0, 1), cA + hstep, voffA);
    if (wr == 1) PG8_BAR;
    PG8_WAIT_V(4); PG8_BAR;
    PG8_STAGE(PG8_SB(1, 0), cB + kstep, voffB); PG8_STAGE(PG8_SA(1, 0), cA + kstep, voffA); PG8_STAGE(PG8_SB(1, 1), cB + hstep + kstep, voffB);
    PG8_WAIT_V(6); PG8_BAR;
    PG8_STAMP();
    for (;;) {
        const bool has_next = S.next(ui + 1, nxt);
        const char* nA = has_next ? (const char*)g.A + (size_t)nxt.pm * tstep : cA; const char* nB = has_next ? (const char*)g.Bt + (size_t)nxt.pn * tstep : cB;
        for (int t = 0; t < nt; t += 2) {
            const bool last = (t == nt - 2);
            const char* a1 = cA + (size_t)(t + 1) * kstep;
            const char* a2 = last ? nA : cA + (size_t)(t + 2) * kstep; const char* b2 = last ? nB : cB + (size_t)(t + 2) * kstep;
            const char* a3 = a2 + kstep; const char* b3 = b2 + kstep;
            if (last && has_next) S.a_ready(nxt);
            PG8_LDB(B0, 0, 0); PG8_SCHED; PG8_LDA(At, 0, 0); PG8_STAGE(PG8_SA(1, 1), a1 + hstep, voffA);
            PG8_WAIT_L(8); PG8_BAR; PG8_WAIT_L(0); PG8_MMA(0, 0, At, B0); PG8_BAR; PG8_SCHED;
            PG8_LDB(B1, 0, 1); PG8_STAGE(PG8_SB(0, 0), b2, voffB);
            PG8_BAR; PG8_WAIT_L(0); PG8_MMA(0, 1, At, B1); PG8_BAR;
            PG8_LDA(At, 0, 1); PG8_STAGE(PG8_SA(0, 0), a2, voffA);
            PG8_BAR; PG8_WAIT_L(0); PG8_MMA(1, 0, At, B0); PG8_BAR; PG8_SCHED;
            PG8_STAGE(PG8_SB(0, 1), b2 + hstep, voffB);
            PG8_WAIT_V(6); PG8_BAR; PG8_MMA(1, 1, At, B1); PG8_BAR;
            PG8_LDB(B0, 1, 0); PG8_SCHED; PG8_LDA(At, 1, 0); PG8_STAGE(PG8_SA(0, 1), a2 + hstep, voffA);
            PG8_WAIT_L(8); PG8_BAR; PG8_WAIT_L(0); PG8_MMA(0, 0, At, B0); PG8_BAR; PG8_SCHED;
            PG8_LDB(B1, 1, 1); PG8_STAGE(PG8_SB(1, 0), b3, voffB);
            PG8_BAR; PG8_WAIT_L(0); PG8_MMA(0, 1, At, B1); PG8_BAR;
            PG8_LDA(At, 1, 1); PG8_STAGE(PG8_SA(1, 0), a3, voffA);
            PG8_BAR; PG8_WAIT_L(0); PG8_MMA(1, 0, At, B0); PG8_BAR; PG8_SCHED;
            PG8_STAGE(PG8_SB(1, 1), b3 + hstep, voffB);
            PG8_WAIT_V(6); PG8_BAR; PG8_MMA(1, 1, At, B1); PG8_BAR;
        }
        PG8_STAMP();
        if constexpr (!Epi::AFTER_DRAIN) { E(acc, cur, wr, wc, fr, fq); S.done(cur); }
        PG8_STAMP();
        if (!has_next) break;
#pragma unroll
        for (int a = 0; a < 2; ++a)
#pragma unroll
            for (int b = 0; b < 2; ++b)
#pragma unroll
                for (int m = 0; m < 4; ++m)
#pragma unroll
                    for (int n = 0; n < 2; ++n) acc[a][b][m][n] = (f32x4){0.f, 0.f, 0.f, 0.f};
        cur = nxt; cA = nA; cB = nB; ++ui;
    }
    PG8_WAIT_V(0);
    if (wr == 0) PG8_BAR;
    PG8_BAR;
    if constexpr (Epi::AFTER_DRAIN) { E.fused(acc, cur, wr, wc, fr, fq, lds, wid, lane); S.done(cur); }
    PG8_STAMP();
    if (STAMP && wid == 0) { stamps[lane] = lane < nts ? (((unsigned long long)(unsigned)ts_hi << 32) | (unsigned)ts_lo) : 0ull;
        if (lane == 62) stamps[62] = rt_entry; if (lane == 63) stamps[63] = (unsigned long long)wall_clock64(); }
#undef PG8_STAMP
#undef PG8_SA
#undef PG8_SB
#undef PG8_STAGE
#undef PG8_LDA
#undef PG8_LDB
#undef PG8_MMA
#undef PG8_WAIT_V
#undef PG8_WAIT_L
#undef PG8_BAR
#undef PG8_SCHED
}
}
DI int crow(int i, int h) { return (i & 3) + 8 * (i >> 2) + 4 * h; }
#define LDS_WAIT() asm volatile("s_waitcnt lgkmcnt(0)" ::: "memory")


DI void phase_p0(const Args& a, unsigned char* lds) {
    float* s = (float*)lds; float* red = (float*)(lds + 36864);
    const int tid = otid(), lane = tid & 63, w = tid >> 6;
    float* MOD = (float*)(a.ws + WS_MOD);
    if ((int)blockIdx.x < 144) {
        const float* c = a.in[7]; const float* cctx = a.in[8];
        for (int i = tid; i < 9 * 1024; i += 512) { const int ci = i >> 10, k = i & 1023; const float v = ci < 8 ? c[ci * 1024 + k] : cctx[k]; s[i] = v * sigmoidf_(v); }
        __syncthreads();
        for (int item = blockIdx.x; item < 144; item += gridDim.x) {
            const int l = item / 36, cc = item % 36;
            const float* W = a.in[9] + (size_t)l * 1024 * NMODW + cc * 256 + 4 * lane;
            f32x4 acc[9];
#pragma unroll
            for (int ci = 0; ci < 9; ++ci) acc[ci] = (f32x4){0.f, 0.f, 0.f, 0.f};
#pragma unroll 2
            for (int k4 = 0; k4 < 32; ++k4) {
                const int k = w * 128 + k4 * 4;
                const f32x4 w0 = *(const f32x4*)(W + (size_t)(k + 0) * NMODW), w1 = *(const f32x4*)(W + (size_t)(k + 1) * NMODW),
                            w2 = *(const f32x4*)(W + (size_t)(k + 2) * NMODW), w3 = *(const f32x4*)(W + (size_t)(k + 3) * NMODW);
#pragma unroll
                for (int ci = 0; ci < 9; ++ci) { const f32x4 sv = *(const f32x4*)(s + ci * 1024 + k); acc[ci] += sv[0] * w0 + sv[1] * w1 + sv[2] * w2 + sv[3] * w3; }
            }
#pragma unroll
            for (int ci = 0; ci < 9; ++ci) *(f32x4*)(red + ((w * 9 + ci) * 256 + 4 * lane)) = acc[ci];
            __syncthreads();
            for (int i = tid; i < 9 * 256; i += 512) { const int ci = i >> 8, col = i & 255; float v = 0.f;
#pragma unroll
                for (int ww = 0; ww < 8; ++ww) v += red[(ww * 9 + ci) * 256 + col];
                v += a.in[10][l * NMODW + cc * 256 + col];
                MOD[((size_t)l * 9 + ci) * NMODW + cc * 256 + col] = v; }
            __syncthreads();
        }
    }
    if (blockIdx.x == gridDim.x - 1) {
        float* LB = (float*)(a.ws + WS_LB); const float* lbin = a.in[16];
        for (int e = tid; e < 1024; e += 512) {
            const float x0 = lbin[e], x1 = lbin[1024 + e], x2 = lbin[2048 + e], x3 = lbin[3072 + e];
            const float mx = fmaxf(fmaxf(x0, x1), fmaxf(x2, x3));
            const float e0 = __expf(x0 - mx), e1 = __expf(x1 - mx), e2 = __expf(x2 - mx), e3 = __expf(x3 - mx); const float inv = 1.f / (e0 + e1 + e2 + e3);
            LB[e] = 0.f; LB[1024 + e] = e1 * inv; LB[2048 + e] = (e1 + e2) * inv; LB[3072 + e] = (e1 + e2 + e3) * inv;
        }
        float* cosT = (float*)(a.ws + WS_ROPE); float* sinT = cosT + 1024;
        for (int e = tid; e < 1024; e += 512) { const int pos = e >> 4, i = e & 15; const float inv = exp2f(-(float)i * (13.287712379549449f / 16.f)); const float ang = (float)pos * inv;
            cosT[e] = cosf(ang); sinT[e] = sinf(ang); }
    }
}

DI void transpose_item(const float* W, int ldw, int srccol0, int k0, bf16_t* WT, int K, int dstrow0, float* scr, int lane) {
#pragma unroll 8
    for (int i = 0; i < 32; ++i) { const int kk = 2 * i + (lane >> 5); scr[kk * 33 + (lane & 31)] = W[(size_t)(k0 + kk) * ldw + srccol0 + (lane & 31)]; }
    LDS_WAIT();
    const int c = lane & 7;
#pragma unroll
    for (int j = 0; j < 4; ++j) { const int n = (lane >> 3) + 8 * j; const float* sp = scr + (8 * c) * 33 + n;
        u32x4 o; o.x = pk2(sp[0 * 33], sp[1 * 33]); o.y = pk2(sp[2 * 33], sp[3 * 33]); o.z = pk2(sp[4 * 33], sp[5 * 33]); o.w = pk2(sp[6 * 33], sp[7 * 33]);
        *(u32x4*)(WT + (size_t)(dstrow0 + n) * K + k0 + 8 * c) = o; }
    LDS_WAIT();
}
DI void phase_wconv(const Args& a, unsigned char* lds, int l, int it0, int it1, int rank, int nrank) {
    const int tid = otid(), lane = tid & 63, w = tid >> 6;
    float* scr = (float*)(lds + w * 8448);
    unsigned char* wb = a.ws + WS_W;
    for (int it = it0 + rank * 8 + w; it < it1; it += nrank * 8) {
        int r = it;
        if (r < 5632) { const int j = r / 2816; r -= j * 2816; const int kb = r / 176, nb = r % 176, n0 = 32 * nb, pn = n0 >> 8, loc = n0 & 255;
            const int src = (loc >> 7) * DFF + 128 * pn + (loc & 127);
            transpose_item(a.in[12] + (size_t)(l * 2 + j) * 1024 * 5632, 5632, src, 64 * kb, (bf16_t*)(wb + W_FI) + (size_t)j * 5632 * 1024, 1024, n0, scr, lane); continue; }
        r -= 5632;
        if (r < 2816) { const int j = r / 1408; r -= j * 1408; const int kb = r / 32, nb = r % 32;
            transpose_item(a.in[13] + (size_t)(l * 2 + j) * DFF * 1024, 1024, 32 * nb, 64 * kb, (bf16_t*)(wb + W_FO) + (size_t)j * 1024 * DFF, DFF, 32 * nb, scr, lane); continue; }
        r -= 2816;
        if (r < 3584) { const int kb = r / 224, nb = r % 224;
            transpose_item(a.in[14] + (size_t)l * 1024 * INW, INW, 32 * nb, 64 * kb, (bf16_t*)(wb + W_IN), 1024, 32 * nb, scr, lane); continue; }
        r -= 3584;
        if (r < 768) { const int k = r / 256; r -= k * 256; const int kb = r / 32, nb = r % 32;
            transpose_item(a.in[19] + (size_t)(l * 3 + k) * 512 * 1024, 1024, 32 * nb, 64 * kb, (bf16_t*)(wb + W_BR) + (size_t)k * 1024 * 512, 512, 32 * nb, scr, lane); continue; }
        r -= 768;
        { const int kb = r / 32, nb = r % 32;
            transpose_item(a.in[20] + (size_t)l * 1024 * 1024, 1024, 32 * nb, 64 * kb, (bf16_t*)(wb + W_OUT), 1024, 32 * nb, scr, lane); }
    }
}

DI void phase_norm(const Args& a, int l, int j, bool first) {
    const int tid = otid(), lane = tid & 63, w = tid >> 6;
    const int gw = obid() * 8 + w, NGW = gridDim.x * 8;
    const float* g = a.in[11] + (size_t)(l * 3 + j) * DM; const float* MOD = (const float*)(a.ws + WS_MOD) + (size_t)l * 9 * NMODW;
    bf16_t* HB = (bf16_t*)(a.ws + WS_HB);
    if (first) {
        f32x4 gg[4];
#pragma unroll
        for (int jj = 0; jj < 4; ++jj) gg[jj] = *(const f32x4*)(g + 4 * lane + 256 * jj);
        for (int row = gw; row < T; row += NGW) {
            const float* xr = row < TC ? a.in[0] + (size_t)row * DM : a.in[1] + (size_t)(row - TC) * DM;
            const int cond = row < TC ? 8 : ((row - TC) >> 11);
            const float* shift = MOD + (size_t)cond * NMODW + 3 * j * DM; const float* scale = shift + DM;
            f32x4 v[4]; float ss = 0.f;
#pragma unroll
            for (int jj = 0; jj < 4; ++jj) { v[jj] = *(const f32x4*)(xr + 4 * lane + 256 * jj); ss += (v[jj][0] * v[jj][0] + v[jj][1] * v[jj][1]) + (v[jj][2] * v[jj][2] + v[jj][3] * v[jj][3]); }
            const float rstd = rsqrtf(wave_sum(ss) * (1.f / DM) + EPS);
#pragma unroll
            for (int jj = 0; jj < 4; ++jj) { const f32x4 sc = *(const f32x4*)(scale + 4 * lane + 256 * jj), sh = *(const f32x4*)(shift + 4 * lane + 256 * jj);
                const f32x4 y = v[jj] * rstd * gg[jj] * (1.f + sc) + sh;
                u32x2 o; o.x = pk2(y[0], y[1]); o.y = pk2(y[2], y[3]);
                *(u32x2*)(HB + (size_t)row * DM + 4 * lane + 256 * jj) = o; }
        }
    } else {
        const bf16_t* XB = (const bf16_t*)(a.ws + WS_XB);
        f32x4 gg[2][2];
#pragma unroll
        for (int jj = 0; jj < 2; ++jj) { gg[jj][0] = *(const f32x4*)(g + 8 * lane + 512 * jj); gg[jj][1] = *(const f32x4*)(g + 8 * lane + 512 * jj + 4); }
        for (int row = gw; row < T; row += NGW) {
            const int cond = row < TC ? 8 : ((row - TC) >> 11);
            const float* shift = MOD + (size_t)cond * NMODW + 3 * j * DM; const float* scale = shift + DM;
            f32x4 v[2][2]; float ss = 0.f;
#pragma unroll
            for (int jj = 0; jj < 2; ++jj) { const u32x4 r = *(const u32x4*)(XB + (size_t)row * DM + 8 * lane + 512 * jj);
                v[jj][0] = (f32x4){bflo(r.x), bfhi(r.x), bflo(r.y), bfhi(r.y)}; v[jj][1] = (f32x4){bflo(r.z), bfhi(r.z), bflo(r.w), bfhi(r.w)};
#pragma unroll
                for (int q = 0; q < 2; ++q) ss += (v[jj][q][0] * v[jj][q][0] + v[jj][q][1] * v[jj][q][1]) + (v[jj][q][2] * v[jj][q][2] + v[jj][q][3] * v[jj][q][3]); }
            const float rstd = rsqrtf(wave_sum(ss) * (1.f / DM) + EPS);
#pragma unroll
            for (int jj = 0; jj < 2; ++jj) { f32x4 y[2];
#pragma unroll
                for (int q = 0; q < 2; ++q) { const f32x4 sc = *(const f32x4*)(scale + 8 * lane + 512 * jj + 4 * q), sh = *(const f32x4*)(shift + 8 * lane + 512 * jj + 4 * q);
                    y[q] = v[jj][q] * rstd * gg[jj][q] * (1.f + sc) + sh; }
                u32x4 o; o.x = pk2(y[0][0], y[0][1]); o.y = pk2(y[0][2], y[0][3]); o.z = pk2(y[1][0], y[1][1]); o.w = pk2(y[1][2], y[1][3]);
                *(u32x4*)(HB + (size_t)row * DM + 8 * lane + 512 * jj) = o; }
        }
    }
}
DI void phase_final(const Args& a) {
    const int tid = otid(), lane = tid & 63, w = tid >> 6;
    const int gw = obid() * 8 + w, NGW = gridDim.x * 8;
    const float* g = a.in[21];
    f32x4 gg[4];
#pragma unroll
    for (int jj = 0; jj < 4; ++jj) gg[jj] = *(const f32x4*)(g + 4 * lane + 256 * jj);
    for (int row = gw; row < T; row += NGW) {
        float* xr = a.out + (size_t)row * DM;
        f32x4 v[4]; float ss = 0.f;
#pragma unroll
        for (int jj = 0; jj < 4; ++jj) { v[jj] = *(const f32x4*)(xr + 4 * lane + 256 * jj); ss += (v[jj][0] * v[jj][0] + v[jj][1] * v[jj][1]) + (v[jj][2] * v[jj][2] + v[jj][3] * v[jj][3]); }
        const float rstd = rsqrtf(wave_sum(ss) * (1.f / DM) + EPS);
#pragma unroll
        for (int jj = 0; jj < 4; ++jj) *(f32x4*)(xr + 4 * lane + 256 * jj) = v[jj] * rstd * gg[jj];
    }
}

DI void phase_prep(const Args& a, int l, bool dry) {
    const int tid = otid(), lane = tid & 63, w = tid >> 6;
    const int gw = obid() * 8 + w, NGW = gridDim.x * 8;
    bf16_t* PROJ = (bf16_t*)(a.ws + WS_PROJ);
    const float* cosT = (const float*)(a.ws + WS_ROPE); const float* sinT = cosT + 1024;
    const float qg = a.in[15][(l * 2 + 0) * 64 + lane], kg = a.in[15][(l * 2 + 1) * 64 + lane];
    bf16_t* KAL = (bf16_t*)(a.ws + WS_KAL); bf16_t* VAL = (bf16_t*)(a.ws + WS_VAL); bf16_t* KWL = (bf16_t*)(a.ws + WS_KWL); bf16_t* VWL = (bf16_t*)(a.ws + WS_VWL);
    bf16_t* KAC = (bf16_t*)(a.ws + WS_KAC); bf16_t* VAC = (bf16_t*)(a.ws + WS_VAC); bf16_t* KWC = (bf16_t*)(a.ws + WS_KWC); bf16_t* VWC = (bf16_t*)(a.ws + WS_VWC);
    for (int r = gw; r < T + 2048; r += NGW) {
        if (r < T) {
            const bool lat = r >= TC; int b, t;
            if (lat) { b = (r - TC) >> 11; t = (r - TC) & 2047; } else { b = r >> 8; t = r & 255; }
            float cs = 1.f, sn = 0.f;
            if (lat) { const int pos = (lane & 32) ? (t & 63) : (t >> 6); cs = cosT[pos * 16 + (lane & 15)]; sn = sinT[pos * 16 + (lane & 15)]; if (!(lane & 16)) sn = -sn; }
            bf16_t* pr = PROJ + (size_t)r * INW;
            bf16_t raw[24];
#pragma unroll
            for (int hh = 0; hh < 24; ++hh) raw[hh] = pr[64 * hh + lane];
#pragma unroll
            for (int h = 0; h < 8; ++h) {
                const float x = bf2f(raw[h]); const float ss = wave_sum(x * x);
                float y = x * rsqrtf(ss * (1.f / 64.f) + EPS) * qg;
                if (lat) { const float p = __shfl_xor(y, 16); y = y * cs + p * sn; }
                if (!dry) pr[C_AQ + 64 * h + lane] = f2bf(y * (0.125f * LOG2E));
            }
#pragma unroll
            for (int h = 0; h < 8; ++h) {
                float y = bf2f(raw[12 + h]);
                if (lat) { const float p = __shfl_xor(y, 16); y = y * cs + p * sn; }
                if (!dry) pr[C_WQ + 64 * h + lane] = f2bf(y * (0.125f * LOG2E));
            }
#pragma unroll
            for (int g2 = 0; g2 < 2; ++g2) {
                const float x = bf2f(raw[8 + g2]); const float ss = wave_sum(x * x);
                float y = x * rsqrtf(ss * (1.f / 64.f) + EPS) * kg;
                if (lat) { const float p = __shfl_xor(y, 16); y = y * cs + p * sn; }
                const bf16_t vbits = raw[10 + g2];
                float yw = bf2f(raw[20 + g2]);
                if (lat) { const float p = __shfl_xor(yw, 16); yw = yw * cs + p * sn; }
                const bf16_t wvbits = raw[22 + g2];
                if (lat) {
                    KAL[((size_t)(b * 2 + g2) * 2304 + 256 + t) * 64 + lane] = f2bf(y);
                    VAL[((size_t)(b * 2 + g2) * 64 + lane) * 2304 + 256 + t] = vbits;
                    KWL[((size_t)(b * 2 + g2) * 2304 + 256 + t) * 64 + lane] = f2bf(yw);
                    VWL[((size_t)(b * 2 + g2) * 64 + lane) * 2304 + 256 + t] = wvbits;
                } else {
                    KAC[((size_t)(b * 2 + g2) * 256 + t) * 64 + lane] = f2bf(y);
                    VAC[((size_t)(b * 2 + g2) * 64 + lane) * 256 + t] = vbits;
                    KWC[((size_t)(b * 2 + g2) * 256 + t) * 64 + lane] = f2bf(yw);
                    VWC[((size_t)(b * 2 + g2) * 64 + lane) * 256 + t] = wvbits;
                    const size_t oi = ((((size_t)b * DEPTH + l) * 256 + t) * 2 + g2) * 64 + lane;
                    a.out[O_NKA + oi] = y; a.out[O_NVA + oi] = bf2f(vbits); a.out[O_NKW + oi] = yw; a.out[O_NVW + oi] = bf2f(wvbits);
                }
            }
        } else {
            const int idx = r - T, b = idx >> 8, p = idx & 255;
#pragma unroll
            for (int g2 = 0; g2 < 2; ++g2) {
                const size_t ci = ((((size_t)b * DEPTH + l) * 256 + p) * 2 + g2) * 64 + lane;
                KAL[((size_t)(b * 2 + g2) * 2304 + p) * 64 + lane] = f2bf(a.in[2][ci]);
                VAL[((size_t)(b * 2 + g2) * 64 + lane) * 2304 + p] = f2bf(a.in[3][ci]);
                KWL[((size_t)(b * 2 + g2) * 2304 + p) * 64 + lane] = f2bf(a.in[4][ci]);
                VWL[((size_t)(b * 2 + g2) * 64 + lane) * 2304 + p] = f2bf(a.in[5][ci]);
            }
        }
    }
}

DI void attn_item(unsigned char* lds, const bf16_t* qp, bf16_t* op, const bf16_t* Kb, const bf16_t* VTb, int nk, int nA, int lo, int hi, bool win, int tq, bool has_sink, float sink2, bool nomax) {
    const int tid = otid(), lane = tid & 63, h = lane >> 5, c = lane & 31;
    const int n64 = nA + (hi - lo), nit = (n64 + 1) >> 1;
    constexpr int STG = 17664;
    bf16_t* Kst0 = (bf16_t*)lds; bf16_t* Vst0 = (bf16_t*)lds + 9216;
    int qoff = (tid >> 6) * 2048 + lane * 8;
    bf16_t* qpark = (bf16_t*)lds + 2 * STG;
#pragma unroll
    for (int s = 0; s < 4; ++s) *(bf16x8*)(qpark + qoff + s * 512) = *(const bf16x8*)(qp + 16 * s + 8 * h);
    f32x16 O0, O1;
#pragma unroll
    for (int i = 0; i < 16; ++i) { O0[i] = 0.f; O1[i] = 0.f; }
    float m = 0.f, lsum = 0.f;
    const int lrow = tid >> 3, lch = tid & 7;
    u32x4 kR, vR;
#define AT_KEY0(j) (((j) < nA ? (j) : 4 + lo + ((j) - nA)) * 64)
#define AT_LOAD(it, sub) do { const int j_ = (2 * (it) + (sub) < n64) ? 2 * (it) + (sub) : 2 * (it); const int k_ = AT_KEY0(j_); \
        kR = *(const u32x4*)(Kb + (size_t)(k_ + lrow) * 64 + 8 * lch); vR = *(const u32x4*)(VTb + (size_t)lrow * nk + k_ + 8 * lch); } while (0)
#define AT_STORE(stg, sub) do { bf16_t* kd_ = Kst0 + (stg) * STG; bf16_t* vd_ = Vst0 + (stg) * STG; \
        *(u32x4*)(kd_ + (64 * (sub) + lrow) * 72 + 8 * lch) = kR; \
        *(u32x2*)(vd_ + lrow * 132 + 64 * (sub) + 8 * lch) = (u32x2){vR.x, vR.y}; *(u32x2*)(vd_ + lrow * 132 + 64 * (sub) + 8 * lch + 4) = (u32x2){vR.z, vR.w}; } while (0)
    AT_LOAD(0, 0); AT_STORE(0, 0); AT_LOAD(0, 1); AT_STORE(0, 1);
    __syncthreads();
    for (int i = 0; i < nit; ++i) {
        const int cur = i & 1;
        if (i + 1 < nit) AT_LOAD(i + 1, 0);
        const bf16_t* Kc = Kst0 + cur * STG; const bf16_t* Vc = Vst0 + cur * STG;
        f32x16 st[4];
        const float cinit = -m;
#pragma unroll
        for (int t = 0; t < 4; ++t)
#pragma unroll
            for (int ii = 0; ii < 16; ++ii) st[t][ii] = cinit;
        asm volatile("" : "+v"(qoff));
#pragma unroll
        for (int s = 0; s < 4; ++s) { const bf16x8 qv = *(const bf16x8*)(qpark + qoff + s * 512);
#pragma unroll
            for (int t = 0; t < 4; ++t) { const bf16x8 ak = *(const bf16x8*)(Kc + (32 * t + c) * 72 + 16 * s + 8 * h); st[t] = MFMA32(ak, qv, st[t]); } }
        float ps = 0.f;
        if (nomax) {
#pragma unroll
            for (int t = 0; t < 4; ++t)
#pragma unroll
                for (int ii = 0; ii < 16; ++ii) { const float p = __builtin_amdgcn_exp2f(st[t][ii]); st[t][ii] = p; ps += p; }
            lsum += ps;
        } else {
            const int ja = 2 * i, jb = 2 * i + 1;
            if (win && ja >= nA) { const int k0 = AT_KEY0(ja);
#pragma unroll
                for (int t = 0; t < 2; ++t)
#pragma unroll
                    for (int ii = 0; ii < 16; ++ii) { const int dd = tq - (k0 - 256 + 32 * t + crow(ii, h)); if (dd > 128 || dd < -128) st[t][ii] = -1e30f; } }
            if (jb >= n64) {
#pragma unroll
                for (int t = 2; t < 4; ++t)
#pragma unroll
                    for (int ii = 0; ii < 16; ++ii) st[t][ii] = -1e30f;
            } else if (win && jb >= nA) { const int k0 = AT_KEY0(jb);
#pragma unroll
                for (int t = 2; t < 4; ++t)
#pragma unroll
                    for (int ii = 0; ii < 16; ++ii) { const int dd = tq - (k0 - 256 + 32 * (t - 2) + crow(ii, h)); if (dd > 128 || dd < -128) st[t][ii] = -1e30f; } }
            float mx = -1e30f;
#pragma unroll
            for (int ii = 0; ii < 16; ++ii) mx = fmaxf(mx, fmaxf(fmaxf(st[0][ii], st[1][ii]), fmaxf(st[2][ii], st[3][ii])));
            mx = fmaxf(mx, __shfl_xor(mx, 32));
            if (i == 0) {
                const float mnew = has_sink ? fmaxf(mx, sink2) : mx;
#pragma unroll
                for (int t = 0; t < 4; ++t)
#pragma unroll
                    for (int ii = 0; ii < 16; ++ii) { const float p = __builtin_amdgcn_exp2f(st[t][ii] - mnew); st[t][ii] = p; ps += p; }
                lsum = ps + ((has_sink && h == 0) ? __builtin_amdgcn_exp2f(sink2 - mnew) : 0.f);
                m = mnew;
            } else if (__builtin_amdgcn_ballot_w64(mx > 0.f) != 0ull) {
                const float delta = fmaxf(mx, 0.f); const float alpha = __builtin_amdgcn_exp2f(-delta); m += delta;
#pragma unroll
                for (int t = 0; t < 4; ++t)
#pragma unroll
                    for (int ii = 0; ii < 16; ++ii) { const float p = __builtin_amdgcn_exp2f(st[t][ii] - delta); st[t][ii] = p; ps += p; }
                lsum = lsum * alpha + ps;
#pragma unroll
                for (int ii = 0; ii < 16; ++ii) { O0[ii] *= alpha; O1[ii] *= alpha; }
            } else {
#pragma unroll
                for (int t = 0; t < 4; ++t)
#pragma unroll
                    for (int ii = 0; ii < 16; ++ii) { const float p = __builtin_amdgcn_exp2f(st[t][ii]); st[t][ii] = p; ps += p; }
                lsum += ps;
            }
        }
        if (i + 1 < nit) { AT_STORE(cur ^ 1, 0); AT_LOAD(i + 1, 1); }
#pragma unroll
        for (int t = 0; t < 4; ++t)
#pragma unroll
            for (int s2 = 0; s2 < 2; ++s2) {
                const bf16x8 pb = pack8(st[t][8 * s2], st[t][8 * s2 + 1], st[t][8 * s2 + 2], st[t][8 * s2 + 3], st[t][8 * s2 + 4], st[t][8 * s2 + 5], st[t][8 * s2 + 6], st[t][8 * s2 + 7]);
                const bf16_t* v0p = Vc + c * 132 + 32 * t + 16 * s2 + 4 * h; const bf16_t* v1p = Vc + (32 + c) * 132 + 32 * t + 16 * s2 + 4 * h;
                O0 = MFMA32(cat44(*(const s16x4*)(v0p), *(const s16x4*)(v0p + 8)), pb, O0);
                O1 = MFMA32(cat44(*(const s16x4*)(v1p), *(const s16x4*)(v1p + 8)), pb, O1);
            }
        if (i + 1 < nit) AT_STORE(cur ^ 1, 1);
        __syncthreads();
    }
#undef AT_KEY0
#undef AT_LOAD
#undef AT_STORE
    lsum += __shfl_xor(lsum, 32);
    const float inv = 1.f / lsum;
#pragma unroll
    for (int g4 = 0; g4 < 4; ++g4) {
        u32x2 w0, w1;
        w0.x = pk2(O0[4 * g4] * inv, O0[4 * g4 + 1] * inv); w0.y = pk2(O0[4 * g4 + 2] * inv, O0[4 * g4 + 3] * inv);
        w1.x = pk2(O1[4 * g4] * inv, O1[4 * g4 + 1] * inv); w1.y = pk2(O1[4 * g4 + 2] * inv, O1[4 * g4 + 3] * inv);
        *(u32x2*)(op + 8 * g4 + 4 * h) = w0; *(u32x2*)(op + 32 + 8 * g4 + 4 * h) = w1;
    }
}
#define LAS __attribute__((address_space(3)))
#define XB_TMO      128
#define XB_XCNT(j)  (256  + 64 * (j))
#define XB_XSUB(j)  (1280 + 64 * (j))
#define XB_XGEN(j)  (2304 + 64 * (j))
#define XB_TOP      3328
#define XB_TOPGEN   3392
#define XCD_BAR_WORDS 3456
#define XB_SPIN_CAP (1u << 18)

__device__ __forceinline__ unsigned xb_ld(unsigned* p)              { return __hip_atomic_load(p, __ATOMIC_RELAXED, __HIP_MEMORY_SCOPE_AGENT); }
__device__ __forceinline__ unsigned xb_add(unsigned* p, unsigned v) { return __hip_atomic_fetch_add(p, v, __ATOMIC_RELAXED, __HIP_MEMORY_SCOPE_AGENT); }
__device__ __forceinline__ unsigned xb_xcc_id() { return (unsigned)__builtin_amdgcn_s_getreg((3 << 11) | 20) & 0xFu; }
#define XB_SPIN(cond, bar) do { unsigned _sp = 0; while (cond) { __builtin_amdgcn_s_sleep(1); \
    if ((++_sp & 255u) == 0u) { if (xb_ld(&(bar)[XB_TMO])) break; if (_sp > XB_SPIN_CAP) { atomicAdd(&(bar)[XB_TMO], 1u); break; } } } } while (0)

struct XcdBarrier {
    unsigned* bar; unsigned x;
    volatile LAS unsigned* st;
};

__device__ __forceinline__ XcdBarrier xcd_barrier_post(unsigned* bar, volatile LAS unsigned* st) {
    XcdBarrier b; b.bar = bar; b.x = xb_xcc_id(); b.st = st;
    if (threadIdx.x == 0) (void)xb_add(&bar[XB_XCNT(b.x)], 1u);
    return b;
}
__device__ __forceinline__ void xcd_barrier_complete(unsigned* bar, unsigned x, unsigned& nloc, unsigned& nx) {
    const unsigned G = gridDim.x * gridDim.y * gridDim.z;
    unsigned sum, cnt, mine, sp = 0u;
    for (;;) {
        sum = 0u; cnt = 0u; mine = 0u;
#pragma unroll
        for (unsigned j = 0; j < 16; ++j) { const unsigned c = xb_ld(&bar[XB_XCNT(j)]); sum += c; cnt += (c > 0u) ? 1u : 0u; mine = (j == x) ? c : mine; }
        if (sum == G) break;
        __builtin_amdgcn_s_sleep(1);
        if ((++sp & 255u) == 0u) { if (xb_ld(&bar[XB_TMO])) break; if (sp > XB_SPIN_CAP) { atomicAdd(&bar[XB_TMO], 1u); break; } }
    }
    nloc = mine > 0u ? mine : 1u; nx = cnt > 0u ? cnt : 1u;
}

__device__ __forceinline__ void xcd_barrier(const XcdBarrier& b) {
    asm volatile("s_waitcnt vmcnt(0)" ::: "memory");
    __syncthreads();
    if (threadIdx.x == 0) {
        unsigned* bar = b.bar;
        __builtin_amdgcn_s_waitcnt(0);
        unsigned nloc = b.st[0], nx = b.st[1];
        if (nloc == 0u) { xcd_barrier_complete(bar, b.x, nloc, nx); b.st[0] = nloc; b.st[1] = nx; }
        const unsigned old = xb_add(&bar[XB_XSUB(b.x)], 1u);
        const unsigned gen = old / nloc;
        if (old + 1u == (gen + 1u) * nloc) {
            __builtin_amdgcn_fence(__ATOMIC_RELEASE, "agent");
            asm volatile("s_waitcnt vmcnt(0)" ::: "memory");
            const unsigned og = xb_add(&bar[XB_TOP], 1u);
            const unsigned tg = og / nx;
            if (og + 1u == (tg + 1u) * nx) xb_add(&bar[XB_TOPGEN], 1u);
            else XB_SPIN(xb_ld(&bar[XB_TOPGEN]) == tg, bar);
            __builtin_amdgcn_fence(__ATOMIC_ACQUIRE, "agent");
            xb_add(&bar[XB_XGEN(b.x)], 1u);
            asm volatile("s_waitcnt vmcnt(0)" ::: "memory");
        } else {
            XB_SPIN(xb_ld(&bar[XB_XGEN(b.x)]) == gen, bar);
            __builtin_amdgcn_fence(__ATOMIC_ACQUIRE, "agent");
            asm volatile("s_waitcnt vmcnt(0)" ::: "memory");
        }
    }
    __syncthreads();
}


DI void hgrn_item(const Args& a, unsigned char* lds, int l, int seq, int hd, int dir) {
    const int tid = otid(), lane = tid & 63, w = tid >> 6, h = lane >> 5, c = lane & 31;
    const bool lat = seq < 8; const int b = lat ? seq : seq - 8; const int L = lat ? 2048 : 256; const int nch = L >> 5; const int seqbase = lat ? TC + b * 2048 : b * 256;
    bf16_t* RQ = (bf16_t*)lds; bf16_t* RZ = (bf16_t*)(lds + 8704); bf16_t* RV = (bf16_t*)(lds + 17408);
    bf16_t* QS = (bf16_t*)(lds + 26112); bf16_t* KS = (bf16_t*)(lds + 34816);
    bf16_t* KST = (bf16_t*)(lds + 43520); bf16_t* VT = (bf16_t*)(lds + 53760); float* E0 = (float*)(lds + 64000); float* E1 = E0 + 128;
    const bf16_t* PROJ = (const bf16_t*)(a.ws + WS_PROJ);
    float* OF = (float*)(a.ws + WS_OF);
    const int cq = C_HQ + 128 * hd, cz = (dir ? C_HFB : C_HFF) + 128 * hd, cv = C_HI + 128 * hd;
    const int wd = w & 3;
    const int dmy = 32 * wd + c;
    const int t0 = 16 * (w >> 2) + 8 * h;
    f32x16 S[4];
    if (w < 4) {
        if (lat) { const float* sp = a.in[6] + ((((size_t)(b * DEPTH + l) * 2 + dir) * 4 + hd) * 128) * 128;
#pragma unroll
            for (int dt = 0; dt < 4; ++dt)
#pragma unroll
                for (int ii = 0; ii < 16; ++ii) S[dt][ii] = sp[(size_t)(32 * dt + crow(ii, h)) * 128 + dmy];
        } else {
#pragma unroll
            for (int dt = 0; dt < 4; ++dt)
#pragma unroll
                for (int ii = 0; ii < 16; ++ii) S[dt][ii] = 0.f;
        }
    }
    const float lbv = ((const float*)(a.ws + WS_LB))[(l * 2 + dir) * 512 + 128 * hd + dmy];
    const float omlb = 1.f - lbv;
    u32x4 rq, rz, rv;
    const int lt = tid >> 4, lcn = tid & 15;
#define HG_GLOAD(ch) do { const int p_ = 32 * (ch) + lt, pos_ = dir ? L - 1 - p_ : p_; const bf16_t* rp_ = PROJ + (size_t)(seqbase + pos_) * INW + 8 * lcn; \
        rq = *(const u32x4*)(rp_ + cq); rz = *(const u32x4*)(rp_ + cz); rv = *(const u32x4*)(rp_ + cv); } while (0)
    HG_GLOAD(0);
    for (int ch = 0; ch < nch; ++ch) {
        *(u32x4*)(RQ + lt * 136 + 8 * lcn) = rq; *(u32x4*)(RZ + lt * 136 + 8 * lcn) = rz; *(u32x4*)(RV + lt * 136 + 8 * lcn) = rv;
        __syncthreads();
        if (ch + 1 < nch) HG_GLOAD(ch + 1);
        {
            float qv[8], kv[8], gv[8]; float qtot = 0.f;
#pragma unroll
            for (int tt = 0; tt < 8; ++tt) { const int t = t0 + tt; const float qr = bf2f(RQ[t * 136 + dmy]), z = bf2f(RZ[t * 136 + dmy]);
                const float sg = sigmoidf_(z); const float f = lbv + omlb * sg; const float g = __logf(fmaxf(f, 1e-30f));
                kv[tt] = omlb * (1.f - sg); qv[tt] = qr * sigmoidf_(qr); gv[tt] = g; qtot += g; }
            const float partner = __shfl_xor(qtot, 32);
            float e[8];
            if (w < 4) { float run = h ? 0.f : -partner;
#pragma unroll
                for (int tt = 7; tt >= 0; --tt) { e[tt] = run; run -= gv[tt]; }
                if (h == 0) E0[dmy] = __expf(qtot + partner);
            } else { float run = h ? partner : 0.f;
#pragma unroll
                for (int tt = 0; tt < 8; ++tt) { run += gv[tt]; e[tt] = run; }
                if (h == 0) E1[dmy] = __expf(qtot + partner);
            }
            float ke[8];
#pragma unroll
            for (int tt = 0; tt < 8; ++tt) { const int t = t0 + tt; const float ex = __expf(fminf(fmaxf(e[tt], -80.f), 80.f)), exn = __builtin_amdgcn_rcpf(ex);
                ke[tt] = kv[tt] * exn;
                QS[t * 136 + dmy] = f2bf(qv[tt] * ex); KS[t * 136 + dmy] = f2bf(ke[tt]); }
            *(bf16x8*)(KST + dmy * 40 + t0) = pack8(ke[0], ke[1], ke[2], ke[3], ke[4], ke[5], ke[6], ke[7]);
            bf16x8 v0;
#pragma unroll
            for (int tt = 0; tt < 8; ++tt) v0[tt] = (short)RV[(t0 + tt) * 136 + dmy];
            *(bf16x8*)(VT + dmy * 40 + t0) = v0;
        }
        __syncthreads();
        if (w < 4) {
            f32x16 st;
#pragma unroll
            for (int ii = 0; ii < 16; ++ii) st[ii] = 0.f;
#pragma unroll
            for (int s = 0; s < 8; ++s) { const bf16x8 ak = *(const bf16x8*)(KS + c * 136 + 16 * s + 8 * h), bq = *(const bf16x8*)(QS + c * 136 + 16 * s + 8 * h); st = MFMA32(ak, bq, st); }
#pragma unroll
            for (int ii = 0; ii < 16; ++ii) if (crow(ii, h) > c) st[ii] = 0.f;
            f32x16 o;
#pragma unroll
            for (int ii = 0; ii < 16; ++ii) o[ii] = 0.f;
#pragma unroll
            for (int s2 = 0; s2 < 2; ++s2) {
                const bf16x8 pb = pack8(st[8 * s2], st[8 * s2 + 1], st[8 * s2 + 2], st[8 * s2 + 3], st[8 * s2 + 4], st[8 * s2 + 5], st[8 * s2 + 6], st[8 * s2 + 7]);
                const bf16_t* vp = VT + dmy * 40 + 16 * s2 + 4 * h;
                o = MFMA32(cat44(*(const s16x4*)vp, *(const s16x4*)(vp + 8)), pb, o);
            }
#pragma unroll
            for (int dt = 0; dt < 4; ++dt) {
#pragma unroll
                for (int g4 = 0; g4 < 4; ++g4) { const f32x4 ev = *(const f32x4*)(E0 + 32 * dt + 8 * g4 + 4 * h);
                    S[dt][4 * g4] *= ev[0]; S[dt][4 * g4 + 1] *= ev[1]; S[dt][4 * g4 + 2] *= ev[2]; S[dt][4 * g4 + 3] *= ev[3]; }
#pragma unroll
                for (int s2 = 0; s2 < 2; ++s2) {
                    const bf16x8 xs = pack8(S[dt][8 * s2], S[dt][8 * s2 + 1], S[dt][8 * s2 + 2], S[dt][8 * s2 + 3], S[dt][8 * s2 + 4], S[dt][8 * s2 + 5], S[dt][8 * s2 + 6], S[dt][8 * s2 + 7]);
                    const bf16_t* qb = QS + c * 136 + 32 * dt + 16 * s2 + 4 * h;
                    o = MFMA32(xs, cat44(*(const s16x4*)qb, *(const s16x4*)(qb + 8)), o);
                }
            }
            {   const int p = 32 * ch + c, pos = dir ? L - 1 - p : p;
                float* op = OF + ((size_t)dir * T + seqbase + pos) * 512 + 128 * hd + 32 * wd;
#pragma unroll
                for (int g4 = 0; g4 < 4; ++g4) { f32x4 v; v[0] = o[4 * g4]; v[1] = o[4 * g4 + 1]; v[2] = o[4 * g4 + 2]; v[3] = o[4 * g4 + 3]; *(f32x4*)(op + 8 * g4 + 4 * h) = v; } }
#pragma unroll
            for (int dt = 0; dt < 4; ++dt) {
#pragma unroll
                for (int s2 = 0; s2 < 2; ++s2) { const bf16x8 ak = *(const bf16x8*)(KST + (32 * dt + c) * 40 + 16 * s2 + 8 * h), bv = *(const bf16x8*)(VT + dmy * 40 + 16 * s2 + 8 * h);
                    S[dt] = MFMA32(ak, bv, S[dt]); }
#pragma unroll
                for (int g4 = 0; g4 < 4; ++g4) { const f32x4 ev = *(const f32x4*)(E1 + 32 * dt + 8 * g4 + 4 * h);
                    S[dt][4 * g4] *= ev[0]; S[dt][4 * g4 + 1] *= ev[1]; S[dt][4 * g4 + 2] *= ev[2]; S[dt][4 * g4 + 3] *= ev[3]; }
            }
        }
    }
#undef HG_GLOAD
    if (!lat && w < 4) { float* sp = a.out + O_NST + ((((size_t)(b * DEPTH + l) * 2 + dir) * 4 + hd) * 128) * 128;
#pragma unroll
        for (int dt = 0; dt < 4; ++dt)
#pragma unroll
            for (int ii = 0; ii < 16; ++ii) sp[(size_t)(32 * dt + crow(ii, h)) * 128 + dmy] = S[dt][ii];
    }
}

DI void phase_mixer(const Args& a, unsigned char* lds, int l, int rep) {
    unsigned* ctl = (unsigned*)(a.ws + WS_CTL) + 16 * l + 8 * rep;
    volatile int* slot = (volatile int*)(lds + LDS_MISC);
    const int tid = otid(), lane = tid & 63, w = tid >> 6, c = lane & 31;
    bf16_t* PROJ = (bf16_t*)(a.ws + WS_PROJ);
    for (;;) {
        __syncthreads();
        if (tid == 0) *slot = (int)__hip_atomic_fetch_add(ctl, 1u, __ATOMIC_RELAXED, __HIP_MEMORY_SCOPE_AGENT);
        __syncthreads();
        const int it = *slot;
        if (it >= 1856) break;
#if PROBE_MASK & 16
        if (rep && !(it < 64 || (it >= 576 && it < 832))) continue;
#endif
#if PROBE_MASK & 32
        if (rep && (it < 64 || (it >= 576 && it < 832))) continue;
#endif
#ifndef NO_HG
        if (it < 64) { hgrn_item(a, lds, l, it >> 3, (it >> 1) & 3, it & 1); continue; }
        if (it >= 576 && it < 832) { const int idx = it - 576; hgrn_item(a, lds, l, 8 + (idx >> 3), (idx >> 1) & 3, idx & 1); continue; }
#endif
        int idx, kind;
        if (it < 576) { idx = it - 64; kind = 0; } else if (it < 1344) { idx = it - 832; kind = 1; } else if (it < 1600) { idx = it - 1344; kind = 2; } else { idx = it - 1600; kind = 3; }
        const bool lat = kind < 2, isw = kind & 1;
        int b, g, qb;
        if (lat) { b = idx >> 6; g = (idx >> 5) & 1; qb = idx & 31; } else { b = idx >> 3; g = (idx >> 2) & 1; qb = idx & 3; }
        const int r = w & 3, tq = 64 * qb + 32 * (w >> 2) + c;
        const int row = (lat ? TC + b * 2048 : b * 256) + tq;
        const bf16_t* qp = PROJ + (size_t)row * INW + (isw ? C_WQ : C_AQ) + (4 * g + r) * 64;
        bf16_t* op = (bf16_t*)(a.ws + (isw ? WS_OWIN : WS_OATT)) + (size_t)row * 512 + (4 * g + r) * 64;
        const bf16_t* Kb; const bf16_t* VTb; int nk;
        if (lat) { nk = 2304; Kb = (const bf16_t*)(a.ws + (isw ? WS_KWL : WS_KAL)) + (size_t)(b * 2 + g) * 2304 * 64; VTb = (const bf16_t*)(a.ws + (isw ? WS_VWL : WS_VAL)) + (size_t)(b * 2 + g) * 64 * 2304; }
        else { nk = 256; Kb = (const bf16_t*)(a.ws + (isw ? WS_KWC : WS_KAC)) + (size_t)(b * 2 + g) * 256 * 64; VTb = (const bf16_t*)(a.ws + (isw ? WS_VWC : WS_VAC)) + (size_t)(b * 2 + g) * 64 * 256; }
        int nA = 4, lo = 0, hi = 0; bool win = false;
        if (kind == 0) nA = 36;
        if (kind == 1) { lo = qb - 2 < 0 ? 0 : qb - 2; hi = qb + 3 > 32 ? 32 : qb + 3; win = true; }
        const float sink2 = isw ? a.in[18][l * 8 + 4 * g + r] * LOG2E : 0.f;
#ifndef NO_ATT
        attn_item(lds, qp, op, Kb, VTb, nk, nA, lo, hi, win, tq, isw, sink2, !isw);
#endif
    }
}

DI void phase_hgcomb(const Args& a, int l) {
    const int tid = otid(), lane = tid & 63, w = tid >> 6;
    const int gw = obid() * 8 + w, NGW = gridDim.x * 8;
    const float* OF = (const float*)(a.ws + WS_OF); const bf16_t* PROJ = (const bf16_t*)(a.ws + WS_PROJ); bf16_t* OHG = (bf16_t*)(a.ws + WS_OHG);
    const f32x2 gn = *(const f32x2*)(a.in[17] + l * 128 + 2 * lane);
    for (int it = gw; it < T * 4; it += NGW) {
        const int row = it >> 2, hd = it & 3;
        const f32x2 x0 = *(const f32x2*)(OF + (size_t)row * 512 + 128 * hd + 2 * lane), x1 = *(const f32x2*)(OF + ((size_t)T + row) * 512 + 128 * hd + 2 * lane);
        const float s0 = x0[0] + x1[0], s1 = x0[1] + x1[1];
        const float rstd = rsqrtf(wave_sum(s0 * s0 + s1 * s1) * (1.f / 128.f) + EPS);
        const unsigned gb = *(const unsigned*)(PROJ + (size_t)row * INW + C_HG + 128 * hd + 2 * lane);
        const float g0 = bflo(gb), g1 = bfhi(gb);
        *(unsigned*)(OHG + (size_t)row * 512 + 128 * hd + 2 * lane) = pk2(s0 * rstd * gn[0] * g0 * sigmoidf_(g0), s1 * rstd * gn[1] * g1 * sigmoidf_(g1));
    }
}

template <class Epi> DI void run_gemm(unsigned char* lds, const bf16_t* A, const bf16_t* Bt, int N, int K, const Epi& E) {
    pg8::Gemm g{A, Bt, T, N, K}; pg8::StaticOrder S; S.init(T, N, (int)gridDim.x, obid());
#if STAGGER
    {
        const unsigned long long t0 = __builtin_amdgcn_s_memrealtime();
        const unsigned long long dly = (unsigned long long)((obid() >> 3) & 7) * (unsigned long long)(STAGGER * (K / 64));
        while (__builtin_amdgcn_s_memrealtime() - t0 < dly) __builtin_amdgcn_s_sleep(4);
    }
#endif
    pg8::gemm_phase<Epi, pg8::StaticOrder, false>((PG8_LAS unsigned char*)lds, g, S, E, nullptr);
}

__global__ void __launch_bounds__(512, 2) mk_fwd(Args a) {
    extern __shared__ __attribute__((aligned(16))) unsigned char lds[];
    cg::grid_group grid = cg::this_grid();
    {   volatile LAS unsigned* st = (volatile LAS unsigned*)((LAS unsigned char*)lds + LDS_MISC + 16);
        if (threadIdx.x < 2) st[threadIdx.x] = 0u;
        __syncthreads(); }
    const XcdBarrier bar = xcd_barrier_post((unsigned*)(a.ws + WS_BAR), (volatile LAS unsigned*)((LAS unsigned char*)lds + LDS_MISC + 16));
    bf16_t* HB = (bf16_t*)(a.ws + WS_HB); bf16_t* PROJ = (bf16_t*)(a.ws + WS_PROJ); bf16_t* ACT = PROJ;
    float* M32 = (float*)(a.ws + WS_OF);
    for (int ph = a.ph_lo; ph < a.ph_hi; ++ph) {
        if (ph > a.ph_lo) { if (ph == a.ph_lo + 1) grid.sync(); else xcd_barrier(bar);
#if PROBE_MASK & 8
            xcd_barrier(bar); xcd_barrier(bar);
#endif
        }
#ifndef NO_P0
        if (ph == 0) { phase_p0(a, lds); __syncthreads(); phase_wconv(a, lds, 0, 0, 13312, obid(), (int)gridDim.x); continue; }
#endif
#ifndef NO_C0
        if (ph == NPH - 1) { phase_final(a); continue; }
#endif
        const int l = (ph - 1) / 13, k = (ph - 1) % 13;
        int reps = 1;
        if ((PROBE_MASK & 1) && (k == 0 || k == 3 || k == 10 || k == 7)) reps = 2;
        if ((PROBE_MASK & 2) && (k == 1 || k == 11 || k == 4 || k == 8)) reps = 2;
        if ((PROBE_MASK & (4 | 16 | 32)) && k == 6) reps = 2;
        if ((PROBE_MASK & (64 | 128)) && (k == 1 || k == 11)) reps = 2;
        if ((PROBE_MASK & 256) && k == 4) reps = 2;
        if ((PROBE_MASK & 2048) && k == 5) reps = 2;
        if ((PROBE_MASK & 512) && k == 8) reps = 2;
        if ((PROBE_MASK & 1024) && (k == 2 || k == 9 || k == 12)) reps = 2;
        for (int rep = 0; rep < reps; ++rep) {
        if (rep) xcd_barrier(bar);
        const float* MODL = (const float*)(a.ws + WS_MOD) + (size_t)l * 9 * NMODW;
        const unsigned char* wb = a.ws + WS_W;
        const bf16_t* WFI = (const bf16_t*)(wb + W_FI); const bf16_t* WFO = (const bf16_t*)(wb + W_FO);
        if (k == 100) {}
#ifndef NO_C0
        else if (k == 0) { if (l > 0) phase_wconv(a, lds, l, 0, 13312, obid(), (int)gridDim.x); phase_norm(a, l, 0, l == 0); }
        else if (k == 3 || k == 10) { phase_norm(a, l, k == 3 ? 1 : 2, false); }
#endif
#ifndef NO_G_SW
        else if (k == 1 || k == 11) { run_gemm(lds, HB, k == 1 ? WFI : WFI + (size_t)5632 * 1024, 2 * DFF, ((PROBE_MASK & 128) && rep == 0) ? 512 : DM, pg8::EpiSwiglu{ACT}); }
#endif
#ifndef NO_G_RES
        else if (k == 2 || k == 9 || k == 12) {
            const bf16_t* A = k == 9 ? HB : ACT; const bf16_t* Bt = k == 9 ? (const bf16_t*)(wb + W_OUT) : (k == 2 ? WFO : WFO + (size_t)1024 * DFF);
            const int K = k == 9 ? DM : DFF;
            run_gemm(lds, A, Bt, DM, K, pg8::EpiResid{a.in[0], a.in[1], a.ws, a.out, l, k});
        }
#endif
#ifndef NO_G_BF
        else if (k == 4) { run_gemm(lds, HB, (const bf16_t*)(wb + W_IN), INW, DM, pg8::EpiBf16P{PROJ, INW}); }
#endif
#ifndef NO_PREP
        else if (k == 5) { phase_prep(a, l, (PROBE_MASK & 2048) && rep == 0); }
#endif
#ifndef NO_MIX
        else if (k == 6) { phase_mixer(a, lds, l, rep); }
#endif
#ifndef NO_C0
        else if (k == 7) { phase_hgcomb(a, l); }
#endif
#ifndef NO_G_BR
        else if (k == 8) {
            const bf16_t* WBR = (const bf16_t*)(wb + W_BR);
            for (int kk = 0; kk < 3; ++kk) {
                const bf16_t* A = (const bf16_t*)(a.ws + (kk == 0 ? WS_OATT : (kk == 1 ? WS_OHG : WS_OWIN)));
                run_gemm(lds, A, WBR + (size_t)kk * 1024 * 512, DM, 512, pg8::EpiBranch{PROJ + C_GA + 1024 * kk, M32, HB, kk});
            }
        }
#endif
        }
    }
}

#ifndef MK_PER_PHASE
#define MK_PER_PHASE 0
#endif
extern "C" void kernel_launch(void* const* d_in, const int* in_sizes, int n_in, void* d_out, int out_size, void* d_ws, size_t ws_size, hipStream_t stream) {
    static int grid = 0;
    if (!grid) {
        if (n_in != 22 || ws_size < WS_END) { fprintf(stderr, "kernel_launch: unexpected n_in %d or ws_size %zu < %zu\n", n_in, ws_size, (size_t)WS_END); grid = -1; return; }
        int dev = 0, cus = 0, per_cu = 0;
        (void)hipGetDevice(&dev); (void)hipDeviceGetAttribute(&cus, hipDeviceAttributeMultiprocessorCount, dev);
        if (hipFuncSetAttribute((const void*)mk_fwd, hipFuncAttributeMaxDynamicSharedMemorySize, LDS_BYTES) != hipSuccess) { fprintf(stderr, "kernel_launch: hipFuncSetAttribute failed\n"); grid = -1; return; }
        (void)hipOccupancyMaxActiveBlocksPerMultiprocessor(&per_cu, mk_fwd, 512, LDS_BYTES);
        if (per_cu < 1) per_cu = 1;
        grid = cus * per_cu; if (grid > 256) grid = 256;
    }
    if (grid < 0) return;
    (void)hipMemsetAsync((char*)d_ws + WS_CTL, 0, CTL_BYTES, stream);
    Args a{};
    for (int i = 0; i < 22; ++i) a.in[i] = (const float*)d_in[i];
    a.out = (float*)d_out; a.ws = (unsigned char*)d_ws;
#if MK_PER_PHASE
    for (int ph = 0; ph < NPH; ++ph) { a.ph_lo = ph; a.ph_hi = ph + 1; hipLaunchKernelGGL(mk_fwd, dim3(grid), dim3(512), LDS_BYTES, stream, a); }
#else
    a.ph_lo = 0; a.ph_hi = NPH;
    void* args[] = {&a};
    hipError_t e = hipLaunchCooperativeKernel((void*)mk_fwd, dim3(grid), dim3(512), args, LDS_BYTES, stream);
    if (e != hipSuccess) fprintf(stderr, "cooperative launch failed: %s (grid %d)\n", hipGetErrorString(e), grid);
#endif
}
```

```cpp
#include <hip/hip_runtime.h>
#include <hip/hip_cooperative_groups.h>
#include <cstdio>
#include <cstdint>
namespace cg = cooperative_groups;

#ifndef PROBE_MASK
#define PROBE_MASK 0
#endif
#ifndef STAGGER
#define STAGGER 0
#endif
#define DI __device__ __forceinline__
typedef unsigned short bf16_t;
typedef short bf16x8 __attribute__((ext_vector_type(8)));
typedef short s16x4 __attribute__((ext_vector_type(4)));
typedef float f32x2 __attribute__((ext_vector_type(2)));
typedef float f32x4 __attribute__((ext_vector_type(4)));
typedef float f32x16 __attribute__((ext_vector_type(16)));
typedef unsigned u32x2 __attribute__((ext_vector_type(2)));
typedef unsigned u32x4 __attribute__((ext_vector_type(4)));
typedef __bf16 bf16x2n __attribute__((ext_vector_type(2)));

DI int otid() { int t = threadIdx.x; asm volatile("" : "+v"(t)); return t; }
DI int obid() { int b = blockIdx.x; asm volatile("" : "+s"(b)); return b; }
DI unsigned pk2(float lo, float hi) { f32x2 v = {lo, hi}; return __builtin_bit_cast(unsigned, __builtin_convertvector(v, bf16x2n)); }
DI float bflo(unsigned u) { return __uint_as_float(u << 16); }
DI float bfhi(unsigned u) { return __uint_as_float(u & 0xffff0000u); }
DI float bf2f(bf16_t b) { return __uint_as_float(((unsigned)b) << 16); }
DI bf16_t f2bf(float f) { return (bf16_t)(pk2(f, 0.f) & 0xffffu); }
DI float sigmoidf_(float x) { return __builtin_amdgcn_rcpf(1.f + __expf(-x)); }
DI float wave_sum(float v) {
#pragma unroll
    for (int o = 1; o < 64; o <<= 1) v += __shfl_xor(v, o);
    return v;
}
#define MFMA32(a, b, c) __builtin_amdgcn_mfma_f32_32x32x16_bf16((a), (b), (c), 0, 0, 0)
DI bf16x8 pack8(float a0, float a1, float a2, float a3, float a4, float a5, float a6, float a7) {
    u32x4 p; p.x = pk2(a0, a1); p.y = pk2(a2, a3); p.z = pk2(a4, a5); p.w = pk2(a6, a7); return __builtin_bit_cast(bf16x8, p);
}
DI bf16x8 cat44(s16x4 lo, s16x4 hi) { return __builtin_shufflevector(lo, hi, 0, 1, 2, 3, 4, 5, 6, 7); }

constexpr int DM = 1024, DEPTH = 4, TC = 8192, TL = 16384, T = 24576, DFF = 2816, INW = 7168, NMODW = 9216;
constexpr int C_AQ = 0, C_AK = 512, C_AV = 640, C_WQ = 768, C_WK = 1280, C_WV = 1408, C_HQ = 1536, C_HFF = 2048, C_HFB = 2560, C_HI = 3072, C_HG = 3584, C_GA = 4096;
constexpr float EPS = 1e-6f, LOG2E = 1.4426950408889634f;
constexpr size_t O_X = 0, O_NKA = 25165824, O_NVA = 29360128, O_NKW = 33554432, O_NVW = 37748736, O_NST = 41943040;
constexpr size_t al256(size_t x) { return (x + 255) & ~(size_t)255; }
constexpr size_t WS_CTL = 0;
constexpr size_t WS_BAR = 4096;
constexpr size_t CTL_BYTES = 32768;
constexpr size_t WS_MOD = CTL_BYTES;
constexpr size_t WS_LB = WS_MOD + al256((size_t)DEPTH * 9 * NMODW * 4);
constexpr size_t WS_ROPE = WS_LB + 16384;
constexpr size_t WSZ = (size_t)(2 * 5632 * 1024 + 2 * 1024 * 2816 + 7168 * 1024 + 3 * 1024 * 512 + 1024 * 1024) * 2;
constexpr size_t WS_W = WS_ROPE + 8192;
constexpr size_t W_FI = 0;
constexpr size_t W_FO = W_FI + (size_t)2 * 5632 * 1024 * 2;
constexpr size_t W_IN = W_FO + (size_t)2 * 1024 * 2816 * 2;
constexpr size_t W_BR = W_IN + (size_t)7168 * 1024 * 2;
constexpr size_t W_OUT = W_BR + (size_t)3 * 1024 * 512 * 2;
constexpr size_t WS_XB = WS_W + WSZ;
constexpr size_t WS_HB = WS_XB + (size_t)T * 1024 * 2;
constexpr size_t WS_PROJ = WS_HB + (size_t)T * 1024 * 2;
constexpr size_t WS_OATT = WS_PROJ + (size_t)T * INW * 2;
constexpr size_t WS_OHG = WS_OATT + (size_t)T * 512 * 2;
constexpr size_t WS_OWIN = WS_OHG + (size_t)T * 512 * 2;
constexpr size_t WS_OF = WS_OWIN + (size_t)T * 512 * 2;
constexpr size_t WS_KAL = WS_OF + (size_t)2 * T * 512 * 4;
constexpr size_t SZ_KL = (size_t)8 * 2 * 2304 * 64 * 2, SZ_KC = (size_t)32 * 2 * 256 * 64 * 2;
constexpr size_t WS_VAL = WS_KAL + SZ_KL;
constexpr size_t WS_KWL = WS_VAL + SZ_KL;
constexpr size_t WS_VWL = WS_KWL + SZ_KL;
constexpr size_t WS_KAC = WS_VWL + SZ_KL;
constexpr size_t WS_VAC = WS_KAC + SZ_KC;
constexpr size_t WS_KWC = WS_VAC + SZ_KC;
constexpr size_t WS_VWC = WS_KWC + SZ_KC;
constexpr size_t WS_END = WS_VWC + SZ_KC;
constexpr int LDS_BYTES = 160 * 1024, LDS_MISC = 159 * 1024;
constexpr int NPH = 1 + 13 * DEPTH + 1;

struct Args { const float* in[22]; float* out; unsigned char* ws; int ph_lo, ph_hi; };

namespace pg8 {
#define PG8_LAS __attribute__((address_space(3)))
typedef unsigned short bf16_t;
typedef short bf16x8 __attribute__((ext_vector_type(8)));
typedef float f32x4 __attribute__((ext_vector_type(4)));
typedef unsigned u32x4 __attribute__((ext_vector_type(4)));
constexpr int BM = 256, BK = 64, HALF = 128, HTB = HALF * BK * 2  , STAGE_BYTES = 8 * HTB, NXCD = 8, WGM = 8;

__host__ __device__ __forceinline__ int lds_byte(int r, int c) { const int st = (r >> 4) * 2 + (c >> 5), rr = r & 15, cc = c & 31, ob = rr * 64 + cc * 2; return st * 1024 + (ob ^ (((ob >> 9) & 1) << 5)); }
__host__ __device__ __forceinline__ void stage_rc(int b, int& R, int& C) { const int st = b / 1024, sb = b % 1024, swz = sb ^ (((sb >> 9) & 1) << 5); R = (st >> 1) * 16 + swz / 64; C = (st & 1) * 32 + (swz % 64) / 2; }
__host__ __device__ __forceinline__ int perm32(int rho) { const int n = rho >> 4, i = rho & 15; return 8 * (i >> 2) + 4 * n + (i & 3); }

struct Unit { int pm, pn; };
struct Gemm { const bf16_t* A; const bf16_t* Bt; int M, N, K; };

struct StaticOrder {
    int nM, nN, nwg, G, c;
    __host__ __device__ void init(int M, int N, int G_, int c_) { nM = M / BM; nN = N / BM; nwg = nM * nN; G = G_; c = c_; }
    __host__ __device__ bool next(int i, Unit& u) const {
        const long L = (long)i * G + c; if (L >= nwg) return false;
        int wgid = (int)L; { const int q = nwg / NXCD, r = nwg % NXCD, xcd = wgid % NXCD, off = wgid / NXCD; wgid = (xcd < r ? xcd * (q + 1) : r * (q + 1) + (xcd - r) * q) + off; }
        const int nig = WGM * nN, gid = wgid / nig, fm = gid * WGM, gsz = (nM - fm) < WGM ? (nM - fm) : WGM;
        u.pm = fm + ((wgid % nig) % gsz); u.pn = (wgid % nig) / gsz; return true;
    }
    __device__ __forceinline__ void a_ready(const Unit&) const {}
    __device__ __forceinline__ void done(const Unit&) const {}
};
struct EpiBf16P {
    static constexpr bool PERM = true, AFTER_DRAIN = false;
    bf16_t* O; int ldc;
    __device__ __forceinline__ void operator()(const f32x4 (&acc)[2][2][4][2], const Unit& u, int wr, int wc, int fr, int fq) const {
        const int row0 = u.pm * BM + wr * 64 + fr, col0 = u.pn * BM + wc * 32 + 8 * fq;
#pragma unroll
        for (int ai = 0; ai < 2; ++ai)
#pragma unroll
            for (int m = 0; m < 4; ++m) { bf16_t* rowp = O + (size_t)(row0 + ai * HALF + m * 16) * ldc + col0;
#pragma unroll
                for (int bj = 0; bj < 2; ++bj) { const f32x4 v0 = acc[ai][bj][m][0], v1 = acc[ai][bj][m][1];
                    u32x4 w; w.x = pk2(v0[0], v0[1]); w.y = pk2(v0[2], v0[3]); w.z = pk2(v1[0], v1[1]); w.w = pk2(v1[2], v1[3]);
                    *(u32x4*)(rowp + bj * HALF) = w; } }
    }
};
struct EpiSwiglu {
    static constexpr bool PERM = true, AFTER_DRAIN = false;
    bf16_t* O;
    __device__ __forceinline__ void operator()(const f32x4 (&acc)[2][2][4][2], const Unit& u, int wr, int wc, int fr, int fq) const {
        const int row0 = u.pm * BM + wr * 64 + fr, col0 = u.pn * HALF + wc * 32 + 8 * fq;
#pragma unroll
        for (int ai = 0; ai < 2; ++ai)
#pragma unroll
            for (int m = 0; m < 4; ++m) { bf16_t* rowp = O + (size_t)(row0 + ai * HALF + m * 16) * DFF + col0;
                float r[8];
#pragma unroll
                for (int n = 0; n < 2; ++n)
#pragma unroll
                    for (int j = 0; j < 4; ++j) { const float g = acc[ai][0][m][n][j], up = acc[ai][1][m][n][j]; r[4 * n + j] = g * __builtin_amdgcn_rcpf(1.f + __expf(-g)) * up; }
                u32x4 w; w.x = pk2(r[0], r[1]); w.y = pk2(r[2], r[3]); w.z = pk2(r[4], r[5]); w.w = pk2(r[6], r[7]);
                *(u32x4*)rowp = w; }
    }
};
struct EpiResid {
    static constexpr bool PERM = true, AFTER_DRAIN = false;
    const float* in0; const float* in1; unsigned char* ws; float* out; int l_; int k_;
    __device__ __forceinline__ void operator()(const f32x4 (&acc)[2][2][4][2], const Unit& u, int wr, int wc, int fr, int fq) const {
        int l = __builtin_amdgcn_readfirstlane(l_), k = __builtin_amdgcn_readfirstlane(k_); asm volatile("" : "+s"(l), "+s"(k));
        const int mode = (k == 2 && l == 0) ? 1 : ((k == 12 && l == DEPTH - 1) ? 2 : 0);
        const float coef = k == 9 ? 1.0f : 0.5f; const float* mod = (const float*)(ws + WS_MOD) + (size_t)l * 9 * NMODW + (k == 2 ? 2 : (k == 9 ? 5 : 8)) * DM;
        bf16_t* xb = (bf16_t*)(ws + WS_XB);
        const int row0 = u.pm * BM + wr * 64 + fr, col0 = u.pn * BM + wc * 32 + 8 * fq;
        const int trow = u.pm * BM; const int cond = trow < TC ? 8 : ((trow - TC) >> 11);
        const float* mp = mod + (size_t)cond * NMODW;
        f32x4 g[2][2];
#pragma unroll
        for (int bj = 0; bj < 2; ++bj)
#pragma unroll
            for (int n = 0; n < 2; ++n) g[bj][n] = coef * *(const f32x4*)(mp + col0 + bj * HALF + 4 * n);
        if (mode == 1) {
            const float* bbase = trow < TC ? in0 + (size_t)row0 * DM : in1 + (size_t)(row0 - TC) * DM;
#pragma unroll
            for (int ai = 0; ai < 2; ++ai) {
                f32x4 bv[4][2][2];
#pragma unroll
                for (int m = 0; m < 4; ++m)
#pragma unroll
                    for (int bj = 0; bj < 2; ++bj)
#pragma unroll
                        for (int n = 0; n < 2; ++n) bv[m][bj][n] = *(const f32x4*)(bbase + (size_t)(ai * HALF + m * 16) * DM + col0 + bj * HALF + 4 * n);
#pragma unroll
                for (int m = 0; m < 4; ++m) { const size_t ro = (size_t)(row0 + ai * HALF + m * 16) * DM + col0;
#pragma unroll
                    for (int bj = 0; bj < 2; ++bj) {
                        const f32x4 x0 = bv[m][bj][0] + g[bj][0] * acc[ai][bj][m][0], x1 = bv[m][bj][1] + g[bj][1] * acc[ai][bj][m][1];
                        u32x4 w; w.x = pk2(x0[0], x0[1]); w.y = pk2(x0[2], x0[3]); w.z = pk2(x1[0], x1[1]); w.w = pk2(x1[2], x1[3]); *(u32x4*)(xb + ro + bj * HALF) = w; } }
            }
        } else {
#pragma unroll
            for (int ai = 0; ai < 2; ++ai) {
                u32x4 raw[4][2];
#pragma unroll
                for (int m = 0; m < 4; ++m)
#pragma unroll
                    for (int bj = 0; bj < 2; ++bj) raw[m][bj] = *(const u32x4*)(xb + (size_t)(row0 + ai * HALF + m * 16) * DM + col0 + bj * HALF);
#pragma unroll
                for (int m = 0; m < 4; ++m) { const size_t ro = (size_t)(row0 + ai * HALF + m * 16) * DM + col0;
#pragma unroll
                    for (int bj = 0; bj < 2; ++bj) { const u32x4 r = raw[m][bj];
                        const f32x4 x0 = (f32x4){bflo(r.x), bfhi(r.x), bflo(r.y), bfhi(r.y)} + g[bj][0] * acc[ai][bj][m][0], x1 = (f32x4){bflo(r.z), bfhi(r.z), bflo(r.w), bfhi(r.w)} + g[bj][1] * acc[ai][bj][m][1];
                        if (mode == 2) { *(f32x4*)(out + ro + bj * HALF) = x0; *(f32x4*)(out + ro + bj * HALF + 4) = x1; }
                        else { u32x4 w; w.x = pk2(x0[0], x0[1]); w.y = pk2(x0[2], x0[3]); w.z = pk2(x1[0], x1[1]); w.w = pk2(x1[2], x1[3]); *(u32x4*)(xb + ro + bj * HALF) = w; } } }
            }
        }
    }
};
struct EpiBranch {
    static constexpr bool PERM = true, AFTER_DRAIN = false;
    const bf16_t* gate; float* acc32; bf16_t* outbf; int mode;
    __device__ __forceinline__ void operator()(const f32x4 (&acc)[2][2][4][2], const Unit& u, int wr, int wc, int fr, int fq) const {
        const int row0 = u.pm * BM + wr * 64 + fr, col0 = u.pn * BM + wc * 32 + 8 * fq;
#pragma unroll
        for (int ai = 0; ai < 2; ++ai) {
            u32x4 gv[4][2], pv[4][2];
#pragma unroll
            for (int m = 0; m < 4; ++m)
#pragma unroll
                for (int bj = 0; bj < 2; ++bj) { const int row = row0 + ai * HALF + m * 16, c = col0 + bj * HALF;
                    gv[m][bj] = *(const u32x4*)(gate + (size_t)row * INW + c);
                    if (mode != 0) pv[m][bj] = *(const u32x4*)(outbf + (size_t)row * DM + c); else pv[m][bj] = (u32x4){0u, 0u, 0u, 0u}; }
#pragma unroll
            for (int m = 0; m < 4; ++m)
#pragma unroll
                for (int bj = 0; bj < 2; ++bj) { const int row = row0 + ai * HALF + m * 16, c = col0 + bj * HALF;
                    const u32x4 g = gv[m][bj], p = pv[m][bj];
                    float v[8];
                    v[0] = sigmoidf_(bflo(g.x)) * acc[ai][bj][m][0][0] + bflo(p.x); v[1] = sigmoidf_(bfhi(g.x)) * acc[ai][bj][m][0][1] + bfhi(p.x);
                    v[2] = sigmoidf_(bflo(g.y)) * acc[ai][bj][m][0][2] + bflo(p.y); v[3] = sigmoidf_(bfhi(g.y)) * acc[ai][bj][m][0][3] + bfhi(p.y);
                    v[4] = sigmoidf_(bflo(g.z)) * acc[ai][bj][m][1][0] + bflo(p.z); v[5] = sigmoidf_(bfhi(g.z)) * acc[ai][bj][m][1][1] + bfhi(p.z);
                    v[6] = sigmoidf_(bflo(g.w)) * acc[ai][bj][m][1][2] + bflo(p.w); v[7] = sigmoidf_(bfhi(g.w)) * acc[ai][bj][m][1][3] + bfhi(p.w);
                    u32x4 w; w.x = pk2(v[0], v[1]); w.y = pk2(v[2], v[3]); w.z = pk2(v[4], v[5]); w.w = pk2(v[6], v[7]);
                    *(u32x4*)(outbf + (size_t)row * DM + c) = w; }
        }
    }
};

template <class Epi, class Sched, bool STAMP = false>
__device__ __forceinline__ void gemm_phase(PG8_LAS unsigned char* lds, const Gemm g, const Sched& S, const Epi& E, unsigned long long* stamps) {
    const int tid = otid(), wid = __builtin_amdgcn_readfirstlane(tid >> 6), lane = tid & 63, wr = wid >> 2, wc = wid & 3, fr = lane & 15, fq = lane >> 4;
    const int K = g.K, nt = K / BK;
    int ts_lo = 0, ts_hi = 0, nts = 0; const unsigned long long rt_entry = STAMP ? (unsigned long long)wall_clock64() : 0ull;
#define PG8_STAMP() do { if (STAMP && wid == 0 && nts < 64) { const unsigned long long _c = (unsigned long long)clock64(); \
        ts_lo = (lane == nts) ? (int)(unsigned)_c : ts_lo; ts_hi = (lane == nts) ? (int)(unsigned)(_c >> 32) : ts_hi; ++nts; } } while (0)
    PG8_STAMP();
    unsigned voffA[2], voffB[2];
#pragma unroll
    for (int i = 0; i < 2; ++i) { int R, C; stage_rc(tid * 16 + i * 8192, R, C); const int Rb = Epi::PERM ? ((R & ~31) + perm32(R & 31)) : R;
        voffA[i] = (unsigned)(R * K + C) * 2u; voffB[i] = (unsigned)(Rb * K + C) * 2u; }
    const size_t kstep = (size_t)(BK * 2);
    const size_t hstep = (size_t)HALF * K * 2;
    const size_t tstep = 2 * hstep;
    const unsigned ldsw = (unsigned)wid * 1024u;
    const int aoff = lds_byte(wr * 64 + fr, fq * 8), boff = lds_byte(wc * 32 + fr, fq * 8);
#define PG8_SA(b, h) (((b) * 2 + (h)) * HTB)
#define PG8_SB(b, h) ((4 + (b) * 2 + (h)) * HTB)
#define PG8_STAGE(bufoff, gbase, voff) do { _Pragma("unroll") for (int _i = 0; _i < 2; ++_i) \
        __builtin_amdgcn_global_load_lds((const unsigned*)((const char*)(gbase) + (voff)[_i]), (PG8_LAS unsigned*)(lds + (bufoff) + ldsw + _i * 8192), 16, 0, 0); } while (0)
#define PG8_LDA(dst, b, h) do { _Pragma("unroll") for (int m = 0; m < 4; ++m) _Pragma("unroll") for (int k = 0; k < 2; ++k) dst[m][k] = *(const PG8_LAS bf16x8*)(lds + PG8_SA(b, h) + aoff + m * 2048 + k * 1024); } while (0)
#define PG8_LDB(dst, b, h) do { _Pragma("unroll") for (int n = 0; n < 2; ++n) _Pragma("unroll") for (int k = 0; k < 2; ++k) dst[n][k] = *(const PG8_LAS bf16x8*)(lds + PG8_SB(b, h) + boff + n * 2048 + k * 1024); } while (0)
#define PG8_MMA(ai, bj, At, Bt) do { __builtin_amdgcn_s_setprio(1); _Pragma("unroll") for (int m = 0; m < 4; ++m) _Pragma("unroll") for (int n = 0; n < 2; ++n) _Pragma("unroll") for (int k = 0; k < 2; ++k) \
        acc[ai][bj][m][n] = __builtin_amdgcn_mfma_f32_16x16x32_bf16(Bt[n][k], At[m][k], acc[ai][bj][m][n], 0, 0, 0); __builtin_amdgcn_s_setprio(0); } while (0)
#define PG8_WAIT_V(n) asm volatile("s_waitcnt vmcnt(" #n ")" ::: "memory")
#define PG8_WAIT_L(n) asm volatile("s_waitcnt lgkmcnt(" #n ")" ::: "memory")
#define PG8_BAR __builtin_amdgcn_s_barrier()
#define PG8_SCHED __builtin_amdgcn_sched_barrier(0)
    Unit cur, nxt; int ui = 0;
    if (!S.next(0, cur)) return;
    f32x4 acc[2][2][4][2];
#pragma unroll
    for (int a = 0; a < 2; ++a)
#pragma unroll
        for (int b = 0; b < 2; ++b)
#pragma unroll
            for (int m = 0; m < 4; ++m)
#pragma unroll
                for (int n = 0; n < 2; ++n) acc[a][b][m][n] = (f32x4){0.f, 0.f, 0.f, 0.f};
    bf16x8 At[4][2], B0[2][2], B1[2][2];
    const char* cA = (const char*)g.A + (size_t)cur.pm * tstep; const char* cB = (const char*)g.Bt + (size_t)cur.pn * tstep;
    S.a_ready(cur);
    PG8_STAGE(PG8_SB(0, 0), cB, voffB); PG8_STAGE(PG8_SA(0, 0), cA, voffA); PG8_STAGE(PG8_SB(0, 1), cB + hstep, voffB); PG8_STAGE(PG8_SA(0, 1), cA + hstep, voffA);
    if (wr == 1) PG8_BAR;
    PG8_WAIT_V(4); PG8_BAR;
    PG8_STAGE(PG8_SB(1, 0), cB + kstep, voffB); PG8_STAGE(PG8_SA(1, 0), cA + kstep, voffA); PG8_STAGE(PG8_SB(1, 1), cB + hstep + kstep, voffB);
    PG8_WAIT_V(6); PG8_BAR;
    PG8_STAMP();
    for (;;) {
        const bool has_next = S.next(ui + 1, nxt);
        const char* nA = has_next ? (const char*)g.A + (size_t)nxt.pm * tstep : cA; const char* nB = has_next ? (const char*)g.Bt + (size_t)nxt.pn * tstep : cB;
        for (int t = 0; t < nt; t += 2) {
            const bool last = (t == nt - 2);
            const char* a1 = cA + (size_t)(t + 1) * kstep;
            const char* a2 = last ? nA : cA + (size_t)(t + 2) * kstep; const char* b2 = last ? nB : cB + (size_t)(t + 2) * kstep;
            const char* a3 = a2 + kstep; const char* b3 = b2 + kstep;
            if (last && has_next) S.a_ready(nxt);
            PG8_LDB(B0, 0, 0); PG8_SCHED; PG8_LDA(At, 0, 0); PG8_STAGE(PG8_SA(1, 1), a1 + hstep, voffA);
            PG8_WAIT_L(8); PG8_BAR; PG8_WAIT_L(0); PG8_MMA(0, 0, At, B0); PG8_BAR; PG8_SCHED;
            PG8_LDB(B1, 0, 1); PG8_STAGE(PG8_SB(0, 0), b2, voffB);
            PG8_BAR; PG8_WAIT_L(0); PG8_MMA(0, 1, At, B1); PG8_BAR;
            PG8_LDA(At, 0, 1); PG8_STAGE(PG8_SA(0, 0), a2, voffA);
            PG8_BAR; PG8_WAIT_L(0); PG8_MMA(1, 0, At, B0); PG8_BAR; PG8_SCHED;
            PG8_STAGE(PG8_SB(0, 1), b2 + hstep, voffB);
            PG8_WAIT_V(6); PG8_BAR; PG8_MMA(1, 1, At, B1); PG8_BAR;
            PG8_LDB(B0, 1, 0); PG8_SCHED; PG8_LDA(At, 1, 0); PG8_STAGE(PG8_SA(0, 1), a2 + hstep, voffA);
            PG8_WAIT_L(8); PG8_BAR; PG8_WAIT_L(0); PG8_MMA(0, 0, At, B0); PG8_BAR; PG8_SCHED;
            PG8_LDB(B1, 1, 1); PG8_STAGE(PG8_SB(1, 0), b3, voffB);
            PG8_BAR; PG8_WAIT_L(0); PG8_MMA(0, 1, At, B1); PG8_BAR;
            PG8_LDA(At, 1, 1); PG8_STAGE(PG8_SA(1, 0), a3, voffA);
            PG8_BAR; PG8_WAIT_L(0); PG8_MMA(1, 0, At, B0); PG8_BAR; PG8_SCHED;
            PG8_STAGE(PG8_SB(1, 1), b3 + hstep, voffB);
            PG8_WAIT_V(6); PG8_BAR; PG8_MMA(1, 1, At, B1); PG8_BAR;
        }
        PG8_STAMP();
        if constexpr (!Epi::AFTER_DRAIN) { E(acc, cur, wr, wc, fr, fq); S.done(cur); }
        PG8_STAMP();
        if (!has_next) break;
#pragma unroll
        for (int a = 0; a < 2; ++a)
#pragma unroll
            for (int b = 0; b < 2; ++b)
#pragma unroll
                for (int m = 0; m < 4; ++m)
#pragma unroll
                    for (int n = 0; n < 2; ++n) acc[a][b][m][n] = (f32x4){0.f, 0.f, 0.f, 0.f};
        cur = nxt; cA = nA; cB = nB; ++ui;
    }
    PG8_WAIT_V(0);
    if (wr == 0) PG8_BAR;
    PG8_BAR;
    if constexpr (Epi::AFTER_DRAIN) { E.fused(acc, cur, wr, wc, fr, fq, lds, wid, lane); S.done(cur); }
    PG8_STAMP();
    if (STAMP && wid == 0) { stamps[lane] = lane < nts ? (((unsigned long long)(unsigned)ts_hi << 32) | (unsigned)ts_lo) : 0ull;
        if (lane == 62) stamps[62] = rt_entry; if (lane == 63) stamps[63] = (unsigned long long)wall_clock64(); }
#undef PG8_STAMP
#undef PG8_SA
#undef PG8_SB
#undef PG8_STAGE
#undef PG8_LDA
#undef PG8_LDB
#undef PG8_MMA
#undef PG8_WAIT_V
#undef PG8_WAIT_L
#undef PG8_BAR
#undef PG8_SCHED
}
}
DI int crow(int i, int h) { return (i & 3) + 8 * (i >> 2) + 4 * h; }
#define LDS_WAIT() asm volatile("s_waitcnt lgkmcnt(0)" ::: "memory")


DI void phase_p0(const Args& a, unsigned char* lds) {
    float* s = (float*)lds; float* red = (float*)(lds + 36864);
    const int tid = otid(), lane = tid & 63, w = tid >> 6;
    float* MOD = (float*)(a.ws + WS_MOD);
    if ((int)blockIdx.x < 144) {
        const float* c = a.in[7]; const float* cctx = a.in[8];
        for (int i = tid; i < 9 * 1024; i += 512) { const int ci = i >> 10, k = i & 1023; const float v = ci < 8 ? c[ci * 1024 + k] : cctx[k]; s[i] = v * sigmoidf_(v); }
        __syncthreads();
        for (int item = blockIdx.x; item < 144; item += gridDim.x) {
            const int l = item / 36, cc = item % 36;
            const float* W = a.in[9] + (size_t)l * 1024 * NMODW + cc * 256 + 4 * lane;
            f32x4 acc[9];
#pragma unroll
            for (int ci = 0; ci < 9; ++ci) acc[ci] = (f32x4){0.f, 0.f, 0.f, 0.f};
#pragma unroll 2
            for (int k4 = 0; k4 < 32; ++k4) {
                const int k = w * 128 + k4 * 4;
                const f32x4 w0 = *(const f32x4*)(W + (size_t)(k + 0) * NMODW), w1 = *(const f32x4*)(W + (size_t)(k + 1) * NMODW),
                            w2 = *(const f32x4*)(W + (size_t)(k + 2) * NMODW), w3 = *(const f32x4*)(W + (size_t)(k + 3) * NMODW);
#pragma unroll
                for (int ci = 0; ci < 9; ++ci) { const f32x4 sv = *(const f32x4*)(s + ci * 1024 + k); acc[ci] += sv[0] * w0 + sv[1] * w1 + sv[2] * w2 + sv[3] * w3; }
            }
#pragma unroll
            for (int ci = 0; ci < 9; ++ci) *(f32x4*)(red + ((w * 9 + ci) * 256 + 4 * lane)) = acc[ci];
            __syncthreads();
            for (int i = tid; i < 9 * 256; i += 512) { const int ci = i >> 8, col = i & 255; float v = 0.f;
#pragma unroll
                for (int ww = 0; ww < 8; ++ww) v += red[(ww * 9 + ci) * 256 + col];
                v += a.in[10][l * NMODW + cc * 256 + col];
                MOD[((size_t)l * 9 + ci) * NMODW + cc * 256 + col] = v; }
            __syncthreads();
        }
    }
    if (blockIdx.x == gridDim.x - 1) {
        float* LB = (float*)(a.ws + WS_LB); const float* lbin = a.in[16];
        for (int e = tid; e < 1024; e += 512) {
            const float x0 = lbin[e], x1 = lbin[1024 + e], x2 = lbin[2048 + e], x3 = lbin[3072 + e];
            const float mx = fmaxf(fmaxf(x0, x1), fmaxf(x2, x3));
            const float e0 = __expf(x0 - mx), e1 = __expf(x1 - mx), e2 = __expf(x2 - mx), e3 = __expf(x3 - mx); const float inv = 1.f / (e0 + e1 + e2 + e3);
            LB[e] = 0.f; LB[1024 + e] = e1 * inv; LB[2048 + e] = (e1 + e2) * inv; LB[3072 + e] = (e1 + e2 + e3) * inv;
        }
        float* cosT = (float*)(a.ws + WS_ROPE); float* sinT = cosT + 1024;
        for (int e = tid; e < 1024; e += 512) { const int pos = e >> 4, i = e & 15; const float inv = exp2f(-(float)i * (13.287712379549449f / 16.f)); const float ang = (float)pos * inv;
            cosT[e] = cosf(ang); sinT[e] = sinf(ang); }
    }
}

DI void transpose_item(const float* W, int ldw, int srccol0, int k0, bf16_t* WT, int K, int dstrow0, float* scr, int lane) {
#pragma unroll 8
    for (int i = 0; i < 32; ++i) { const int kk = 2 * i + (lane >> 5); scr[kk * 33 + (lane & 31)] = W[(size_t)(k0 + kk) * ldw + srccol0 + (lane & 31)]; }
    LDS_WAIT();
    const int c = lane & 7;
#pragma unroll
    for (int j = 0; j < 4; ++j) { const int n = (lane >> 3) + 8 * j; const float* sp = scr + (8 * c) * 33 + n;
        u32x4 o; o.x = pk2(sp[0 * 33], sp[1 * 33]); o.y = pk2(sp[2 * 33], sp[3 * 33]); o.z = pk2(sp[4 * 33], sp[5 * 33]); o.w = pk2(sp[6 * 33], sp[7 * 33]);
        *(u32x4*)(WT + (size_t)(dstrow0 + n) * K + k0 + 8 * c) = o; }
    LDS_WAIT();
}
DI void phase_wconv(const Args& a, unsigned char* lds, int l, int it0, int it1, int rank, int nrank) {
    const int tid = otid(), lane = tid & 63, w = tid >> 6;
    float* scr = (float*)(lds + w * 8448);
    unsigned char* wb = a.ws + WS_W;
    for (int it = it0 + rank * 8 + w; it < it1; it += nrank * 8) {
        int r = it;
        if (r < 5632) { const int j = r / 2816; r -= j * 2816; const int kb = r / 176, nb = r % 176, n0 = 32 * nb, pn = n0 >> 8, loc = n0 & 255;
            const int src = (loc >> 7) * DFF + 128 * pn + (loc & 127);
            transpose_item(a.in[12] + (size_t)(l * 2 + j) * 1024 * 5632, 5632, src, 64 * kb, (bf16_t*)(wb + W_FI) + (size_t)j * 5632 * 1024, 1024, n0, scr, lane); continue; }
        r -= 5632;
        if (r < 2816) { const int j = r / 1408; r -= j * 1408; const int kb = r / 32, nb = r % 32;
            transpose_item(a.in[13] + (size_t)(l * 2 + j) * DFF * 1024, 1024, 32 * nb, 64 * kb, (bf16_t*)(wb + W_FO) + (size_t)j * 1024 * DFF, DFF, 32 * nb, scr, lane); continue; }
        r -= 2816;
        if (r < 3584) { const int kb = r / 224, nb = r % 224;
            transpose_item(a.in[14] + (size_t)l * 1024 * INW, INW, 32 * nb, 64 * kb, (bf16_t*)(wb + W_IN), 1024, 32 * nb, scr, lane); continue; }
        r -= 3584;
        if (r < 768) { const int k = r / 256; r -= k * 256; const int kb = r / 32, nb = r % 32;
            transpose_item(a.in[19] + (size_t)(l * 3 + k) * 512 * 1024, 1024, 32 * nb, 64 * kb, (bf16_t*)(wb + W_BR) + (size_t)k * 1024 * 512, 512, 32 * nb, scr, lane); continue; }
        r -= 768;
        { const int kb = r / 32, nb = r % 32;
            transpose_item(a.in[20] + (size_t)l * 1024 * 1024, 1024, 32 * nb, 64 * kb, (bf16_t*)(wb + W_OUT), 1024, 32 * nb, scr, lane); }
    }
}

DI void phase_norm(const Args& a, int l, int j, bool first) {
    const int tid = otid(), lane = tid & 63, w = tid >> 6;
    const int gw = obid() * 8 + w, NGW = gridDim.x * 8;
    const float* g = a.in[11] + (size_t)(l * 3 + j) * DM; const float* MOD = (const float*)(a.ws + WS_MOD) + (size_t)l * 9 * NMODW;
    bf16_t* HB = (bf16_t*)(a.ws + WS_HB);
    if (first) {
        f32x4 gg[4];
#pragma unroll
        for (int jj = 0; jj < 4; ++jj) gg[jj] = *(const f32x4*)(g + 4 * lane + 256 * jj);
        for (int row = gw; row < T; row += NGW) {
            const float* xr = row < TC ? a.in[0] + (size_t)row * DM : a.in[1] + (size_t)(row - TC) * DM;
            const int cond = row < TC ? 8 : ((row - TC) >> 11);
            const float* shift = MOD + (size_t)cond * NMODW + 3 * j * DM; const float* scale = shift + DM;
            f32x4 v[4]; float ss = 0.f;
#pragma unroll
            for (int jj = 0; jj < 4; ++jj) { v[jj] = *(const f32x4*)(xr + 4 * lane + 256 * jj); ss += (v[jj][0] * v[jj][0] + v[jj][1] * v[jj][1]) + (v[jj][2] * v[jj][2] + v[jj][3] * v[jj][3]); }
            const float rstd = rsqrtf(wave_sum(ss) * (1.f / DM) + EPS);
#pragma unroll
            for (int jj = 0; jj < 4; ++jj) { const f32x4 sc = *(const f32x4*)(scale + 4 * lane + 256 * jj), sh = *(const f32x4*)(shift + 4 * lane + 256 * jj);
                const f32x4 y = v[jj] * rstd * gg[jj] * (1.f + sc) + sh;
                u32x2 o; o.x = pk2(y[0], y[1]); o.y = pk2(y[2], y[3]);
                *(u32x2*)(HB + (size_t)row * DM + 4 * lane + 256 * jj) = o; }
        }
    } else {
        const bf16_t* XB = (const bf16_t*)(a.ws + WS_XB);
        f32x4 gg[2][2];
#pragma unroll
        for (int jj = 0; jj < 2; ++jj) { gg[jj][0] = *(const f32x4*)(g + 8 * lane + 512 * jj); gg[jj][1] = *(const f32x4*)(g + 8 * lane + 512 * jj + 4); }
        for (int row = gw; row < T; row += NGW) {
            const int cond = row < TC ? 8 : ((row - TC) >> 11);
            const float* shift = MOD + (size_t)cond * NMODW + 3 * j * DM; const float* scale = shift + DM;
            f32x4 v[2][2]; float ss = 0.f;
#pragma unroll
            for (int jj = 0; jj < 2; ++jj) { const u32x4 r = *(const u32x4*)(XB + (size_t)row * DM + 8 * lane + 512 * jj);
                v[jj][0] = (f32x4){bflo(r.x), bfhi(r.x), bflo(r.y), bfhi(r.y)}; v[jj][1] = (f32x4){bflo(r.z), bfhi(r.z), bflo(r.w), bfhi(r.w)};
#pragma unroll
                for (int q = 0; q < 2; ++q) ss += (v[jj][q][0] * v[jj][q][0] + v[jj][q][1] * v[jj][q][1]) + (v[jj][q][2] * v[jj][q][2] + v[jj][q][3] * v[jj][q][3]); }
            const float rstd = rsqrtf(wave_sum(ss) * (1.f / DM) + EPS);
#pragma unroll
            for (int jj = 0; jj < 2; ++jj) { f32x4 y[2];
#pragma unroll
                for (int q = 0; q < 2; ++q) { const f32x4 sc = *(const f32x4*)(scale + 8 * lane + 512 * jj + 4 * q), sh = *(const f32x4*)(shift + 8 * lane + 512 * jj + 4 * q);
                    y[q] = v[jj][q] * rstd * gg[jj][q] * (1.f + sc) + sh; }
                u32x4 o; o.x = pk2(y[0][0], y[0][1]); o.y = pk2(y[0][2], y[0][3]); o.z = pk2(y[1][0], y[1][1]); o.w = pk2(y[1][2], y[1][3]);
                *(u32x4*)(HB + (size_t)row * DM + 8 * lane + 512 * jj) = o; }
        }
    }
}
DI void phase_final(const Args& a) {
    const int tid = otid(), lane = tid & 63, w = tid >> 6;
    const int gw = obid() * 8 + w, NGW = gridDim.x * 8;
    const float* g = a.in[21];
    f32x4 gg[4];
#pragma unroll
    for (int jj = 0; jj < 4; ++jj) gg[jj] = *(const f32x4*)(g + 4 * lane + 256 * jj);
    for (int row = gw; row < T; row += NGW) {
        float* xr = a.out + (size_t)row * DM;
        f32x4 v[4]; float ss = 0.f;
#pragma unroll
        for (int jj = 0; jj < 4; ++jj) { v[jj] = *(const f32x4*)(xr + 4 * lane + 256 * jj); ss += (v[jj][0] * v[jj][0] + v[jj][1] * v[jj][1]) + (v[jj][2] * v[jj][2] + v[jj][3] * v[jj][3]); }
        const float rstd = rsqrtf(wave_sum(ss) * (1.f / DM) + EPS);
#pragma unroll
        for (int jj = 0; jj < 4; ++jj) *(f32x4*)(xr + 4 * lane + 256 * jj) = v[jj] * rstd * gg[jj];
    }
}

DI void phase_prep(const Args& a, int l, bool dry) {
    const int tid = otid(), lane = tid & 63, w = tid >> 6;
    const int gw = obid() * 8 + w, NGW = gridDim.x * 8;
    bf16_t* PROJ = (bf16_t*)(a.ws + WS_PROJ);
    const float* cosT = (const float*)(a.ws + WS_ROPE); const float* sinT = cosT + 1024;
    const float qg = a.in[15][(l * 2 + 0) * 64 + lane], kg = a.in[15][(l * 2 + 1) * 64 + lane];
    bf16_t* KAL = (bf16_t*)(a.ws + WS_KAL); bf16_t* VAL = (bf16_t*)(a.ws + WS_VAL); bf16_t* KWL = (bf16_t*)(a.ws + WS_KWL); bf16_t* VWL = (bf16_t*)(a.ws + WS_VWL);
    bf16_t* KAC = (bf16_t*)(a.ws + WS_KAC); bf16_t* VAC = (bf16_t*)(a.ws + WS_VAC); bf16_t* KWC = (bf16_t*)(a.ws + WS_KWC); bf16_t* VWC = (bf16_t*)(a.ws + WS_VWC);
    for (int r = gw; r < T + 2048; r += NGW) {
        if (r < T) {
            const bool lat = r >= TC; int b, t;
            if (lat) { b = (r - TC) >> 11; t = (r - TC) & 2047; } else { b = r >> 8; t = r & 255; }
            float cs = 1.f, sn = 0.f;
            if (lat) { const int pos = (lane & 32) ? (t & 63) : (t >> 6); cs = cosT[pos * 16 + (lane & 15)]; sn = sinT[pos * 16 + (lane & 15)]; if (!(lane & 16)) sn = -sn; }
            bf16_t* pr = PROJ + (size_t)r * INW;
            bf16_t raw[24];
#pragma unroll
            for (int hh = 0; hh < 24; ++hh) raw[hh] = pr[64 * hh + lane];
#pragma unroll
            for (int h = 0; h < 8; ++h) {
                const float x = bf2f(raw[h]); const float ss = wave_sum(x * x);
                float y = x * rsqrtf(ss * (1.f / 64.f) + EPS) * qg;
                if (lat) { const float p = __shfl_xor(y, 16); y = y * cs + p * sn; }
                if (!dry) pr[C_AQ + 64 * h + lane] = f2bf(y * (0.125f * LOG2E));
            }
#pragma unroll
            for (int h = 0; h < 8; ++h) {
                float y = bf2f(raw[12 + h]);
                if (lat) { const float p = __shfl_xor(y, 16); y = y * cs + p * sn; }
                if (!dry) pr[C_WQ + 64 * h + lane] = f2bf(y * (0.125f * LOG2E));
            }
#pragma unroll
            for (int g2 = 0; g2 < 2; ++g2) {
                const float x = bf2f(raw[8 + g2]); const float ss = wave_sum(x * x);
                float y = x * rsqrtf(ss * (1.f / 64.f) + EPS) * kg;
                if (lat) { const float p = __shfl_xor(y, 16); y = y * cs + p * sn; }
                const bf16_t vbits = raw[10 + g2];
                float yw = bf2f(raw[20 + g2]);
                if (lat) { const float p = __shfl_xor(yw, 16); yw = yw * cs + p * sn; }
                const bf16_t wvbits = raw[22 + g2];
                if (lat) {
                    KAL[((size_t)(b * 2 + g2) * 2304 + 256 + t) * 64 + lane] = f2bf(y);
                    VAL[((size_t)(b * 2 + g2) * 64 + lane) * 2304 + 256 + t] = vbits;
                    KWL[((size_t)(b * 2 + g2) * 2304 + 256 + t) * 64 + lane] = f2bf(yw);
                    VWL[((size_t)(b * 2 + g2) * 64 + lane) * 2304 + 256 + t] = wvbits;
                } else {
                    KAC[((size_t)(b * 2 + g2) * 256 + t) * 64 + lane] = f2bf(y);
                    VAC[((size_t)(b * 2 + g2) * 64 + lane) * 256 + t] = vbits;
                    KWC[((size_t)(b * 2 + g2) * 256 + t) * 64 + lane] = f2bf(yw);
                    VWC[((size_t)(b * 2 + g2) * 64 + lane) * 256 + t] = wvbits;
                    const size_t oi = ((((size_t)b * DEPTH + l) * 256 + t) * 2 + g2) * 64 + lane;
                    a.out[O_NKA + oi] = y; a.out[O_NVA + oi] = bf2f(vbits); a.out[O_NKW + oi] = yw; a.out[O_NVW + oi] = bf2f(wvbits);
                }
            }
        } else {
            const int idx = r - T, b = idx >> 8, p = idx & 255;
#pragma unroll
            for (int g2 = 0; g2 < 2; ++g2) {
                const size_t ci = ((((size_t)b * DEPTH + l) * 256 + p) * 2 + g2) * 64 + lane;
                KAL[((size_t)(b * 2 + g2) * 2304 + p) * 64 + lane] = f2bf(a.in[2][ci]);
                VAL[((size_t)(b * 2 + g2) * 64 + lane) * 2304 + p] = f2bf(a.in[3][ci]);
                KWL[((size_t)(b * 2 + g2) * 2304 + p) * 64 + lane] = f2bf(a.in[4][ci]);
                VWL[((size_t)(b * 2 + g2) * 64 + lane) * 2304 + p] = f2bf(a.in[5][ci]);
            }
        }
    }
}

DI void attn_item(unsigned char* lds, const bf16_t* qp, bf16_t* op, const bf16_t* Kb, const bf16_t* VTb, int nk, int nA, int lo, int hi, bool win, int tq, bool has_sink, float sink2, bool nomax) {
    const int tid = otid(), lane = tid & 63, h = lane >> 5, c = lane & 31;
    const int n64 = nA + (hi - lo), nit = (n64 + 1) >> 1;
    constexpr int STG = 17664;
    bf16_t* Kst0 = (bf16_t*)lds; bf16_t* Vst0 = (bf16_t*)lds + 9216;
    int qoff = (tid >> 6) * 2048 + lane * 8;
    bf16_t* qpark = (bf16_t*)lds + 2 * STG;
#pragma unroll
    for (int s = 0; s < 4; ++s) *(bf16x8*)(qpark + qoff + s * 512) = *(const bf16x8*)(qp + 16 * s + 8 * h);
    f32x16 O0, O1;
#pragma unroll
    for (int i = 0; i < 16; ++i) { O0[i] = 0.f; O1[i] = 0.f; }
    float m = 0.f, lsum = 0.f;
    const int lrow = tid >> 3, lch = tid & 7;
    u32x4 kR, vR;
#define AT_KEY0(j) (((j) < nA ? (j) : 4 + lo + ((j) - nA)) * 64)
#define AT_LOAD(it, sub) do { const int j_ = (2 * (it) + (sub) < n64) ? 2 * (it) + (sub) : 2 * (it); const int k_ = AT_KEY0(j_); \
        kR = *(const u32x4*)(Kb + (size_t)(k_ + lrow) * 64 + 8 * lch); vR = *(const u32x4*)(VTb + (size_t)lrow * nk + k_ + 8 * lch); } while (0)
#define AT_STORE(stg, sub) do { bf16_t* kd_ = Kst0 + (stg) * STG; bf16_t* vd_ = Vst0 + (stg) * STG; \
        *(u32x4*)(kd_ + (64 * (sub) + lrow) * 72 + 8 * lch) = kR; \
        *(u32x2*)(vd_ + lrow * 132 + 64 * (sub) + 8 * lch) = (u32x2){vR.x, vR.y}; *(u32x2*)(vd_ + lrow * 132 + 64 * (sub) + 8 * lch + 4) = (u32x2){vR.z, vR.w}; } while (0)
    AT_LOAD(0, 0); AT_STORE(0, 0); AT_LOAD(0, 1); AT_STORE(0, 1);
    __syncthreads();
    for (int i = 0; i < nit; ++i) {
        const int cur = i & 1;
        if (i + 1 < nit) AT_LOAD(i + 1, 0);
        const bf16_t* Kc = Kst0 + cur * STG; const bf16_t* Vc = Vst0 + cur * STG;
        f32x16 st[4];
        const float cinit = -m;
#pragma unroll
        for (int t = 0; t < 4; ++t)
#pragma unroll
            for (int ii = 0; ii < 16; ++ii) st[t][ii] = cinit;
        asm volatile("" : "+v"(qoff));
#pragma unroll
        for (int s = 0; s < 4; ++s) { const bf16x8 qv = *(const bf16x8*)(qpark + qoff + s * 512);
#pragma unroll
            for (int t = 0; t < 4; ++t) { const bf16x8 ak = *(const bf16x8*)(Kc + (32 * t + c) * 72 + 16 * s + 8 * h); st[t] = MFMA32(ak, qv, st[t]); } }
        float ps = 0.f;
        if (nomax) {
#pragma unroll
            for (int t = 0; t < 4; ++t)
#pragma unroll
                for (int ii = 0; ii < 16; ++ii) { const float p = __builtin_amdgcn_exp2f(st[t][ii]); st[t][ii] = p; ps += p; }
            lsum += ps;
        } else {
            const int ja = 2 * i, jb = 2 * i + 1;
            if (win && ja >= nA) { const int k0 = AT_KEY0(ja);
#pragma unroll
                for (int t = 0; t < 2; ++t)
#pragma unroll
                    for (int ii = 0; ii < 16; ++ii) { const int dd = tq - (k0 - 256 + 32 * t + crow(ii, h)); if (dd > 128 || dd < -128) st[t][ii] = -1e30f; } }
            if (jb >= n64) {
#pragma unroll
                for (int t = 2; t < 4; ++t)
#pragma unroll
                    for (int ii = 0; ii < 16; ++ii) st[t][ii] = -1e30f;
            } else if (win && jb >= nA) { const int k0 = AT_KEY0(jb);
#pragma unroll
                for (int t = 2; t < 4; ++t)
#pragma unroll
                    for (int ii = 0; ii < 16; ++ii) { const int dd = tq - (k0 - 256 + 32 * (t - 2) + crow(ii, h)); if (dd > 128 || dd < -128) st[t][ii] = -1e30f; } }
            float mx = -1e30f;
#pragma unroll
            for (int ii = 0; ii < 16; ++ii) mx = fmaxf(mx, fmaxf(fmaxf(st[0][ii], st[1][ii]), fmaxf(st[2][ii], st[3][ii])));
            mx = fmaxf(mx, __shfl_xor(mx, 32));
            if (i == 0) {
                const float mnew = has_sink ? fmaxf(mx, sink2) : mx;
#pragma unroll
                for (int t = 0; t < 4; ++t)
#pragma unroll
                    for (int ii = 0; ii < 16; ++ii) { const float p = __builtin_amdgcn_exp2f(st[t][ii] - mnew); st[t][ii] = p; ps += p; }
                lsum = ps + ((has_sink && h == 0) ? __builtin_amdgcn_exp2f(sink2 - mnew) : 0.f);
                m = mnew;
            } else if (__builtin_amdgcn_ballot_w64(mx > 0.f) != 0ull) {
                const float delta = fmaxf(mx, 0.f); const float alpha = __builtin_amdgcn_exp2f(-delta); m += delta;
#pragma unroll
                for (int t = 0; t < 4; ++t)
#pragma unroll
                    for (int ii = 0; ii < 16; ++ii) { const float p = __builtin_amdgcn_exp2f(st[t][ii] - delta); st[t][ii] = p; ps += p; }
                lsum = lsum * alpha + ps;
#pragma unroll
                for (int ii = 0; ii < 16; ++ii) { O0[ii] *= alpha; O1[ii] *= alpha; }
            } else {
#pragma unroll
                for (int t = 0; t < 4; ++t)
#pragma unroll
                    for (int ii = 0; ii < 16; ++ii) { const float p = __builtin_amdgcn_exp2f(st[t][ii]); st[t][ii] = p; ps += p; }
                lsum += ps;
            }
        }
        if (i + 1 < nit) { AT_STORE(cur ^ 1, 0); AT_LOAD(i + 1, 1); }
#pragma unroll
        for (int t = 0; t < 4; ++t)
#pragma unroll
            for (int s2 = 0; s2 < 2; ++s2) {
                const bf16x8 pb = pack8(st[t][8 * s2], st[t][8 * s2 + 1], st[t][8 * s2 + 2], st[t][8 * s2 + 3], st[t][8 * s2 + 4], st[t][8 * s2 + 5], st[t][8 * s2 + 6], st[t][8 * s2 + 7]);
                const bf16_t* v0p = Vc + c * 132 + 32 * t + 16 * s2 + 4 * h; const bf16_t* v1p = Vc + (32 + c) * 132 + 32 * t + 16 * s2 + 4 * h;
                O0 = MFMA32(cat44(*(const s16x4*)(v0p), *(const s16x4*)(v0p + 8)), pb, O0);
                O1 = MFMA32(cat44(*(const s16x4*)(v1p), *(const s16x4*)(v1p + 8)), pb, O1);
            }
        if (i + 1 < nit) AT_STORE(cur ^ 1, 1);
        __syncthreads();
    }
#undef AT_KEY0
#undef AT_LOAD
#undef AT_STORE
    lsum += __shfl_xor(lsum, 32);
    const float inv = 1.f / lsum;
#pragma unroll
    for (int g4 = 0; g4 < 4; ++g4) {
        u32x2 w0, w1;
        w0.x = pk2(O0[4 * g4] * inv, O0[4 * g4 + 1] * inv); w0.y = pk2(O0[4 * g4 + 2] * inv, O0[4 * g4 + 3] * inv);
        w1.x = pk2(O1[4 * g4] * inv, O1[4 * g4 + 1] * inv); w1.y = pk2(O1[4 * g4 + 2] * inv, O1[4 * g4 + 3] * inv);
        *(u32x2*)(op + 8 * g4 + 4 * h) = w0; *(u32x2*)(op + 32 + 8 * g4 + 4 * h) = w1;
    }
}
#define LAS __attribute__((address_space(3)))
#define XB_TMO      128
#define XB_XCNT(j)  (256  + 64 * (j))
#define XB_XSUB(j)  (1280 + 64 * (j))
#define XB_XGEN(j)  (2304 + 64 * (j))
#define XB_TOP      3328
#define XB_TOPGEN   3392
#define XCD_BAR_WORDS 3456
#define XB_SPIN_CAP (1u << 18)

__device__ __forceinline__ unsigned xb_ld(unsigned* p)              { return __hip_atomic_load(p, __ATOMIC_RELAXED, __HIP_MEMORY_SCOPE_AGENT); }
__device__ __forceinline__ unsigned xb_add(unsigned* p, unsigned v) { return __hip_atomic_fetch_add(p, v, __ATOMIC_RELAXED, __HIP_MEMORY_SCOPE_AGENT); }
__device__ __forceinline__ unsigned xb_xcc_id() { return (unsigned)__builtin_amdgcn_s_getreg((3 << 11) | 20) & 0xFu; }
#define XB_SPIN(cond, bar) do { unsigned _sp = 0; while (cond) { __builtin_amdgcn_s_sleep(1); \
    if ((++_sp & 255u) == 0u) { if (xb_ld(&(bar)[XB_TMO])) break; if (_sp > XB_SPIN_CAP) { atomicAdd(&(bar)[XB_TMO], 1u); break; } } } } while (0)

struct XcdBarrier {
    unsigned* bar; unsigned x;
    volatile LAS unsigned* st;
};

__device__ __forceinline__ XcdBarrier xcd_barrier_post(unsigned* bar, volatile LAS unsigned* st) {
    XcdBarrier b; b.bar = bar; b.x = xb_xcc_id(); b.st = st;
    if (threadIdx.x == 0) (void)xb_add(&bar[XB_XCNT(b.x)], 1u);
    return b;
}
__device__ __forceinline__ void xcd_barrier_complete(unsigned* bar, unsigned x, unsigned& nloc, unsigned& nx) {
    const unsigned G = gridDim.x * gridDim.y * gridDim.z;
    unsigned sum, cnt, mine, sp = 0u;
    for (;;) {
        sum = 0u; cnt = 0u; mine = 0u;
#pragma unroll
        for (unsigned j = 0; j < 16; ++j) { const unsigned c = xb_ld(&bar[XB_XCNT(j)]); sum += c; cnt += (c > 0u) ? 1u : 0u; mine = (j == x) ? c : mine; }
        if (sum == G) break;
        __builtin_amdgcn_s_sleep(1);
        if ((++sp & 255u) == 0u) { if (xb_ld(&bar[XB_TMO])) break; if (sp > XB_SPIN_CAP) { atomicAdd(&bar[XB_TMO], 1u); break; } }
    }
    nloc = mine > 0u ? mine : 1u; nx = cnt > 0u ? cnt : 1u;
}

__device__ __forceinline__ void xcd_barrier(const XcdBarrier& b) {
    asm volatile("s_waitcnt vmcnt(0)" ::: "memory");
    __syncthreads();
    if (threadIdx.x == 0) {
        unsigned* bar = b.bar;
        __builtin_amdgcn_s_waitcnt(0);
        unsigned nloc = b.st[0], nx = b.st[1];
        if (nloc == 0u) { xcd_barrier_complete(bar, b.x, nloc, nx); b.st[0] = nloc; b.st[1] = nx; }
        const unsigned old = xb_add(&bar[XB_XSUB(b.x)], 1u);
        const unsigned gen = old / nloc;
        if (old + 1u == (gen + 1u) * nloc) {
            __builtin_amdgcn_fence(__ATOMIC_RELEASE, "agent");
            asm volatile("s_waitcnt vmcnt(0)" ::: "memory");
            const unsigned og = xb_add(&bar[XB_TOP], 1u);
            const unsigned tg = og / nx;
            if (og + 1u == (tg + 1u) * nx) xb_add(&bar[XB_TOPGEN], 1u);
            else XB_SPIN(xb_ld(&bar[XB_TOPGEN]) == tg, bar);
            __builtin_amdgcn_fence(__ATOMIC_ACQUIRE, "agent");
            xb_add(&bar[XB_XGEN(b.x)], 1u);
            asm volatile("s_waitcnt vmcnt(0)" ::: "memory");
        } else {
            XB_SPIN(xb_ld(&bar[XB_XGEN(b.x)]) == gen, bar);
            __builtin_amdgcn_fence(__ATOMIC_ACQUIRE, "agent");
            asm volatile("s_waitcnt vmcnt(0)" ::: "memory");
        }
    }
    __syncthreads();
}


DI void hgrn_item(const Args& a, unsigned char* lds, int l, int seq, int hd, int dir) {
    const int tid = otid(), lane = tid & 63, w = tid >> 6, h = lane >> 5, c = lane & 31;
    const bool lat = seq < 8; const int b = lat ? seq : seq - 8; const int L = lat ? 2048 : 256; const int nch = L >> 5; const int seqbase = lat ? TC + b * 2048 : b * 256;
    bf16_t* RQ = (bf16_t*)lds; bf16_t* RZ = (bf16_t*)(lds + 8704); bf16_t* RV = (bf16_t*)(lds + 17408);
    bf16_t* QS = (bf16_t*)(lds + 26112); bf16_t* KS = (bf16_t*)(lds + 34816);
    bf16_t* KST = (bf16_t*)(lds + 43520); bf16_t* VT = (bf16_t*)(lds + 53760); float* E0 = (float*)(lds + 64000); float* E1 = E0 + 128;
    const bf16_t* PROJ = (const bf16_t*)(a.ws + WS_PROJ);
    bf16_t* OF = (bf16_t*)(a.ws + WS_OF);
    const int cq = C_HQ + 128 * hd, cz = (dir ? C_HFB : C_HFF) + 128 * hd, cv = C_HI + 128 * hd;
    const int wd = w & 3;
    const int dmy = 32 * wd + c;
    const int t0 = 16 * (w >> 2) + 8 * h;
    f32x16 S[4];
    if (w < 4) {
        if (lat) { const float* sp = a.in[6] + ((((size_t)(b * DEPTH + l) * 2 + dir) * 4 + hd) * 128) * 128;
#pragma unroll
            for (int dt = 0; dt < 4; ++dt)
#pragma unroll
                for (int ii = 0; ii < 16; ++ii) S[dt][ii] = sp[(size_t)(32 * dt + crow(ii, h)) * 128 + dmy];
        } else {
#pragma unroll
            for (int dt = 0; dt < 4; ++dt)
#pragma unroll
                for (int ii = 0; ii < 16; ++ii) S[dt][ii] = 0.f;
        }
    }
    const float lbv = ((const float*)(a.ws + WS_LB))[(l * 2 + dir) * 512 + 128 * hd + dmy];
    const float omlb = 1.f - lbv;
    u32x4 rq, rz, rv;
    const int lt = tid >> 4, lcn = tid & 15;
#define HG_GLOAD(ch) do { const int p_ = 32 * (ch) + lt, pos_ = dir ? L - 1 - p_ : p_; const bf16_t* rp_ = PROJ + (size_t)(seqbase + pos_) * INW + 8 * lcn; \
        rq = *(const u32x4*)(rp_ + cq); rz = *(const u32x4*)(rp_ + cz); rv = *(const u32x4*)(rp_ + cv); } while (0)
    HG_GLOAD(0);
    for (int ch = 0; ch < nch; ++ch) {
        *(u32x4*)(RQ + lt * 136 + 8 * lcn) = rq; *(u32x4*)(RZ + lt * 136 + 8 * lcn) = rz; *(u32x4*)(RV + lt * 136 + 8 * lcn) = rv;
        __syncthreads();
        if (ch + 1 < nch) HG_GLOAD(ch + 1);
        {
            float qv[8], kv[8], gv[8]; float qtot = 0.f;
#pragma unroll
            for (int tt = 0; tt < 8; ++tt) { const int t = t0 + tt; const float qr = bf2f(RQ[t * 136 + dmy]), z = bf2f(RZ[t * 136 + dmy]);
                const float sg = sigmoidf_(z); const float f = lbv + omlb * sg; const float g = __logf(fmaxf(f, 1e-30f));
                kv[tt] = omlb * (1.f - sg); qv[tt] = qr * sigmoidf_(qr); gv[tt] = g; qtot += g; }
            const float partner = __shfl_xor(qtot, 32);
            float e[8];
            if (w < 4) { float run = h ? 0.f : -partner;
#pragma unroll
                for (int tt = 7; tt >= 0; --tt) { e[tt] = run; run -= gv[tt]; }
                if (h == 0) E0[dmy] = __expf(qtot + partner);
            } else { float run = h ? partner : 0.f;
#pragma unroll
                for (int tt = 0; tt < 8; ++tt) { run += gv[tt]; e[tt] = run; }
                if (h == 0) E1[dmy] = __expf(qtot + partner);
            }
            float ke[8];
#pragma unroll
            for (int tt = 0; tt < 8; ++tt) { const int t = t0 + tt; const float ex = __expf(fminf(fmaxf(e[tt], -80.f), 80.f)), exn = __builtin_amdgcn_rcpf(ex);
                ke[tt] = kv[tt] * exn;
                QS[t * 136 + dmy] = f2bf(qv[tt] * ex); KS[t * 136 + dmy] = f2bf(ke[tt]); }
            *(bf16x8*)(KST + dmy * 40 + t0) = pack8(ke[0], ke[1], ke[2], ke[3], ke[4], ke[5], ke[6], ke[7]);
            bf16x8 v0;
#pragma unroll
            for (int tt = 0; tt < 8; ++tt) v0[tt] = (short)RV[(t0 + tt) * 136 + dmy];
            *(bf16x8*)(VT + dmy * 40 + t0) = v0;
        }
        __syncthreads();
        if (w < 4) {
            f32x16 st;
#pragma unroll
            for (int ii = 0; ii < 16; ++ii) st[ii] = 0.f;
#pragma unroll
            for (int s = 0; s < 8; ++s) { const bf16x8 ak = *(const bf16x8*)(KS + c * 136 + 16 * s + 8 * h), bq = *(const bf16x8*)(QS + c * 136 + 16 * s + 8 * h); st = MFMA32(ak, bq, st); }
#pragma unroll
            for (int ii = 0; ii < 16; ++ii) if (crow(ii, h) > c) st[ii] = 0.f;
            f32x16 o;
#pragma unroll
            for (int ii = 0; ii < 16; ++ii) o[ii] = 0.f;
#pragma unroll
            for (int s2 = 0; s2 < 2; ++s2) {
                const bf16x8 pb = pack8(st[8 * s2], st[8 * s2 + 1], st[8 * s2 + 2], st[8 * s2 + 3], st[8 * s2 + 4], st[8 * s2 + 5], st[8 * s2 + 6], st[8 * s2 + 7]);
                const bf16_t* vp = VT + dmy * 40 + 16 * s2 + 4 * h;
                o = MFMA32(cat44(*(const s16x4*)vp, *(const s16x4*)(vp + 8)), pb, o);
            }
#pragma unroll
            for (int dt = 0; dt < 4; ++dt) {
#pragma unroll
                for (int g4 = 0; g4 < 4; ++g4) { const f32x4 ev = *(const f32x4*)(E0 + 32 * dt + 8 * g4 + 4 * h);
                    S[dt][4 * g4] *= ev[0]; S[dt][4 * g4 + 1] *= ev[1]; S[dt][4 * g4 + 2] *= ev[2]; S[dt][4 * g4 + 3] *= ev[3]; }
#pragma unroll
                for (int s2 = 0; s2 < 2; ++s2) {
                    const bf16x8 xs = pack8(S[dt][8 * s2], S[dt][8 * s2 + 1], S[dt][8 * s2 + 2], S[dt][8 * s2 + 3], S[dt][8 * s2 + 4], S[dt][8 * s2 + 5], S[dt][8 * s2 + 6], S[dt][8 * s2 + 7]);
                    const bf16_t* qb = QS + c * 136 + 32 * dt + 16 * s2 + 4 * h;
                    o = MFMA32(xs, cat44(*(const s16x4*)qb, *(const s16x4*)(qb + 8)), o);
                }
            }
            {   const int p = 32 * ch + c, pos = dir ? L - 1 - p : p;
                bf16_t* op = OF + ((size_t)dir * T + seqbase + pos) * 512 + 128 * hd + 32 * wd;
#pragma unroll
                for (int g4 = 0; g4 < 4; ++g4) { u32x2 v; v.x = pk2(o[4 * g4], o[4 * g4 + 1]); v.y = pk2(o[4 * g4 + 2], o[4 * g4 + 3]); *(u32x2*)(op + 8 * g4 + 4 * h) = v; } }
#pragma unroll
            for (int dt = 0; dt < 4; ++dt) {
#pragma unroll
                for (int s2 = 0; s2 < 2; ++s2) { const bf16x8 ak = *(const bf16x8*)(KST + (32 * dt + c) * 40 + 16 * s2 + 8 * h), bv = *(const bf16x8*)(VT + dmy * 40 + 16 * s2 + 8 * h);
                    S[dt] = MFMA32(ak, bv, S[dt]); }
#pragma unroll
                for (int g4 = 0; g4 < 4; ++g4) { const f32x4 ev = *(const f32x4*)(E1 + 32 * dt + 8 * g4 + 4 * h);
                    S[dt][4 * g4] *= ev[0]; S[dt][4 * g4 + 1] *= ev[1]; S[dt][4 * g4 + 2] *= ev[2]; S[dt][4 * g4 + 3] *= ev[3]; }
            }
        }
    }
#undef HG_GLOAD
    if (!lat && w < 4) { float* sp = a.out + O_NST + ((((size_t)(b * DEPTH + l) * 2 + dir) * 4 + hd) * 128) * 128;
#pragma unroll
        for (int dt = 0; dt < 4; ++dt)
#pragma unroll
            for (int ii = 0; ii < 16; ++ii) sp[(size_t)(32 * dt + crow(ii, h)) * 128 + dmy] = S[dt][ii];
    }
}

DI void phase_mixer(const Args& a, unsigned char* lds, int l, int rep) {
    unsigned* ctl = (unsigned*)(a.ws + WS_CTL) + 16 * l + 8 * rep;
    volatile int* slot = (volatile int*)(lds + LDS_MISC);
    const int tid = otid(), lane = tid & 63, w = tid >> 6, c = lane & 31;
    bf16_t* PROJ = (bf16_t*)(a.ws + WS_PROJ);
    for (;;) {
        __syncthreads();
        if (tid == 0) *slot = (int)__hip_atomic_fetch_add(ctl, 1u, __ATOMIC_RELAXED, __HIP_MEMORY_SCOPE_AGENT);
        __syncthreads();
        const int it = *slot;
        if (it >= 1856) break;
#if PROBE_MASK & 16
        if (rep && !(it < 64 || (it >= 576 && it < 832))) continue;
#endif
#if PROBE_MASK & 32
        if (rep && (it < 64 || (it >= 576 && it < 832))) continue;
#endif
#ifndef NO_HG
        if (it < 64) { hgrn_item(a, lds, l, it >> 3, (it >> 1) & 3, it & 1); continue; }
        if (it >= 576 && it < 832) { const int idx = it - 576; hgrn_item(a, lds, l, 8 + (idx >> 3), (idx >> 1) & 3, idx & 1); continue; }
#endif
        int idx, kind;
        if (it < 576) { idx = it - 64; kind = 0; } else if (it < 1344) { idx = it - 832; kind = 1; } else if (it < 1600) { idx = it - 1344; kind = 2; } else { idx = it - 1600; kind = 3; }
        const bool lat = kind < 2, isw = kind & 1;
        int b, g, qb;
        if (lat) { b = idx >> 6; g = (idx >> 5) & 1; qb = idx & 31; } else { b = idx >> 3; g = (idx >> 2) & 1; qb = idx & 3; }
        const int r = w & 3, tq = 64 * qb + 32 * (w >> 2) + c;
        const int row = (lat ? TC + b * 2048 : b * 256) + tq;
        const bf16_t* qp = PROJ + (size_t)row * INW + (isw ? C_WQ : C_AQ) + (4 * g + r) * 64;
        bf16_t* op = (bf16_t*)(a.ws + (isw ? WS_OWIN : WS_OATT)) + (size_t)row * 512 + (4 * g + r) * 64;
        const bf16_t* Kb; const bf16_t* VTb; int nk;
        if (lat) { nk = 2304; Kb = (const bf16_t*)(a.ws + (isw ? WS_KWL : WS_KAL)) + (size_t)(b * 2 + g) * 2304 * 64; VTb = (const bf16_t*)(a.ws + (isw ? WS_VWL : WS_VAL)) + (size_t)(b * 2 + g) * 64 * 2304; }
        else { nk = 256; Kb = (const bf16_t*)(a.ws + (isw ? WS_KWC : WS_KAC)) + (size_t)(b * 2 + g) * 256 * 64; VTb = (const bf16_t*)(a.ws + (isw ? WS_VWC : WS_VAC)) + (size_t)(b * 2 + g) * 64 * 256; }
        int nA = 4, lo = 0, hi = 0; bool win = false;
        if (kind == 0) nA = 36;
        if (kind == 1) { lo = qb - 2 < 0 ? 0 : qb - 2; hi = qb + 3 > 32 ? 32 : qb + 3; win = true; }
        const float sink2 = isw ? a.in[18][l * 8 + 4 * g + r] * LOG2E : 0.f;
#ifndef NO_ATT
        attn_item(lds, qp, op, Kb, VTb, nk, nA, lo, hi, win, tq, isw, sink2, !isw);
#endif
    }
}

DI void phase_hgcomb(const Args& a, int l) {
    const int tid = otid(), lane = tid & 63, w = tid >> 6;
    const int gw = obid() * 8 + w, NGW = gridDim.x * 8;
    const bf16_t* OF = (const bf16_t*)(a.ws + WS_OF); const bf16_t* PROJ = (const bf16_t*)(a.ws + WS_PROJ); bf16_t* OHG = (bf16_t*)(a.ws + WS_OHG);
    const f32x4 gn0 = *(const f32x4*)(a.in[17] + l * 128 + ((8 * lane) & 127)), gn1 = *(const f32x4*)(a.in[17] + l * 128 + ((8 * lane) & 127) + 4);
    for (int row = gw; row < T; row += NGW) {
        const u32x4 xa = *(const u32x4*)(OF + (size_t)row * 512 + 8 * lane), xb = *(const u32x4*)(OF + ((size_t)T + row) * 512 + 8 * lane);
        const u32x4 gb = *(const u32x4*)(PROJ + (size_t)row * INW + C_HG + 8 * lane);
        float s[8];
        s[0] = bflo(xa.x) + bflo(xb.x); s[1] = bfhi(xa.x) + bfhi(xb.x); s[2] = bflo(xa.y) + bflo(xb.y); s[3] = bfhi(xa.y) + bfhi(xb.y);
        s[4] = bflo(xa.z) + bflo(xb.z); s[5] = bfhi(xa.z) + bfhi(xb.z); s[6] = bflo(xa.w) + bflo(xb.w); s[7] = bfhi(xa.w) + bfhi(xb.w);
        float ss = 0.f;
#pragma unroll
        for (int i = 0; i < 8; ++i) ss += s[i] * s[i];
        ss += __shfl_xor(ss, 1); ss += __shfl_xor(ss, 2); ss += __shfl_xor(ss, 4); ss += __shfl_xor(ss, 8);
        const float rstd = rsqrtf(ss * (1.f / 128.f) + EPS);
        float g[8];
        g[0] = bflo(gb.x); g[1] = bfhi(gb.x); g[2] = bflo(gb.y); g[3] = bfhi(gb.y); g[4] = bflo(gb.z); g[5] = bfhi(gb.z); g[6] = bflo(gb.w); g[7] = bfhi(gb.w);
        float o[8];
#pragma unroll
        for (int i = 0; i < 8; ++i) o[i] = s[i] * rstd * (i < 4 ? gn0[i] : gn1[i - 4]) * g[i] * sigmoidf_(g[i]);
        u32x4 wv; wv.x = pk2(o[0], o[1]); wv.y = pk2(o[2], o[3]); wv.z = pk2(o[4], o[5]); wv.w = pk2(o[6], o[7]);
        *(u32x4*)(OHG + (size_t)row * 512 + 8 * lane) = wv;
    }
}

template <class Epi> DI void run_gemm(unsigned char* lds, const bf16_t* A, const bf16_t* Bt, int N, int K, const Epi& E) {
    pg8::Gemm g{A, Bt, T, N, K}; pg8::StaticOrder S; S.init(T, N, (int)gridDim.x, obid());
#if STAGGER
    {
        const unsigned long long t0 = __builtin_amdgcn_s_memrealtime();
        const unsigned long long dly = (unsigned long long)((obid() >> 3) & 7) * (unsigned long long)(STAGGER * (K / 64));
        while (__builtin_amdgcn_s_memrealtime() - t0 < dly) __builtin_amdgcn_s_sleep(4);
    }
#endif
    pg8::gemm_phase<Epi, pg8::StaticOrder, false>((PG8_LAS unsigned char*)lds, g, S, E, nullptr);
}

__global__ void __launch_bounds__(512, 2) mk_fwd(Args a) {
    extern __shared__ __attribute__((aligned(16))) unsigned char lds[];
    cg::grid_group grid = cg::this_grid();
    {   volatile LAS unsigned* st = (volatile LAS unsigned*)((LAS unsigned char*)lds + LDS_MISC + 16);
        if (threadIdx.x < 2) st[threadIdx.x] = 0u;
        __syncthreads(); }
    const XcdBarrier bar = xcd_barrier_post((unsigned*)(a.ws + WS_BAR), (volatile LAS unsigned*)((LAS unsigned char*)lds + LDS_MISC + 16));
    bf16_t* HB = (bf16_t*)(a.ws + WS_HB); bf16_t* PROJ = (bf16_t*)(a.ws + WS_PROJ); bf16_t* ACT = PROJ;
    float* M32 = (float*)(a.ws + WS_OF);
    for (int ph = a.ph_lo; ph < a.ph_hi; ++ph) {
        if (ph > a.ph_lo) { if (ph == a.ph_lo + 1) grid.sync(); else xcd_barrier(bar);
#if PROBE_MASK & 8
            xcd_barrier(bar); xcd_barrier(bar);
#endif
        }
#ifndef NO_P0
        if (ph == 0) { phase_p0(a, lds); __syncthreads(); phase_wconv(a, lds, 0, 0, 13312, obid(), (int)gridDim.x); continue; }
#endif
#ifndef NO_C0
        if (ph == NPH - 1) { phase_final(a); continue; }
#endif
        const int l = (ph - 1) / 13, k = (ph - 1) % 13;
        int reps = 1;
        if ((PROBE_MASK & 1) && (k == 0 || k == 3 || k == 10 || k == 7)) reps = 2;
        if ((PROBE_MASK & 2) && (k == 1 || k == 11 || k == 4 || k == 8)) reps = 2;
        if ((PROBE_MASK & (4 | 16 | 32)) && k == 6) reps = 2;
        if ((PROBE_MASK & (64 | 128)) && (k == 1 || k == 11)) reps = 2;
        if ((PROBE_MASK & 256) && k == 4) reps = 2;
        if ((PROBE_MASK & 2048) && k == 5) reps = 2;
        if ((PROBE_MASK & 512) && k == 8) reps = 2;
        if ((PROBE_MASK & 1024) && (k == 2 || k == 9 || k == 12)) reps = 2;
        for (int rep = 0; rep < reps; ++rep) {
        if (rep) xcd_barrier(bar);
        const float* MODL = (const float*)(a.ws + WS_MOD) + (size_t)l * 9 * NMODW;
        const unsigned char* wb = a.ws + WS_W;
        const bf16_t* WFI = (const bf16_t*)(wb + W_FI); const bf16_t* WFO = (const bf16_t*)(wb + W_FO);
        if (k == 100) {}
#ifndef NO_C0
        else if (k == 0) { if (l > 0) phase_wconv(a, lds, l, 0, 13312, obid(), (int)gridDim.x); phase_norm(a, l, 0, l == 0); }
        else if (k == 3 || k == 10) { phase_norm(a, l, k == 3 ? 1 : 2, false); }
#endif
#ifndef NO_G_SW
        else if (k == 1 || k == 11) { run_gemm(lds, HB, k == 1 ? WFI : WFI + (size_t)5632 * 1024, 2 * DFF, ((PROBE_MASK & 128) && rep == 0) ? 512 : DM, pg8::EpiSwiglu{ACT}); }
#endif
#ifndef NO_G_RES
        else if (k == 2 || k == 9 || k == 12) {
            const bf16_t* A = k == 9 ? HB : ACT; const bf16_t* Bt = k == 9 ? (const bf16_t*)(wb + W_OUT) : (k == 2 ? WFO : WFO + (size_t)1024 * DFF);
            const int K = k == 9 ? DM : DFF;
            run_gemm(lds, A, Bt, DM, K, pg8::EpiResid{a.in[0], a.in[1], a.ws, a.out, l, k});
        }
#endif
#ifndef NO_G_BF
        else if (k == 4) { run_gemm(lds, HB, (const bf16_t*)(wb + W_IN), INW, DM, pg8::EpiBf16P{PROJ, INW}); }
#endif
#ifndef NO_PREP
        else if (k == 5) { phase_prep(a, l, (PROBE_MASK & 2048) && rep == 0); }
#endif
#ifndef NO_MIX
        else if (k == 6) { phase_mixer(a, lds, l, rep); }
#endif
#ifndef NO_C0
        else if (k == 7) { phase_hgcomb(a, l); }
#endif
#ifndef NO_G_BR
        else if (k == 8) {
            const bf16_t* WBR = (const bf16_t*)(wb + W_BR);
            for (int kk = 0; kk < 3; ++kk) {
                const bf16_t* A = (const bf16_t*)(a.ws + (kk == 0 ? WS_OATT : (kk == 1 ? WS_OHG : WS_OWIN)));
                run_gemm(lds, A, WBR + (size_t)kk * 1024 * 512, DM, 512, pg8::EpiBranch{PROJ + C_GA + 1024 * kk, M32, HB, kk});
            }
        }
#endif
        }
    }
}

#ifndef MK_PER_PHASE
#define MK_PER_PHASE 0
#endif
extern "C" void kernel_launch(void* const* d_in, const int* in_sizes, int n_in, void* d_out, int out_size, void* d_ws, size_t ws_size, hipStream_t stream) {
    static int grid = 0;
    if (!grid) {
        if (n_in != 22 || ws_size < WS_END) { fprintf(stderr, "kernel_launch: unexpected n_in %d or ws_size %zu < %zu\n", n_in, ws_size, (size_t)WS_END); grid = -1; return; }
        int dev = 0, cus = 0, per_cu = 0;
        (void)hipGetDevice(&dev); (void)hipDeviceGetAttribute(&cus, hipDeviceAttributeMultiprocessorCount, dev);
        if (hipFuncSetAttribute((const void*)mk_fwd, hipFuncAttributeMaxDynamicSharedMemorySize, LDS_BYTES) != hipSuccess) { fprintf(stderr, "kernel_launch: hipFuncSetAttribute failed\n"); grid = -1; return; }
        (void)hipOccupancyMaxActiveBlocksPerMultiprocessor(&per_cu, mk_fwd, 512, LDS_BYTES);
        if (per_cu < 1) per_cu = 1;
        grid = cus * per_cu; if (grid > 256) grid = 256;
    }
    if (grid < 0) return;
    (void)hipMemsetAsync((char*)d_ws + WS_CTL, 0, CTL_BYTES, stream);
    Args a{};
    for (int i = 0; i < 22; ++i) a.in[i] = (const float*)d_in[i];
    a.out = (float*)d_out; a.ws = (unsigned char*)d_ws;
#if MK_PER_PHASE
    for (int ph = 0; ph < NPH; ++ph) { a.ph_lo = ph; a.ph_hi = ph + 1; hipLaunchKernelGGL(mk_fwd, dim3(grid), dim3(512), LDS_BYTES, stream, a); }
#else
    a.ph_lo = 0; a.ph_hi = NPH;
    void* args[] = {&a};
    hipError_t e = hipLaunchCooperativeKernel((void*)mk_fwd, dim3(grid), dim3(512), args, LDS_BYTES, stream);
    if (e != hipSuccess) fprintf(stderr, "cooperative launch failed: %s (grid %d)\n", hipGetErrorString(e), grid);
#endif
}
```

```cpp
#include <hip/hip_runtime.h>
#include <hip/hip_cooperative_groups.h>
#include <cstdio>
#include <cstdint>
namespace cg = cooperative_groups;

#ifndef PROBE_MASK
#define PROBE_MASK 0
#endif
#ifndef STAGGER
#define STAGGER 0
#endif
#define DI __device__ __forceinline__
typedef unsigned short bf16_t;
typedef short bf16x8 __attribute__((ext_vector_type(8)));
typedef short s16x4 __attribute__((ext_vector_type(4)));
typedef float f32x2 __attribute__((ext_vector_type(2)));
typedef float f32x4 __attribute__((ext_vector_type(4)));
typedef float f32x16 __attribute__((ext_vector_type(16)));
typedef unsigned u32x2 __attribute__((ext_vector_type(2)));
typedef unsigned u32x4 __attribute__((ext_vector_type(4)));
typedef __bf16 bf16x2n __attribute__((ext_vector_type(2)));

DI int otid() { int t = threadIdx.x; asm volatile("" : "+v"(t)); return t; }
DI int obid() { int b = blockIdx.x; asm volatile("" : "+s"(b)); return b; }
DI unsigned pk2(float lo, float hi) { f32x2 v = {lo, hi}; return __builtin_bit_cast(unsigned, __builtin_convertvector(v, bf16x2n)); }
DI float bflo(unsigned u) { return __uint_as_float(u << 16); }
DI float bfhi(unsigned u) { return __uint_as_float(u & 0xffff0000u); }
DI float bf2f(bf16_t b) { return __uint_as_float(((unsigned)b) << 16); }
DI bf16_t f2bf(float f) { return (bf16_t)(pk2(f, 0.f) & 0xffffu); }
DI float sigmoidf_(float x) { return __builtin_amdgcn_rcpf(1.f + __expf(-x)); }
DI float wave_sum(float v) {
#pragma unroll
    for (int o = 1; o < 64; o <<= 1) v += __shfl_xor(v, o);
    return v;
}
#define MFMA32(a, b, c) __builtin_amdgcn_mfma_f32_32x32x16_bf16((a), (b), (c), 0, 0, 0)
DI bf16x8 pack8(float a0, float a1, float a2, float a3, float a4, float a5, float a6, float a7) {
    u32x4 p; p.x = pk2(a0, a1); p.y = pk2(a2, a3); p.z = pk2(a4, a5); p.w = pk2(a6, a7); return __builtin_bit_cast(bf16x8, p);
}
DI bf16x8 cat44(s16x4 lo, s16x4 hi) { return __builtin_shufflevector(lo, hi, 0, 1, 2, 3, 4, 5, 6, 7); }

constexpr int DM = 1024, DEPTH = 4, TC = 8192, TL = 16384, T = 24576, DFF = 2816, INW = 7168, NMODW = 9216;
constexpr int C_AQ = 0, C_AK = 512, C_AV = 640, C_WQ = 768, C_WK = 1280, C_WV = 1408, C_HQ = 1536, C_HFF = 2048, C_HFB = 2560, C_HI = 3072, C_HG = 3584, C_GA = 4096;
constexpr float EPS = 1e-6f, LOG2E = 1.4426950408889634f;
constexpr size_t O_X = 0, O_NKA = 25165824, O_NVA = 29360128, O_NKW = 33554432, O_NVW = 37748736, O_NST = 41943040;
constexpr size_t al256(size_t x) { return (x + 255) & ~(size_t)255; }
constexpr size_t WS_CTL = 0;
constexpr size_t WS_BAR = 4096;
constexpr size_t CTL_BYTES = 32768;
constexpr size_t WS_MOD = CTL_BYTES;
constexpr size_t WS_LB = WS_MOD + al256((size_t)DEPTH * 9 * NMODW * 4);
constexpr size_t WS_ROPE = WS_LB + 16384;
constexpr size_t WSZ = (size_t)(2 * 5632 * 1024 + 2 * 1024 * 2816 + 7168 * 1024 + 3 * 1024 * 512 + 1024 * 1024) * 2;
constexpr size_t WS_W = WS_ROPE + 8192;
constexpr size_t W_FI = 0;
constexpr size_t W_FO = W_FI + (size_t)2 * 5632 * 1024 * 2;
constexpr size_t W_IN = W_FO + (size_t)2 * 1024 * 2816 * 2;
constexpr size_t W_BR = W_IN + (size_t)7168 * 1024 * 2;
constexpr size_t W_OUT = W_BR + (size_t)3 * 1024 * 512 * 2;
constexpr size_t WS_XB = WS_W + WSZ;
constexpr size_t WS_HB = WS_XB + (size_t)T * 1024 * 2;
constexpr size_t WS_PROJ = WS_HB + (size_t)T * 1024 * 2;
constexpr size_t WS_OATT = WS_PROJ + (size_t)T * INW * 2;
constexpr size_t WS_OHG = WS_OATT + (size_t)T * 512 * 2;
constexpr size_t WS_OWIN = WS_OHG + (size_t)T * 512 * 2;
constexpr size_t WS_OF = WS_OWIN + (size_t)T * 512 * 2;
constexpr size_t WS_KAL = WS_OF + (size_t)2 * T * 512 * 4;
constexpr size_t SZ_KL = (size_t)8 * 2 * 2304 * 64 * 2, SZ_KC = (size_t)32 * 2 * 256 * 64 * 2;
constexpr size_t WS_VAL = WS_KAL + SZ_KL;
constexpr size_t WS_KWL = WS_VAL + SZ_KL;
constexpr size_t WS_VWL = WS_KWL + SZ_KL;
constexpr size_t WS_KAC = WS_VWL + SZ_KL;
constexpr size_t WS_VAC = WS_KAC + SZ_KC;
constexpr size_t WS_KWC = WS_VAC + SZ_KC;
constexpr size_t WS_VWC = WS_KWC + SZ_KC;
constexpr size_t WS_END = WS_VWC + SZ_KC;
constexpr int LDS_BYTES = 160 * 1024, LDS_MISC = 159 * 1024;
constexpr int NPH = 1 + 13 * DEPTH + 1;

struct Args { const float* in[22]; float* out; unsigned char* ws; int ph_lo, ph_hi; };

namespace pg8 {
#define PG8_LAS __attribute__((address_space(3)))
typedef unsigned short bf16_t;
typedef short bf16x8 __attribute__((ext_vector_type(8)));
typedef float f32x4 __attribute__((ext_vector_type(4)));
typedef unsigned u32x4 __attribute__((ext_vector_type(4)));
constexpr int BM = 256, BK = 64, HALF = 128, HTB = HALF * BK * 2  , STAGE_BYTES = 8 * HTB, NXCD = 8, WGM = 8;

__host__ __device__ __forceinline__ int lds_byte(int r, int c) { const int st = (r >> 4) * 2 + (c >> 5), rr = r & 15, cc = c & 31, ob = rr * 64 + cc * 2; return st * 1024 + (ob ^ (((ob >> 9) & 1) << 5)); }
__host__ __device__ __forceinline__ void stage_rc(int b, int& R, int& C) { const int st = b / 1024, sb = b % 1024, swz = sb ^ (((sb >> 9) & 1) << 5); R = (st >> 1) * 16 + swz / 64; C = (st & 1) * 32 + (swz % 64) / 2; }
__host__ __device__ __forceinline__ int perm32(int rho) { const int n = rho >> 4, i = rho & 15; return 8 * (i >> 2) + 4 * n + (i & 3); }

struct Unit { int pm, pn; };
struct Gemm { const bf16_t* A; const bf16_t* Bt; int M, N, K; };

struct StaticOrder {
    int nM, nN, nwg, G, c;
    __host__ __device__ void init(int M, int N, int G_, int c_) { nM = M / BM; nN = N / BM; nwg = nM * nN; G = G_; c = c_; }
    __host__ __device__ bool next(int i, Unit& u) const {
        const long L = (long)i * G + c; if (L >= nwg) return false;
        int wgid = (int)L; { const int q = nwg / NXCD, r = nwg % NXCD, xcd = wgid % NXCD, off = wgid / NXCD; wgid = (xcd < r ? xcd * (q + 1) : r * (q + 1) + (xcd - r) * q) + off; }
        const int nig = WGM * nN, gid = wgid / nig, fm = gid * WGM, gsz = (nM - fm) < WGM ? (nM - fm) : WGM;
        u.pm = fm + ((wgid % nig) % gsz); u.pn = (wgid % nig) / gsz; return true;
    }
    __device__ __forceinline__ void a_ready(const Unit&) const {}
    __device__ __forceinline__ void done(const Unit&) const {}
};
struct EpiBf16P {
    static constexpr bool PERM = true, AFTER_DRAIN = false;
    bf16_t* O; int ldc;
    __device__ __forceinline__ void operator()(const f32x4 (&acc)[2][2][4][2], const Unit& u, int wr, int wc, int fr, int fq) const {
        const int row0 = u.pm * BM + wr * 64 + fr, col0 = u.pn * BM + wc * 32 + 8 * fq;
#pragma unroll
        for (int ai = 0; ai < 2; ++ai)
#pragma unroll
            for (int m = 0; m < 4; ++m) { bf16_t* rowp = O + (size_t)(row0 + ai * HALF + m * 16) * ldc + col0;
#pragma unroll
                for (int bj = 0; bj < 2; ++bj) { const f32x4 v0 = acc[ai][bj][m][0], v1 = acc[ai][bj][m][1];
                    u32x4 w; w.x = pk2(v0[0], v0[1]); w.y = pk2(v0[2], v0[3]); w.z = pk2(v1[0], v1[1]); w.w = pk2(v1[2], v1[3]);
                    *(u32x4*)(rowp + bj * HALF) = w; } }
    }
};
struct EpiSwiglu {
    static constexpr bool PERM = true, AFTER_DRAIN = false;
    bf16_t* O;
    __device__ __forceinline__ void operator()(const f32x4 (&acc)[2][2][4][2], const Unit& u, int wr, int wc, int fr, int fq) const {
        const int row0 = u.pm * BM + wr * 64 + fr, col0 = u.pn * HALF + wc * 32 + 8 * fq;
#pragma unroll
        for (int ai = 0; ai < 2; ++ai)
#pragma unroll
            for (int m = 0; m < 4; ++m) { bf16_t* rowp = O + (size_t)(row0 + ai * HALF + m * 16) * DFF + col0;
                float r[8];
#pragma unroll
                for (int n = 0; n < 2; ++n)
#pragma unroll
                    for (int j = 0; j < 4; ++j) { const float g = acc[ai][0][m][n][j], up = acc[ai][1][m][n][j]; r[4 * n + j] = g * __builtin_amdgcn_rcpf(1.f + __expf(-g)) * up; }
                u32x4 w; w.x = pk2(r[0], r[1]); w.y = pk2(r[2], r[3]); w.z = pk2(r[4], r[5]); w.w = pk2(r[6], r[7]);
                *(u32x4*)rowp = w; }
    }
};
struct EpiResid {
    static constexpr bool PERM = true, AFTER_DRAIN = false;
    const float* in0; const float* in1; unsigned char* ws; float* out; int l_; int k_;
    __device__ __forceinline__ void operator()(const f32x4 (&acc)[2][2][4][2], const Unit& u, int wr, int wc, int fr, int fq) const {
        int l = __builtin_amdgcn_readfirstlane(l_), k = __builtin_amdgcn_readfirstlane(k_); asm volatile("" : "+s"(l), "+s"(k));
        const int mode = (k == 2 && l == 0) ? 1 : ((k == 12 && l == DEPTH - 1) ? 2 : 0);
        const float coef = k == 9 ? 1.0f : 0.5f; const float* mod = (const float*)(ws + WS_MOD) + (size_t)l * 9 * NMODW + (k == 2 ? 2 : (k == 9 ? 5 : 8)) * DM;
        bf16_t* xb = (bf16_t*)(ws + WS_XB);
        const int row0 = u.pm * BM + wr * 64 + fr, col0 = u.pn * BM + wc * 32 + 8 * fq;
        const int trow = u.pm * BM; const int cond = trow < TC ? 8 : ((trow - TC) >> 11);
        const float* mp = mod + (size_t)cond * NMODW;
        f32x4 g[2][2];
#pragma unroll
        for (int bj = 0; bj < 2; ++bj)
#pragma unroll
            for (int n = 0; n < 2; ++n) g[bj][n] = coef * *(const f32x4*)(mp + col0 + bj * HALF + 4 * n);
        if (mode == 1) {
            const float* bbase = trow < TC ? in0 + (size_t)row0 * DM : in1 + (size_t)(row0 - TC) * DM;
#pragma unroll
            for (int ai = 0; ai < 2; ++ai) {
                f32x4 bv[4][2][2];
#pragma unroll
                for (int m = 0; m < 4; ++m)
#pragma unroll
                    for (int bj = 0; bj < 2; ++bj)
#pragma unroll
                        for (int n = 0; n < 2; ++n) bv[m][bj][n] = *(const f32x4*)(bbase + (size_t)(ai * HALF + m * 16) * DM + col0 + bj * HALF + 4 * n);
#pragma unroll
                for (int m = 0; m < 4; ++m) { const size_t ro = (size_t)(row0 + ai * HALF + m * 16) * DM + col0;
#pragma unroll
                    for (int bj = 0; bj < 2; ++bj) {
                        const f32x4 x0 = bv[m][bj][0] + g[bj][0] * acc[ai][bj][m][0], x1 = bv[m][bj][1] + g[bj][1] * acc[ai][bj][m][1];
                        u32x4 w; w.x = pk2(x0[0], x0[1]); w.y = pk2(x0[2], x0[3]); w.z = pk2(x1[0], x1[1]); w.w = pk2(x1[2], x1[3]); *(u32x4*)(xb + ro + bj * HALF) = w; } }
            }
        } else {
#pragma unroll
            for (int ai = 0; ai < 2; ++ai) {
                u32x4 raw[4][2];
#pragma unroll
                for (int m = 0; m < 4; ++m)
#pragma unroll
                    for (int bj = 0; bj < 2; ++bj) raw[m][bj] = *(const u32x4*)(xb + (size_t)(row0 + ai * HALF + m * 16) * DM + col0 + bj * HALF);
#pragma unroll
                for (int m = 0; m < 4; ++m) { const size_t ro = (size_t)(row0 + ai * HALF + m * 16) * DM + col0;
#pragma unroll
                    for (int bj = 0; bj < 2; ++bj) { const u32x4 r = raw[m][bj];
                        const f32x4 x0 = (f32x4){bflo(r.x), bfhi(r.x), bflo(r.y), bfhi(r.y)} + g[bj][0] * acc[ai][bj][m][0], x1 = (f32x4){bflo(r.z), bfhi(r.z), bflo(r.w), bfhi(r.w)} + g[bj][1] * acc[ai][bj][m][1];
                        if (mode == 2) { *(f32x4*)(out + ro + bj * HALF) = x0; *(f32x4*)(out + ro + bj * HALF + 4) = x1; }
                        else { u32x4 w; w.x = pk2(x0[0], x0[1]); w.y = pk2(x0[2], x0[3]); w.z = pk2(x1[0], x1[1]); w.w = pk2(x1[2], x1[3]); *(u32x4*)(xb + ro + bj * HALF) = w; } } }
            }
        }
    }
};
struct EpiBranch {
    static constexpr bool PERM = true, AFTER_DRAIN = false;
    const bf16_t* gate; float* acc32; bf16_t* outbf; int mode;
    __device__ __forceinline__ void operator()(const f32x4 (&acc)[2][2][4][2], const Unit& u, int wr, int wc, int fr, int fq) const {
        const int row0 = u.pm * BM + wr * 64 + fr, col0 = u.pn * BM + wc * 32 + 8 * fq;
#pragma unroll
        for (int ai = 0; ai < 2; ++ai) {
            u32x4 gv[4][2], pv[4][2];
#pragma unroll
            for (int m = 0; m < 4; ++m)
#pragma unroll
                for (int bj = 0; bj < 2; ++bj) { const int row = row0 + ai * HALF + m * 16, c = col0 + bj * HALF;
                    gv[m][bj] = *(const u32x4*)(gate + (size_t)row * INW + c);
                    if (mode != 0) pv[m][bj] = *(const u32x4*)(outbf + (size_t)row * DM + c); else pv[m][bj] = (u32x4){0u, 0u, 0u, 0u}; }
#pragma unroll
            for (int m = 0; m < 4; ++m)
#pragma unroll
                for (int bj = 0; bj < 2; ++bj) { const int row = row0 + ai * HALF + m * 16, c = col0 + bj * HALF;
                    const u32x4 g = gv[m][bj], p = pv[m][bj];
                    float v[8];
                    v[0] = sigmoidf_(bflo(g.x)) * acc[ai][bj][m][0][0] + bflo(p.x); v[1] = sigmoidf_(bfhi(g.x)) * acc[ai][bj][m][0][1] + bfhi(p.x);
                    v[2] = sigmoidf_(bflo(g.y)) * acc[ai][bj][m][0][2] + bflo(p.y); v[3] = sigmoidf_(bfhi(g.y)) * acc[ai][bj][m][0][3] + bfhi(p.y);
                    v[4] = sigmoidf_(bflo(g.z)) * acc[ai][bj][m][1][0] + bflo(p.z); v[5] = sigmoidf_(bfhi(g.z)) * acc[ai][bj][m][1][1] + bfhi(p.z);
                    v[6] = sigmoidf_(bflo(g.w)) * acc[ai][bj][m][1][2] + bflo(p.w); v[7] = sigmoidf_(bfhi(g.w)) * acc[ai][bj][m][1][3] + bfhi(p.w);
                    u32x4 w; w.x = pk2(v[0], v[1]); w.y = pk2(v[2], v[3]); w.z = pk2(v[4], v[5]); w.w = pk2(v[6], v[7]);
                    *(u32x4*)(outbf + (size_t)row * DM + c) = w; }
        }
    }
};

template <class Epi, class Sched, bool STAMP = false>
__device__ __forceinline__ void gemm_phase(PG8_LAS unsigned char* lds, const Gemm g, const Sched& S, const Epi& E, unsigned long long* stamps) {
    const int tid = otid(), wid = __builtin_amdgcn_readfirstlane(tid >> 6), lane = tid & 63, wr = wid >> 2, wc = wid & 3, fr = lane & 15, fq = lane >> 4;
    const int K = g.K, nt = K / BK;
    int ts_lo = 0, ts_hi = 0, nts = 0; const unsigned long long rt_entry = STAMP ? (unsigned long long)wall_clock64() : 0ull;
#define PG8_STAMP() do { if (STAMP && wid == 0 && nts < 64) { const unsigned long long _c = (unsigned long long)clock64(); \
        ts_lo = (lane == nts) ? (int)(unsigned)_c : ts_lo; ts_hi = (lane == nts) ? (int)(unsigned)(_c >> 32) : ts_hi; ++nts; } } while (0)
    PG8_STAMP();
    unsigned voffA[2], voffB[2];
#pragma unroll
    for (int i = 0; i < 2; ++i) { int R, C; stage_rc(tid * 16 + i * 8192, R, C); const int Rb = Epi::PERM ? ((R & ~31) + perm32(R & 31)) : R;
        voffA[i] = (unsigned)(R * K + C) * 2u; voffB[i] = (unsigned)(Rb * K + C) * 2u; }
    const size_t kstep = (size_t)(BK * 2);
    const size_t hstep = (size_t)HALF * K * 2;
    const size_t tstep = 2 * hstep;
    const unsigned ldsw = (unsigned)wid * 1024u;
    const int aoff = lds_byte(wr * 64 + fr, fq * 8), boff = lds_byte(wc * 32 + fr, fq * 8);
#define PG8_SA(b, h) (((b) * 2 + (h)) * HTB)
#define PG8_SB(b, h) ((4 + (b) * 2 + (h)) * HTB)
#define PG8_STAGE(bufoff, gbase, voff) do { _Pragma("unroll") for (int _i = 0; _i < 2; ++_i) \
        __builtin_amdgcn_global_load_lds((const unsigned*)((const char*)(gbase) + (voff)[_i]), (PG8_LAS unsigned*)(lds + (bufoff) + ldsw + _i * 8192), 16, 0, 0); } while (0)
#define PG8_LDA(dst, b, h) do { _Pragma("unroll") for (int m = 0; m < 4; ++m) _Pragma("unroll") for (int k = 0; k < 2; ++k) dst[m][k] = *(const PG8_LAS bf16x8*)(lds + PG8_SA(b, h) + aoff + m * 2048 + k * 1024); } while (0)
#define PG8_LDB(dst, b, h) do { _Pragma("unroll") for (int n = 0; n < 2; ++n) _Pragma("unroll") for (int k = 0; k < 2; ++k) dst[n][k] = *(const PG8_LAS bf16x8*)(lds + PG8_SB(b, h) + boff + n * 2048 + k * 1024); } while (0)
#define PG8_MMA(ai, bj, At, Bt) do { __builtin_amdgcn_s_setprio(1); _Pragma("unroll") for (int m = 0; m < 4; ++m) _Pragma("unroll") for (int n = 0; n < 2; ++n) _Pragma("unroll") for (int k = 0; k < 2; ++k) \
        acc[ai][bj][m][n] = __builtin_amdgcn_mfma_f32_16x16x32_bf16(Bt[n][k], At[m][k], acc[ai][bj][m][n], 0, 0, 0); __builtin_amdgcn_s_setprio(0); } while (0)
#define PG8_WAIT_V(n) asm volatile("s_waitcnt vmcnt(" #n ")" ::: "memory")
#define PG8_WAIT_L(n) asm volatile("s_waitcnt lgkmcnt(" #n ")" ::: "memory")
#define PG8_BAR __builtin_amdgcn_s_barrier()
#define PG8_SCHED __builtin_amdgcn_sched_barrier(0)
    Unit cur, nxt; int ui = 0;
    if (!S.next(0, cur)) return;
    f32x4 acc[2][2][4][2];
#pragma unroll
    for (int a = 0; a < 2; ++a)
#pragma unroll
        for (int b = 0; b < 2; ++b)
#pragma unroll
            for (int m = 0; m < 4; ++m)
#pragma unroll
                for (int n = 0; n < 2; ++n) acc[a][b][m][n] = (f32x4){0.f, 0.f, 0.f, 0.f};
    bf16x8 At[4][2], B0[2][2], B1[2][2];
    const char* cA = (const char*)g.A + (size_t)cur.pm * tstep; const char* cB = (const char*)g.Bt + (size_t)cur.pn * tstep;
    S.a_ready(cur);
    PG8_STAGE(PG8_SB(0, 0), cB, voffB); PG8_STAGE(PG8_SA(0, 0), cA, voffA); PG8_STAGE(PG8_SB(0, 1), cB + hstep, voffB); PG8_STAGE(PG8_SA(0, 1), cA + hstep, voffA);
    if (wr == 1) PG8_BAR;
    PG8_WAIT_V(4); PG8_BAR;
    PG8_STAGE(PG8_SB(1, 0), cB + kstep, voffB); PG8_STAGE(PG8_SA(1, 0), cA + kstep, voffA); PG8_STAGE(PG8_SB(1, 1), cB + hstep + kstep, voffB);
    PG8_WAIT_V(6); PG8_BAR;
    PG8_STAMP();
    for (;;) {
        const bool has_next = S.next(ui + 1, nxt);
        const char* nA = has_next ? (const char*)g.A + (size_t)nxt.pm * tstep : cA; const char* nB = has_next ? (const char*)g.Bt + (size_t)nxt.pn * tstep : cB;
        for (int t = 0; t < nt; t += 2) {
            const bool last = (t == nt - 2);
            const char* a1 = cA + (size_t)(t + 1) * kstep;
            const char* a2 = last ? nA : cA + (size_t)(t + 2) * kstep; const char* b2 = last ? nB : cB + (size_t)(t + 2) * kstep;
            const char* a3 = a2 + kstep; const char* b3 = b2 + kstep;
            if (last && has_next) S.a_ready(nxt);
            PG8_LDB(B0, 0, 0); PG8_SCHED; PG8_LDA(At, 0, 0); PG8_STAGE(PG8_SA(1, 1), a1 + hstep, voffA);
            PG8_WAIT_L(8); PG8_BAR; PG8_WAIT_L(0); PG8_MMA(0, 0, At, B0); PG8_BAR; PG8_SCHED;
            PG8_LDB(B1, 0, 1); PG8_STAGE(PG8_SB(0, 0), b2, voffB);
            PG8_BAR; PG8_WAIT_L(0); PG8_MMA(0, 1, At, B1); PG8_BAR;
            PG8_LDA(At, 0, 1); PG8_STAGE(PG8_SA(0, 0), a2, voffA);
            PG8_BAR; PG8_WAIT_L(0); PG8_MMA(1, 0, At, B0); PG8_BAR; PG8_SCHED;
            PG8_STAGE(PG8_SB(0, 1), b2 + hstep, voffB);
            PG8_WAIT_V(6); PG8_BAR; PG8_MMA(1, 1, At, B1); PG8_BAR;
            PG8_LDB(B0, 1, 0); PG8_SCHED; PG8_LDA(At, 1, 0); PG8_STAGE(PG8_SA(0, 1), a2 + hstep, voffA);
            PG8_WAIT_L(8); PG8_BAR; PG8_WAIT_L(0); PG8_MMA(0, 0, At, B0); PG8_BAR; PG8_SCHED;
            PG8_LDB(B1, 1, 1); PG8_STAGE(PG8_SB(1, 0), b3, voffB);
            PG8_BAR; PG8_WAIT_L(0); PG8_MMA(0, 1, At, B1); PG8_BAR;
            PG8_LDA(At, 1, 1); PG8_STAGE(PG8_SA(1, 0), a3, voffA);
            PG8_BAR; PG8_WAIT_L(0); PG8_MMA(1, 0, At, B0); PG8_BAR; PG8_SCHED;
            PG8_STAGE(PG8_SB(1, 1), b3 + hstep, voffB);
            PG8_WAIT_V(6); PG8_BAR; PG8_MMA(1, 1, At, B1); PG8_BAR;
        }
        PG8_STAMP();
        if constexpr (!Epi::AFTER_DRAIN) { E(acc, cur, wr, wc, fr, fq); S.done(cur); }
        PG8_STAMP();
        if (!has_next) break;
#pragma unroll
        for (int a = 0; a < 2; ++a)
#pragma unroll
            for (int b = 0; b < 2; ++b)
#pragma unroll
                for (int m = 0; m < 4; ++m)
#pragma unroll
                    for (int n = 0; n < 2; ++n) acc[a][b][m][n] = (f32x4){0.f, 0.f, 0.f, 0.f};
        cur = nxt; cA = nA; cB = nB; ++ui;
    }
    PG8_WAIT_V(0);
    if (wr == 0) PG8_BAR;
    PG8_BAR;
    if constexpr (Epi::AFTER_DRAIN) { E.fused(acc, cur, wr, wc, fr, fq, lds, wid, lane); S.done(cur); }
    PG8_STAMP();
    if (STAMP && wid == 0) { stamps[lane] = lane < nts ? (((unsigned long long)(unsigned)ts_hi << 32) | (unsigned)ts_lo) : 0ull;
        if (lane == 62) stamps[62] = rt_entry; if (lane == 63) stamps[63] = (unsigned long long)wall_clock64(); }
#undef PG8_STAMP
#undef PG8_SA
#undef PG8_SB
#undef PG8_STAGE
#undef PG8_LDA
#undef PG8_LDB
#undef PG8_MMA
#undef PG8_WAIT_V
#undef PG8_WAIT_L
#undef PG8_BAR
#undef PG8_SCHED
}
}
DI int crow(int i, int h) { return (i & 3) + 8 * (i >> 2) + 4 * h; }
#define LDS_WAIT() asm volatile("s_waitcnt lgkmcnt(0)" ::: "memory")


DI void phase_p0(const Args& a, unsigned char* lds) {
    float* s = (float*)lds; float* red = (float*)(lds + 36864);
    const int tid = otid(), lane = tid & 63, w = tid >> 6;
    float* MOD = (float*)(a.ws + WS_MOD);
    if ((int)blockIdx.x < 144) {
        const float* c = a.in[7]; const float* cctx = a.in[8];
        for (int i = tid; i < 9 * 1024; i += 512) { const int ci = i >> 10, k = i & 1023; const float v = ci < 8 ? c[ci * 1024 + k] : cctx[k]; s[i] = v * sigmoidf_(v); }
        __syncthreads();
        for (int item = blockIdx.x; item < 144; item += gridDim.x) {
            const int l = item / 36, cc = item % 36;
            const float* W = a.in[9] + (size_t)l * 1024 * NMODW + cc * 256 + 4 * lane;
            f32x4 acc[9];
#pragma unroll
            for (int ci = 0; ci < 9; ++ci) acc[ci] = (f32x4){0.f, 0.f, 0.f, 0.f};
#pragma unroll 2
            for (int k4 = 0; k4 < 32; ++k4) {
                const int k = w * 128 + k4 * 4;
                const f32x4 w0 = *(const f32x4*)(W + (size_t)(k + 0) * NMODW), w1 = *(const f32x4*)(W + (size_t)(k + 1) * NMODW),
                            w2 = *(const f32x4*)(W + (size_t)(k + 2) * NMODW), w3 = *(const f32x4*)(W + (size_t)(k + 3) * NMODW);
#pragma unroll
                for (int ci = 0; ci < 9; ++ci) { const f32x4 sv = *(const f32x4*)(s + ci * 1024 + k); acc[ci] += sv[0] * w0 + sv[1] * w1 + sv[2] * w2 + sv[3] * w3; }
            }
#pragma unroll
            for (int ci = 0; ci < 9; ++ci) *(f32x4*)(red + ((w * 9 + ci) * 256 + 4 * lane)) = acc[ci];
            __syncthreads();
            for (int i = tid; i < 9 * 256; i += 512) { const int ci = i >> 8, col = i & 255; float v = 0.f;
#pragma unroll
                for (int ww = 0; ww < 8; ++ww) v += red[(ww * 9 + ci) * 256 + col];
                v += a.in[10][l * NMODW + cc * 256 + col];
                MOD[((size_t)l * 9 + ci) * NMODW + cc * 256 + col] = v; }
            __syncthreads();
        }
    }
    if (blockIdx.x == gridDim.x - 1) {
        float* LB = (float*)(a.ws + WS_LB); const float* lbin = a.in[16];
        for (int e = tid; e < 1024; e += 512) {
            const float x0 = lbin[e], x1 = lbin[1024 + e], x2 = lbin[2048 + e], x3 = lbin[3072 + e];
            const float mx = fmaxf(fmaxf(x0, x1), fmaxf(x2, x3));
            const float e0 = __expf(x0 - mx), e1 = __expf(x1 - mx), e2 = __expf(x2 - mx), e3 = __expf(x3 - mx); const float inv = 1.f / (e0 + e1 + e2 + e3);
            LB[e] = 0.f; LB[1024 + e] = e1 * inv; LB[2048 + e] = (e1 + e2) * inv; LB[3072 + e] = (e1 + e2 + e3) * inv;
        }
        float* cosT = (float*)(a.ws + WS_ROPE); float* sinT = cosT + 1024;
        for (int e = tid; e < 1024; e += 512) { const int pos = e >> 4, i = e & 15; const float inv = exp2f(-(float)i * (13.287712379549449f / 16.f)); const float ang = (float)pos * inv;
            cosT[e] = cosf(ang); sinT[e] = sinf(ang); }
    }
}

DI void transpose_item(const float* W, int ldw, int srccol0, int k0, bf16_t* WT, int K, int dstrow0, float* scr, int lane) {
#pragma unroll 8
    for (int i = 0; i < 32; ++i) { const int kk = 2 * i + (lane >> 5); scr[kk * 33 + (lane & 31)] = W[(size_t)(k0 + kk) * ldw + srccol0 + (lane & 31)]; }
    LDS_WAIT();
    const int c = lane & 7;
#pragma unroll
    for (int j = 0; j < 4; ++j) { const int n = (lane >> 3) + 8 * j; const float* sp = scr + (8 * c) * 33 + n;
        u32x4 o; o.x = pk2(sp[0 * 33], sp[1 * 33]); o.y = pk2(sp[2 * 33], sp[3 * 33]); o.z = pk2(sp[4 * 33], sp[5 * 33]); o.w = pk2(sp[6 * 33], sp[7 * 33]);
        *(u32x4*)(WT + (size_t)(dstrow0 + n) * K + k0 + 8 * c) = o; }
    LDS_WAIT();
}
DI void phase_wconv(const Args& a, unsigned char* lds, int l, int it0, int it1, int rank, int nrank) {
    const int tid = otid(), lane = tid & 63, w = tid >> 6;
    float* scr = (float*)(lds + w * 8448);
    unsigned char* wb = a.ws + WS_W;
    for (int it = it0 + rank * 8 + w; it < it1; it += nrank * 8) {
        int r = it;
        if (r < 5632) { const int j = r / 2816; r -= j * 2816; const int kb = r / 176, nb = r % 176, n0 = 32 * nb, pn = n0 >> 8, loc = n0 & 255;
            const int src = (loc >> 7) * DFF + 128 * pn + (loc & 127);
            transpose_item(a.in[12] + (size_t)(l * 2 + j) * 1024 * 5632, 5632, src, 64 * kb, (bf16_t*)(wb + W_FI) + (size_t)j * 5632 * 1024, 1024, n0, scr, lane); continue; }
        r -= 5632;
        if (r < 2816) { const int j = r / 1408; r -= j * 1408; const int kb = r / 32, nb = r % 32;
            transpose_item(a.in[13] + (size_t)(l * 2 + j) * DFF * 1024, 1024, 32 * nb, 64 * kb, (bf16_t*)(wb + W_FO) + (size_t)j * 1024 * DFF, DFF, 32 * nb, scr, lane); continue; }
        r -= 2816;
        if (r < 3584) { const int kb = r / 224, nb = r % 224;
            transpose_item(a.in[14] + (size_t)l * 1024 * INW, INW, 32 * nb, 64 * kb, (bf16_t*)(wb + W_IN), 1024, 32 * nb, scr, lane); continue; }
        r -= 3584;
        if (r < 768) { const int k = r / 256; r -= k * 256; const int kb = r / 32, nb = r % 32;
            transpose_item(a.in[19] + (size_t)(l * 3 + k) * 512 * 1024, 1024, 32 * nb, 64 * kb, (bf16_t*)(wb + W_BR) + (size_t)k * 1024 * 512, 512, 32 * nb, scr, lane); continue; }
        r -= 768;
        { const int kb = r / 32, nb = r % 32;
            transpose_item(a.in[20] + (size_t)l * 1024 * 1024, 1024, 32 * nb, 64 * kb, (bf16_t*)(wb + W_OUT), 1024, 32 * nb, scr, lane); }
    }
}

DI void phase_norm(const Args& a, int l, int j, bool first) {
    const int tid = otid(), lane = tid & 63, w = tid >> 6;
    const int gw = obid() * 8 + w, NGW = gridDim.x * 8;
    const float* g = a.in[11] + (size_t)(l * 3 + j) * DM; const float* MOD = (const float*)(a.ws + WS_MOD) + (size_t)l * 9 * NMODW;
    bf16_t* HB = (bf16_t*)(a.ws + WS_HB);
    if (first) {
        f32x4 gg[4];
#pragma unroll
        for (int jj = 0; jj < 4; ++jj) gg[jj] = *(const f32x4*)(g + 4 * lane + 256 * jj);
        for (int row = gw; row < T; row += NGW) {
            const float* xr = row < TC ? a.in[0] + (size_t)row * DM : a.in[1] + (size_t)(row - TC) * DM;
            const int cond = row < TC ? 8 : ((row - TC) >> 11);
            const float* shift = MOD + (size_t)cond * NMODW + 3 * j * DM; const float* scale = shift + DM;
            f32x4 v[4]; float ss = 0.f;
#pragma unroll
            for (int jj = 0; jj < 4; ++jj) { v[jj] = *(const f32x4*)(xr + 4 * lane + 256 * jj); ss += (v[jj][0] * v[jj][0] + v[jj][1] * v[jj][1]) + (v[jj][2] * v[jj][2] + v[jj][3] * v[jj][3]); }
            const float rstd = rsqrtf(wave_sum(ss) * (1.f / DM) + EPS);
#pragma unroll
            for (int jj = 0; jj < 4; ++jj) { const f32x4 sc = *(const f32x4*)(scale + 4 * lane + 256 * jj), sh = *(const f32x4*)(shift + 4 * lane + 256 * jj);
                const f32x4 y = v[jj] * rstd * gg[jj] * (1.f + sc) + sh;
                u32x2 o; o.x = pk2(y[0], y[1]); o.y = pk2(y[2], y[3]);
                *(u32x2*)(HB + (size_t)row * DM + 4 * lane + 256 * jj) = o; }
        }
    } else {
        const bf16_t* XB = (const bf16_t*)(a.ws + WS_XB);
        f32x4 gg[2][2];
#pragma unroll
        for (int jj = 0; jj < 2; ++jj) { gg[jj][0] = *(const f32x4*)(g + 8 * lane + 512 * jj); gg[jj][1] = *(const f32x4*)(g + 8 * lane + 512 * jj + 4); }
        const int per = (T + NGW - 1) / NGW;
        int ccur = -1; f32x4 gs[2][2], sh[2][2];
        for (int i = 0; i < per; ++i) {
            const int row = gw * per + i; if (row >= T) break;
            const int cond = row < TC ? 8 : ((row - TC) >> 11);
            if (cond != ccur) { ccur = cond;
                const float* shift = MOD + (size_t)cond * NMODW + 3 * j * DM; const float* scale = shift + DM;
#pragma unroll
                for (int jj = 0; jj < 2; ++jj)
#pragma unroll
                    for (int q = 0; q < 2; ++q) { gs[jj][q] = gg[jj][q] * (1.f + *(const f32x4*)(scale + 8 * lane + 512 * jj + 4 * q)); sh[jj][q] = *(const f32x4*)(shift + 8 * lane + 512 * jj + 4 * q); } }
            f32x4 v[2][2]; float ss = 0.f;
#pragma unroll
            for (int jj = 0; jj < 2; ++jj) { const u32x4 r = *(const u32x4*)(XB + (size_t)row * DM + 8 * lane + 512 * jj);
                v[jj][0] = (f32x4){bflo(r.x), bfhi(r.x), bflo(r.y), bfhi(r.y)}; v[jj][1] = (f32x4){bflo(r.z), bfhi(r.z), bflo(r.w), bfhi(r.w)};
#pragma unroll
                for (int q = 0; q < 2; ++q) ss += (v[jj][q][0] * v[jj][q][0] + v[jj][q][1] * v[jj][q][1]) + (v[jj][q][2] * v[jj][q][2] + v[jj][q][3] * v[jj][q][3]); }
            const float rstd = rsqrtf(wave_sum(ss) * (1.f / DM) + EPS);
#pragma unroll
            for (int jj = 0; jj < 2; ++jj) { const f32x4 y0 = v[jj][0] * rstd * gs[jj][0] + sh[jj][0], y1 = v[jj][1] * rstd * gs[jj][1] + sh[jj][1];
                u32x4 o; o.x = pk2(y0[0], y0[1]); o.y = pk2(y0[2], y0[3]); o.z = pk2(y1[0], y1[1]); o.w = pk2(y1[2], y1[3]);
                *(u32x4*)(HB + (size_t)row * DM + 8 * lane + 512 * jj) = o; }
        }
    }
}
DI void phase_final(const Args& a) {
    const int tid = otid(), lane = tid & 63, w = tid >> 6;
    const int gw = obid() * 8 + w, NGW = gridDim.x * 8;
    const float* g = a.in[21];
    f32x4 gg[4];
#pragma unroll
    for (int jj = 0; jj < 4; ++jj) gg[jj] = *(const f32x4*)(g + 4 * lane + 256 * jj);
    for (int row = gw; row < T; row += NGW) {
        float* xr = a.out + (size_t)row * DM;
        f32x4 v[4]; float ss = 0.f;
#pragma unroll
        for (int jj = 0; jj < 4; ++jj) { v[jj] = *(const f32x4*)(xr + 4 * lane + 256 * jj); ss += (v[jj][0] * v[jj][0] + v[jj][1] * v[jj][1]) + (v[jj][2] * v[jj][2] + v[jj][3] * v[jj][3]); }
        const float rstd = rsqrtf(wave_sum(ss) * (1.f / DM) + EPS);
#pragma unroll
        for (int jj = 0; jj < 4; ++jj) *(f32x4*)(xr + 4 * lane + 256 * jj) = v[jj] * rstd * gg[jj];
    }
}

DI void phase_prep(const Args& a, int l, bool dry) {
    const int tid = otid(), lane = tid & 63, w = tid >> 6;
    const int gw = obid() * 8 + w, NGW = gridDim.x * 8;
    bf16_t* PROJ = (bf16_t*)(a.ws + WS_PROJ);
    const float* cosT = (const float*)(a.ws + WS_ROPE); const float* sinT = cosT + 1024;
    const float qg = a.in[15][(l * 2 + 0) * 64 + lane], kg = a.in[15][(l * 2 + 1) * 64 + lane];
    bf16_t* KAL = (bf16_t*)(a.ws + WS_KAL); bf16_t* VAL = (bf16_t*)(a.ws + WS_VAL); bf16_t* KWL = (bf16_t*)(a.ws + WS_KWL); bf16_t* VWL = (bf16_t*)(a.ws + WS_VWL);
    bf16_t* KAC = (bf16_t*)(a.ws + WS_KAC); bf16_t* VAC = (bf16_t*)(a.ws + WS_VAC); bf16_t* KWC = (bf16_t*)(a.ws + WS_KWC); bf16_t* VWC = (bf16_t*)(a.ws + WS_VWC);
    for (int r = gw; r < T + 2048; r += NGW) {
        if (r < T) {
            const bool lat = r >= TC; int b, t;
            if (lat) { b = (r - TC) >> 11; t = (r - TC) & 2047; } else { b = r >> 8; t = r & 255; }
            float cs = 1.f, sn = 0.f;
            if (lat) { const int pos = (lane & 32) ? (t & 63) : (t >> 6); cs = cosT[pos * 16 + (lane & 15)]; sn = sinT[pos * 16 + (lane & 15)]; if (!(lane & 16)) sn = -sn; }
            bf16_t* pr = PROJ + (size_t)r * INW;
            bf16_t raw[24];
#pragma unroll
            for (int hh = 0; hh < 24; ++hh) raw[hh] = pr[64 * hh + lane];
#pragma unroll
            for (int h = 0; h < 8; ++h) {
                const float x = bf2f(raw[h]); const float ss = wave_sum(x * x);
                float y = x * rsqrtf(ss * (1.f / 64.f) + EPS) * qg;
                if (lat) { const float p = __shfl_xor(y, 16); y = y * cs + p * sn; }
                if (!dry) pr[C_AQ + 64 * h + lane] = f2bf(y * (0.125f * LOG2E));
            }
#pragma unroll
            for (int h = 0; h < 8; ++h) {
                float y = bf2f(raw[12 + h]);
                if (lat) { const float p = __shfl_xor(y, 16); y = y * cs + p * sn; }
                if (!dry) pr[C_WQ + 64 * h + lane] = f2bf(y * (0.125f * LOG2E));
            }
#pragma unroll
            for (int g2 = 0; g2 < 2; ++g2) {
                const float x = bf2f(raw[8 + g2]); const float ss = wave_sum(x * x);
                float y = x * rsqrtf(ss * (1.f / 64.f) + EPS) * kg;
                if (lat) { const float p = __shfl_xor(y, 16); y = y * cs + p * sn; }
                const bf16_t vbits = raw[10 + g2];
                float yw = bf2f(raw[20 + g2]);
                if (lat) { const float p = __shfl_xor(yw, 16); yw = yw * cs + p * sn; }
                const bf16_t wvbits = raw[22 + g2];
                if (lat) {
                    KAL[((size_t)(b * 2 + g2) * 2304 + 256 + t) * 64 + lane] = f2bf(y);
                    VAL[((size_t)(b * 2 + g2) * 64 + lane) * 2304 + 256 + t] = vbits;
                    KWL[((size_t)(b * 2 + g2) * 2304 + 256 + t) * 64 + lane] = f2bf(yw);
                    VWL[((size_t)(b * 2 + g2) * 64 + lane) * 2304 + 256 + t] = wvbits;
                } else {
                    KAC[((size_t)(b * 2 + g2) * 256 + t) * 64 + lane] = f2bf(y);
                    VAC[((size_t)(b * 2 + g2) * 64 + lane) * 256 + t] = vbits;
                    KWC[((size_t)(b * 2 + g2) * 256 + t) * 64 + lane] = f2bf(yw);
                    VWC[((size_t)(b * 2 + g2) * 64 + lane) * 256 + t] = wvbits;
                    const size_t oi = ((((size_t)b * DEPTH + l) * 256 + t) * 2 + g2) * 64 + lane;
                    a.out[O_NKA + oi] = y; a.out[O_NVA + oi] = bf2f(vbits); a.out[O_NKW + oi] = yw; a.out[O_NVW + oi] = bf2f(wvbits);
                }
            }
        } else {
            const int idx = r - T, b = idx >> 8, p = idx & 255;
#pragma unroll
            for (int g2 = 0; g2 < 2; ++g2) {
                const size_t ci = ((((size_t)b * DEPTH + l) * 256 + p) * 2 + g2) * 64 + lane;
                KAL[((size_t)(b * 2 + g2) * 2304 + p) * 64 + lane] = f2bf(a.in[2][ci]);
                VAL[((size_t)(b * 2 + g2) * 64 + lane) * 2304 + p] = f2bf(a.in[3][ci]);
                KWL[((size_t)(b * 2 + g2) * 2304 + p) * 64 + lane] = f2bf(a.in[4][ci]);
                VWL[((size_t)(b * 2 + g2) * 64 + lane) * 2304 + p] = f2bf(a.in[5][ci]);
            }
        }
    }
}

DI void attn_item(unsigned char* lds, const bf16_t* qp, bf16_t* op, const bf16_t* Kb, const bf16_t* VTb, int nk, int nA, int lo, int hi, bool win, int tq, bool has_sink, float sink2, bool nomax) {
    const int tid = otid(), lane = tid & 63, h = lane >> 5, c = lane & 31;
    const int n64 = nA + (hi - lo), nit = (n64 + 1) >> 1;
    constexpr int STG = 17664;
    bf16_t* Kst0 = (bf16_t*)lds; bf16_t* Vst0 = (bf16_t*)lds + 9216;
    int qoff = (tid >> 6) * 2048 + lane * 8;
    bf16_t* qpark = (bf16_t*)lds + 2 * STG;
#pragma unroll
    for (int s = 0; s < 4; ++s) *(bf16x8*)(qpark + qoff + s * 512) = *(const bf16x8*)(qp + 16 * s + 8 * h);
    f32x16 O0, O1;
#pragma unroll
    for (int i = 0; i < 16; ++i) { O0[i] = 0.f; O1[i] = 0.f; }
    float m = 0.f, lsum = 0.f;
    const int lrow = tid >> 3, lch = tid & 7;
    u32x4 kR, vR;
#define AT_KEY0(j) (((j) < nA ? (j) : 4 + lo + ((j) - nA)) * 64)
#define AT_LOAD(it, sub) do { const int j_ = (2 * (it) + (sub) < n64) ? 2 * (it) + (sub) : 2 * (it); const int k_ = AT_KEY0(j_); \
        kR = *(const u32x4*)(Kb + (size_t)(k_ + lrow) * 64 + 8 * lch); vR = *(const u32x4*)(VTb + (size_t)lrow * nk + k_ + 8 * lch); } while (0)
#define AT_STORE(stg, sub) do { bf16_t* kd_ = Kst0 + (stg) * STG; bf16_t* vd_ = Vst0 + (stg) * STG; \
        *(u32x4*)(kd_ + (64 * (sub) + lrow) * 72 + 8 * lch) = kR; \
        *(u32x2*)(vd_ + lrow * 132 + 64 * (sub) + 8 * lch) = (u32x2){vR.x, vR.y}; *(u32x2*)(vd_ + lrow * 132 + 64 * (sub) + 8 * lch + 4) = (u32x2){vR.z, vR.w}; } while (0)
    AT_LOAD(0, 0); AT_STORE(0, 0); AT_LOAD(0, 1); AT_STORE(0, 1);
    __syncthreads();
    for (int i = 0; i < nit; ++i) {
        const int cur = i & 1;
        if (i + 1 < nit) AT_LOAD(i + 1, 0);
        const bf16_t* Kc = Kst0 + cur * STG; const bf16_t* Vc = Vst0 + cur * STG;
        f32x16 st[4];
        const float cinit = -m;
#pragma unroll
        for (int t = 0; t < 4; ++t)
#pragma unroll
            for (int ii = 0; ii < 16; ++ii) st[t][ii] = cinit;
        asm volatile("" : "+v"(qoff));
#pragma unroll
        for (int s = 0; s < 4; ++s) { const bf16x8 qv = *(const bf16x8*)(qpark + qoff + s * 512);
#pragma unroll
            for (int t = 0; t < 4; ++t) { const bf16x8 ak = *(const bf16x8*)(Kc + (32 * t + c) * 72 + 16 * s + 8 * h); st[t] = MFMA32(ak, qv, st[t]); } }
        float ps = 0.f;
        if (nomax) {
#pragma unroll
            for (int t = 0; t < 4; ++t)
#pragma unroll
                for (int ii = 0; ii < 16; ++ii) { const float p = __builtin_amdgcn_exp2f(st[t][ii]); st[t][ii] = p; ps += p; }
            lsum += ps;
        } else {
            const int ja = 2 * i, jb = 2 * i + 1;
            if (win && ja >= nA) { const int k0 = AT_KEY0(ja);
#pragma unroll
                for (int t = 0; t < 2; ++t)
#pragma unroll
                    for (int ii = 0; ii < 16; ++ii) { const int dd = tq - (k0 - 256 + 32 * t + crow(ii, h)); if (dd > 128 || dd < -128) st[t][ii] = -1e30f; } }
            if (jb >= n64) {
#pragma unroll
                for (int t = 2; t < 4; ++t)
#pragma unroll
                    for (int ii = 0; ii < 16; ++ii) st[t][ii] = -1e30f;
            } else if (win && jb >= nA) { const int k0 = AT_KEY0(jb);
#pragma unroll
                for (int t = 2; t < 4; ++t)
#pragma unroll
                    for (int ii = 0; ii < 16; ++ii) { const int dd = tq - (k0 - 256 + 32 * (t - 2) + crow(ii, h)); if (dd > 128 || dd < -128) st[t][ii] = -1e30f; } }
            float mx = -1e30f;
#pragma unroll
            for (int ii = 0; ii < 16; ++ii) mx = fmaxf(mx, fmaxf(fmaxf(st[0][ii], st[1][ii]), fmaxf(st[2][ii], st[3][ii])));
            mx = fmaxf(mx, __shfl_xor(mx, 32));
            if (i == 0) {
                const float mnew = has_sink ? fmaxf(mx, sink2) : mx;
#pragma unroll
                for (int t = 0; t < 4; ++t)
#pragma unroll
                    for (int ii = 0; ii < 16; ++ii) { const float p = __builtin_amdgcn_exp2f(st[t][ii] - mnew); st[t][ii] = p; ps += p; }
                lsum = ps + ((has_sink && h == 0) ? __builtin_amdgcn_exp2f(sink2 - mnew) : 0.f);
                m = mnew;
            } else if (__builtin_amdgcn_ballot_w64(mx > 0.f) != 0ull) {
                const float delta = fmaxf(mx, 0.f); const float alpha = __builtin_amdgcn_exp2f(-delta); m += delta;
#pragma unroll
                for (int t = 0; t < 4; ++t)
#pragma unroll
                    for (int ii = 0; ii < 16; ++ii) { const float p = __builtin_amdgcn_exp2f(st[t][ii] - delta); st[t][ii] = p; ps += p; }
                lsum = lsum * alpha + ps;
#pragma unroll
                for (int ii = 0; ii < 16; ++ii) { O0[ii] *= alpha; O1[ii] *= alpha; }
            } else {
#pragma unroll
                for (int t = 0; t < 4; ++t)
#pragma unroll
                    for (int ii = 0; ii < 16; ++ii) { const float p = __builtin_amdgcn_exp2f(st[t][ii]); st[t][ii] = p; ps += p; }
                lsum += ps;
            }
        }
        if (i + 1 < nit) { AT_STORE(cur ^ 1, 0); AT_LOAD(i + 1, 1); }
#pragma unroll
        for (int t = 0; t < 4; ++t)
#pragma unroll
            for (int s2 = 0; s2 < 2; ++s2) {
                const bf16x8 pb = pack8(st[t][8 * s2], st[t][8 * s2 + 1], st[t][8 * s2 + 2], st[t][8 * s2 + 3], st[t][8 * s2 + 4], st[t][8 * s2 + 5], st[t][8 * s2 + 6], st[t][8 * s2 + 7]);
                const bf16_t* v0p = Vc + c * 132 + 32 * t + 16 * s2 + 4 * h; const bf16_t* v1p = Vc + (32 + c) * 132 + 32 * t + 16 * s2 + 4 * h;
                O0 = MFMA32(cat44(*(const s16x4*)(v0p), *(const s16x4*)(v0p + 8)), pb, O0);
                O1 = MFMA32(cat44(*(const s16x4*)(v1p), *(const s16x4*)(v1p + 8)), pb, O1);
            }
        if (i + 1 < nit) AT_STORE(cur ^ 1, 1);
        __syncthreads();
    }
#undef AT_KEY0
#undef AT_LOAD
#undef AT_STORE
    lsum += __shfl_xor(lsum, 32);
    const float inv = 1.f / lsum;
#pragma unroll
    for (int g4 = 0; g4 < 4; ++g4) {
        u32x2 w0, w1;
        w0.x = pk2(O0[4 * g4] * inv, O0[4 * g4 + 1] * inv); w0.y = pk2(O0[4 * g4 + 2] * inv, O0[4 * g4 + 3] * inv);
        w1.x = pk2(O1[4 * g4] * inv, O1[4 * g4 + 1] * inv); w1.y = pk2(O1[4 * g4 + 2] * inv, O1[4 * g4 + 3] * inv);
        *(u32x2*)(op + 8 * g4 + 4 * h) = w0; *(u32x2*)(op + 32 + 8 * g4 + 4 * h) = w1;
    }
}
#define LAS __attribute__((address_space(3)))
#define XB_TMO      128
#define XB_XCNT(j)  (256  + 64 * (j))
#define XB_XSUB(j)  (1280 + 64 * (j))
#define XB_XGEN(j)  (2304 + 64 * (j))
#define XB_TOP      3328
#define XB_TOPGEN   3392
#define XCD_BAR_WORDS 3456
#define XB_SPIN_CAP (1u << 18)

__device__ __forceinline__ unsigned xb_ld(unsigned* p)              { return __hip_atomic_load(p, __ATOMIC_RELAXED, __HIP_MEMORY_SCOPE_AGENT); }
__device__ __forceinline__ unsigned xb_add(unsigned* p, unsigned v) { return __hip_atomic_fetch_add(p, v, __ATOMIC_RELAXED, __HIP_MEMORY_SCOPE_AGENT); }
__device__ __forceinline__ unsigned xb_xcc_id() { return (unsigned)__builtin_amdgcn_s_getreg((3 << 11) | 20) & 0xFu; }
#define XB_SPIN(cond, bar) do { unsigned _sp = 0; while (cond) { __builtin_amdgcn_s_sleep(1); \
    if ((++_sp & 255u) == 0u) { if (xb_ld(&(bar)[XB_TMO])) break; if (_sp > XB_SPIN_CAP) { atomicAdd(&(bar)[XB_TMO], 1u); break; } } } } while (0)

struct XcdBarrier {
    unsigned* bar; unsigned x;
    volatile LAS unsigned* st;
};

__device__ __forceinline__ XcdBarrier xcd_barrier_post(unsigned* bar, volatile LAS unsigned* st) {
    XcdBarrier b; b.bar = bar; b.x = xb_xcc_id(); b.st = st;
    if (threadIdx.x == 0) (void)xb_add(&bar[XB_XCNT(b.x)], 1u);
    return b;
}
__device__ __forceinline__ void xcd_barrier_complete(unsigned* bar, unsigned x, unsigned& nloc, unsigned& nx) {
    const unsigned G = gridDim.x * gridDim.y * gridDim.z;
    unsigned sum, cnt, mine, sp = 0u;
    for (;;) {
        sum = 0u; cnt = 0u; mine = 0u;
#pragma unroll
        for (unsigned j = 0; j < 16; ++j) { const unsigned c = xb_ld(&bar[XB_XCNT(j)]); sum += c; cnt += (c > 0u) ? 1u : 0u; mine = (j == x) ? c : mine; }
        if (sum == G) break;
        __builtin_amdgcn_s_sleep(1);
        if ((++sp & 255u) == 0u) { if (xb_ld(&bar[XB_TMO])) break; if (sp > XB_SPIN_CAP) { atomicAdd(&bar[XB_TMO], 1u); break; } }
    }
    nloc = mine > 0u ? mine : 1u; nx = cnt > 0u ? cnt : 1u;
}

__device__ __forceinline__ void xcd_barrier(const XcdBarrier& b) {
    asm volatile("s_waitcnt vmcnt(0)" ::: "memory");
    __syncthreads();
    if (threadIdx.x == 0) {
        unsigned* bar = b.bar;
        __builtin_amdgcn_s_waitcnt(0);
        unsigned nloc = b.st[0], nx = b.st[1];
        if (nloc == 0u) { xcd_barrier_complete(bar, b.x, nloc, nx); b.st[0] = nloc; b.st[1] = nx; }
        const unsigned old = xb_add(&bar[XB_XSUB(b.x)], 1u);
        const unsigned gen = old / nloc;
        if (old + 1u == (gen + 1u) * nloc) {
            __builtin_amdgcn_fence(__ATOMIC_RELEASE, "agent");
            asm volatile("s_waitcnt vmcnt(0)" ::: "memory");
            const unsigned og = xb_add(&bar[XB_TOP], 1u);
            const unsigned tg = og / nx;
            if (og + 1u == (tg + 1u) * nx) xb_add(&bar[XB_TOPGEN], 1u);
            else XB_SPIN(xb_ld(&bar[XB_TOPGEN]) == tg, bar);
            __builtin_amdgcn_fence(__ATOMIC_ACQUIRE, "agent");
            xb_add(&bar[XB_XGEN(b.x)], 1u);
            asm volatile("s_waitcnt vmcnt(0)" ::: "memory");
        } else {
            XB_SPIN(xb_ld(&bar[XB_XGEN(b.x)]) == gen, bar);
            __builtin_amdgcn_fence(__ATOMIC_ACQUIRE, "agent");
            asm volatile("s_waitcnt vmcnt(0)" ::: "memory");
        }
    }
    __syncthreads();
}


DI void hgrn_item(const Args& a, unsigned char* lds, int l, int seq, int hd, int dir) {
    const int tid = otid(), lane = tid & 63, w = tid >> 6, h = lane >> 5, c = lane & 31;
    const bool lat = seq < 8; const int b = lat ? seq : seq - 8; const int L = lat ? 2048 : 256; const int nch = L >> 5; const int seqbase = lat ? TC + b * 2048 : b * 256;
    bf16_t* RQ = (bf16_t*)lds; bf16_t* RZ = (bf16_t*)(lds + 8704); bf16_t* RV = (bf16_t*)(lds + 17408);
    bf16_t* QS = (bf16_t*)(lds + 26112); bf16_t* KS = (bf16_t*)(lds + 34816);
    bf16_t* KST = (bf16_t*)(lds + 43520); bf16_t* VT = (bf16_t*)(lds + 53760); float* E0 = (float*)(lds + 64000); float* E1 = E0 + 128;
    const bf16_t* PROJ = (const bf16_t*)(a.ws + WS_PROJ);
    bf16_t* OF = (bf16_t*)(a.ws + WS_OF);
    const int cq = C_HQ + 128 * hd, cz = (dir ? C_HFB : C_HFF) + 128 * hd, cv = C_HI + 128 * hd;
    const int wd = w & 3;
    const int dmy = 32 * wd + c;
    const int t0 = 16 * (w >> 2) + 8 * h;
    f32x16 S[4];
    if (w < 4) {
        if (lat) { const float* sp = a.in[6] + ((((size_t)(b * DEPTH + l) * 2 + dir) * 4 + hd) * 128) * 128;
#pragma unroll
            for (int dt = 0; dt < 4; ++dt)
#pragma unroll
                for (int ii = 0; ii < 16; ++ii) S[dt][ii] = sp[(size_t)(32 * dt + crow(ii, h)) * 128 + dmy];
        } else {
#pragma unroll
            for (int dt = 0; dt < 4; ++dt)
#pragma unroll
                for (int ii = 0; ii < 16; ++ii) S[dt][ii] = 0.f;
        }
    }
    const float lbv = ((const float*)(a.ws + WS_LB))[(l * 2 + dir) * 512 + 128 * hd + dmy];
    const float omlb = 1.f - lbv;
    u32x4 rq, rz, rv;
    const int lt = tid >> 4, lcn = tid & 15;
#define HG_GLOAD(ch) do { const int p_ = 32 * (ch) + lt, pos_ = dir ? L - 1 - p_ : p_; const bf16_t* rp_ = PROJ + (size_t)(seqbase + pos_) * INW + 8 * lcn; \
        rq = *(const u32x4*)(rp_ + cq); rz = *(const u32x4*)(rp_ + cz); rv = *(const u32x4*)(rp_ + cv); } while (0)
    HG_GLOAD(0);
    for (int ch = 0; ch < nch; ++ch) {
        *(u32x4*)(RQ + lt * 136 + 8 * lcn) = rq; *(u32x4*)(RZ + lt * 136 + 8 * lcn) = rz; *(u32x4*)(RV + lt * 136 + 8 * lcn) = rv;
        __syncthreads();
        if (ch + 1 < nch) HG_GLOAD(ch + 1);
        {
            float qv[8], kv[8], gv[8]; float qtot = 0.f;
#pragma unroll
            for (int tt = 0; tt < 8; ++tt) { const int t = t0 + tt; const float qr = bf2f(RQ[t * 136 + dmy]), z = bf2f(RZ[t * 136 + dmy]);
                const float sg = sigmoidf_(z); const float f = lbv + omlb * sg; const float g = __logf(fmaxf(f, 1e-30f));
                kv[tt] = omlb * (1.f - sg); qv[tt] = qr * sigmoidf_(qr); gv[tt] = g; qtot += g; }
            const float partner = __shfl_xor(qtot, 32);
            float e[8];
            if (w < 4) { float run = h ? 0.f : -partner;
#pragma unroll
                for (int tt = 7; tt >= 0; --tt) { e[tt] = run; run -= gv[tt]; }
                if (h == 0) E0[dmy] = __expf(qtot + partner);
            } else { float run = h ? partner : 0.f;
#pragma unroll
                for (int tt = 0; tt < 8; ++tt) { run += gv[tt]; e[tt] = run; }
                if (h == 0) E1[dmy] = __expf(qtot + partner);
            }
            float ke[8];
#pragma unroll
            for (int tt = 0; tt < 8; ++tt) { const int t = t0 + tt; const float ex = __expf(fminf(fmaxf(e[tt], -80.f), 80.f)), exn = __builtin_amdgcn_rcpf(ex);
                ke[tt] = kv[tt] * exn;
                QS[t * 136 + dmy] = f2bf(qv[tt] * ex); KS[t * 136 + dmy] = f2bf(ke[tt]); }
            *(bf16x8*)(KST + dmy * 40 + t0) = pack8(ke[0], ke[1], ke[2], ke[3], ke[4], ke[5], ke[6], ke[7]);
            bf16x8 v0;
#pragma unroll
            for (int tt = 0; tt < 8; ++tt) v0[tt] = (short)RV[(t0 + tt) * 136 + dmy];
            *(bf16x8*)(VT + dmy * 40 + t0) = v0;
        }
        __syncthreads();
        if (w < 4) {
            f32x16 st;
#pragma unroll
            for (int ii = 0; ii < 16; ++ii) st[ii] = 0.f;
#pragma unroll
            for (int s = 0; s < 8; ++s) { const bf16x8 ak = *(const bf16x8*)(KS + c * 136 + 16 * s + 8 * h), bq = *(const bf16x8*)(QS + c * 136 + 16 * s + 8 * h); st = MFMA32(ak, bq, st); }
#pragma unroll
            for (int ii = 0; ii < 16; ++ii) if (crow(ii, h) > c) st[ii] = 0.f;
            f32x16 o;
#pragma unroll
            for (int ii = 0; ii < 16; ++ii) o[ii] = 0.f;
#pragma unroll
            for (int s2 = 0; s2 < 2; ++s2) {
                const bf16x8 pb = pack8(st[8 * s2], st[8 * s2 + 1], st[8 * s2 + 2], st[8 * s2 + 3], st[8 * s2 + 4], st[8 * s2 + 5], st[8 * s2 + 6], st[8 * s2 + 7]);
                const bf16_t* vp = VT + dmy * 40 + 16 * s2 + 4 * h;
                o = MFMA32(cat44(*(const s16x4*)vp, *(const s16x4*)(vp + 8)), pb, o);
            }
#pragma unroll
            for (int dt = 0; dt < 4; ++dt) {
#pragma unroll
                for (int g4 = 0; g4 < 4; ++g4) { const f32x4 ev = *(const f32x4*)(E0 + 32 * dt + 8 * g4 + 4 * h);
                    S[dt][4 * g4] *= ev[0]; S[dt][4 * g4 + 1] *= ev[1]; S[dt][4 * g4 + 2] *= ev[2]; S[dt][4 * g4 + 3] *= ev[3]; }
#pragma unroll
                for (int s2 = 0; s2 < 2; ++s2) {
                    const bf16x8 xs = pack8(S[dt][8 * s2], S[dt][8 * s2 + 1], S[dt][8 * s2 + 2], S[dt][8 * s2 + 3], S[dt][8 * s2 + 4], S[dt][8 * s2 + 5], S[dt][8 * s2 + 6], S[dt][8 * s2 + 7]);
                    const bf16_t* qb = QS + c * 136 + 32 * dt + 16 * s2 + 4 * h;
                    o = MFMA32(xs, cat44(*(const s16x4*)qb, *(const s16x4*)(qb + 8)), o);
                }
            }
            {   const int p = 32 * ch + c, pos = dir ? L - 1 - p : p;
                bf16_t* op = OF + ((size_t)dir * T + seqbase + pos) * 512 + 128 * hd + 32 * wd;
#pragma unroll
                for (int g4 = 0; g4 < 4; ++g4) { u32x2 v; v.x = pk2(o[4 * g4], o[4 * g4 + 1]); v.y = pk2(o[4 * g4 + 2], o[4 * g4 + 3]); *(u32x2*)(op + 8 * g4 + 4 * h) = v; } }
#pragma unroll
            for (int dt = 0; dt < 4; ++dt) {
#pragma unroll
                for (int s2 = 0; s2 < 2; ++s2) { const bf16x8 ak = *(const bf16x8*)(KST + (32 * dt + c) * 40 + 16 * s2 + 8 * h), bv = *(const bf16x8*)(VT + dmy * 40 + 16 * s2 + 8 * h);
                    S[dt] = MFMA32(ak, bv, S[dt]); }
#pragma unroll
                for (int g4 = 0; g4 < 4; ++g4) { const f32x4 ev = *(const f32x4*)(E1 + 32 * dt + 8 * g4 + 4 * h);
                    S[dt][4 * g4] *= ev[0]; S[dt][4 * g4 + 1] *= ev[1]; S[dt][4 * g4 + 2] *= ev[2]; S[dt][4 * g4 + 3] *= ev[3]; }
            }
        }
    }
#undef HG_GLOAD
    if (!lat && w < 4) { float* sp = a.out + O_NST + ((((size_t)(b * DEPTH + l) * 2 + dir) * 4 + hd) * 128) * 128;
#pragma unroll
        for (int dt = 0; dt < 4; ++dt)
#pragma unroll
            for (int ii = 0; ii < 16; ++ii) sp[(size_t)(32 * dt + crow(ii, h)) * 128 + dmy] = S[dt][ii];
    }
}

DI void phase_mixer(const Args& a, unsigned char* lds, int l, int rep) {
    unsigned* ctl = (unsigned*)(a.ws + WS_CTL) + 16 * l + 8 * rep;
    volatile int* slot = (volatile int*)(lds + LDS_MISC);
    const int tid = otid(), lane = tid & 63, w = tid >> 6, c = lane & 31;
    bf16_t* PROJ = (bf16_t*)(a.ws + WS_PROJ);
    for (;;) {
        __syncthreads();
        if (tid == 0) *slot = (int)__hip_atomic_fetch_add(ctl, 1u, __ATOMIC_RELAXED, __HIP_MEMORY_SCOPE_AGENT);
        __syncthreads();
        const int it = *slot;
        if (it >= 1856) break;
#if PROBE_MASK & 16
        if (rep && !(it < 64 || (it >= 576 && it < 832))) continue;
#endif
#if PROBE_MASK & 32
        if (rep && (it < 64 || (it >= 576 && it < 832))) continue;
#endif
#ifndef NO_HG
        if (it < 64) { hgrn_item(a, lds, l, it >> 3, (it >> 1) & 3, it & 1); continue; }
        if (it >= 576 && it < 832) { const int idx = it - 576; hgrn_item(a, lds, l, 8 + (idx >> 3), (idx >> 1) & 3, idx & 1); continue; }
#endif
        int idx, kind;
        if (it < 576) { idx = it - 64; kind = 0; } else if (it < 1344) { idx = it - 832; kind = 1; } else if (it < 1600) { idx = it - 1344; kind = 2; } else { idx = it - 1600; kind = 3; }
        const bool lat = kind < 2, isw = kind & 1;
        int b, g, qb;
        if (lat) { b = idx >> 6; g = (idx >> 5) & 1; qb = idx & 31; } else { b = idx >> 3; g = (idx >> 2) & 1; qb = idx & 3; }
        const int r = w & 3, tq = 64 * qb + 32 * (w >> 2) + c;
        const int row = (lat ? TC + b * 2048 : b * 256) + tq;
        const bf16_t* qp = PROJ + (size_t)row * INW + (isw ? C_WQ : C_AQ) + (4 * g + r) * 64;
        bf16_t* op = (bf16_t*)(a.ws + (isw ? WS_OWIN : WS_OATT)) + (size_t)row * 512 + (4 * g + r) * 64;
        const bf16_t* Kb; const bf16_t* VTb; int nk;
        if (lat) { nk = 2304; Kb = (const bf16_t*)(a.ws + (isw ? WS_KWL : WS_KAL)) + (size_t)(b * 2 + g) * 2304 * 64; VTb = (const bf16_t*)(a.ws + (isw ? WS_VWL : WS_VAL)) + (size_t)(b * 2 + g) * 64 * 2304; }
        else { nk = 256; Kb = (const bf16_t*)(a.ws + (isw ? WS_KWC : WS_KAC)) + (size_t)(b * 2 + g) * 256 * 64; VTb = (const bf16_t*)(a.ws + (isw ? WS_VWC : WS_VAC)) + (size_t)(b * 2 + g) * 64 * 256; }
        int nA = 4, lo = 0, hi = 0; bool win = false;
        if (kind == 0) nA = 36;
        if (kind == 1) { lo = qb - 2 < 0 ? 0 : qb - 2; hi = qb + 3 > 32 ? 32 : qb + 3; win = true; }
        const float sink2 = isw ? a.in[18][l * 8 + 4 * g + r] * LOG2E : 0.f;
#ifndef NO_ATT
        attn_item(lds, qp, op, Kb, VTb, nk, nA, lo, hi, win, tq, isw, sink2, !isw);
#endif
    }
}

DI void phase_hgcomb(const Args& a, int l) {
    const int tid = otid(), lane = tid & 63, w = tid >> 6;
    const int gw = obid() * 8 + w, NGW = gridDim.x * 8;
    const bf16_t* OF = (const bf16_t*)(a.ws + WS_OF); const bf16_t* PROJ = (const bf16_t*)(a.ws + WS_PROJ); bf16_t* OHG = (bf16_t*)(a.ws + WS_OHG);
    const f32x4 gn0 = *(const f32x4*)(a.in[17] + l * 128 + ((8 * lane) & 127)), gn1 = *(const f32x4*)(a.in[17] + l * 128 + ((8 * lane) & 127) + 4);
    for (int row = gw; row < T; row += NGW) {
        const u32x4 xa = *(const u32x4*)(OF + (size_t)row * 512 + 8 * lane), xb = *(const u32x4*)(OF + ((size_t)T + row) * 512 + 8 * lane);
        const u32x4 gb = *(const u32x4*)(PROJ + (size_t)row * INW + C_HG + 8 * lane);
        float s[8];
        s[0] = bflo(xa.x) + bflo(xb.x); s[1] = bfhi(xa.x) + bfhi(xb.x); s[2] = bflo(xa.y) + bflo(xb.y); s[3] = bfhi(xa.y) + bfhi(xb.y);
        s[4] = bflo(xa.z) + bflo(xb.z); s[5] = bfhi(xa.z) + bfhi(xb.z); s[6] = bflo(xa.w) + bflo(xb.w); s[7] = bfhi(xa.w) + bfhi(xb.w);
        float ss = 0.f;
#pragma unroll
        for (int i = 0; i < 8; ++i) ss += s[i] * s[i];
        ss += __shfl_xor(ss, 1); ss += __shfl_xor(ss, 2); ss += __shfl_xor(ss, 4); ss += __shfl_xor(ss, 8);
        const float rstd = rsqrtf(ss * (1.f / 128.f) + EPS);
        float g[8];
        g[0] = bflo(gb.x); g[1] = bfhi(gb.x); g[2] = bflo(gb.y); g[3] = bfhi(gb.y); g[4] = bflo(gb.z); g[5] = bfhi(gb.z); g[6] = bflo(gb.w); g[7] = bfhi(gb.w);
        float o[8];
#pragma unroll
        for (int i = 0; i < 8; ++i) o[i] = s[i] * rstd * (i < 4 ? gn0[i] : gn1[i - 4]) * g[i] * sigmoidf_(g[i]);
        u32x4 wv; wv.x = pk2(o[0], o[1]); wv.y = pk2(o[2], o[3]); wv.z = pk2(o[4], o[5]); wv.w = pk2(o[6], o[7]);
        *(u32x4*)(OHG + (size_t)row * 512 + 8 * lane) = wv;
    }
}

template <class Epi> DI void run_gemm(unsigned char* lds, const bf16_t* A, const bf16_t* Bt, int N, int K, const Epi& E) {
    pg8::Gemm g{A, Bt, T, N, K}; pg8::StaticOrder S; S.init(T, N, (int)gridDim.x, obid());
#if STAGGER
    {
        const unsigned long long t0 = __builtin_amdgcn_s_memrealtime();
        const unsigned long long dly = (unsigned long long)((obid() >> 3) & 7) * (unsigned long long)(STAGGER * (K / 64));
        while (__builtin_amdgcn_s_memrealtime() - t0 < dly) __builtin_amdgcn_s_sleep(4);
    }
#endif
    pg8::gemm_phase<Epi, pg8::StaticOrder, false>((PG8_LAS unsigned char*)lds, g, S, E, nullptr);
}

__global__ void __launch_bounds__(512, 2) mk_fwd(Args a) {
    extern __shared__ __attribute__((aligned(16))) unsigned char lds[];
    cg::grid_group grid = cg::this_grid();
    {   volatile LAS unsigned* st = (volatile LAS unsigned*)((LAS unsigned char*)lds + LDS_MISC + 16);
        if (threadIdx.x < 2) st[threadIdx.x] = 0u;
        __syncthreads(); }
    const XcdBarrier bar = xcd_barrier_post((unsigned*)(a.ws + WS_BAR), (volatile LAS unsigned*)((LAS unsigned char*)lds + LDS_MISC + 16));
    bf16_t* HB = (bf16_t*)(a.ws + WS_HB); bf16_t* PROJ = (bf16_t*)(a.ws + WS_PROJ); bf16_t* ACT = PROJ;
    float* M32 = (float*)(a.ws + WS_OF);
    for (int ph = a.ph_lo; ph < a.ph_hi; ++ph) {
        if (ph > a.ph_lo) { if (ph == a.ph_lo + 1) grid.sync(); else xcd_barrier(bar);
#if PROBE_MASK & 8
            xcd_barrier(bar); xcd_barrier(bar);
#endif
        }
#ifndef NO_P0
        if (ph == 0) { phase_p0(a, lds); __syncthreads(); phase_wconv(a, lds, 0, 0, 13312, obid(), (int)gridDim.x); continue; }
#endif
#ifndef NO_C0
        if (ph == NPH - 1) { phase_final(a); continue; }
#endif
        const int l = (ph - 1) / 13, k = (ph - 1) % 13;
        int reps = 1;
        if ((PROBE_MASK & 1) && (k == 0 || k == 3 || k == 10 || k == 7)) reps = 2;
        if ((PROBE_MASK & 2) && (k == 1 || k == 11 || k == 4 || k == 8)) reps = 2;
        if ((PROBE_MASK & (4 | 16 | 32)) && k == 6) reps = 2;
        if ((PROBE_MASK & (64 | 128)) && (k == 1 || k == 11)) reps = 2;
        if ((PROBE_MASK & 256) && k == 4) reps = 2;
        if ((PROBE_MASK & 2048) && k == 5) reps = 2;
        if ((PROBE_MASK & 512) && k == 8) reps = 2;
        if ((PROBE_MASK & 1024) && (k == 2 || k == 9 || k == 12)) reps = 2;
        for (int rep = 0; rep < reps; ++rep) {
        if (rep) xcd_barrier(bar);
        const float* MODL = (const float*)(a.ws + WS_MOD) + (size_t)l * 9 * NMODW;
        const unsigned char* wb = a.ws + WS_W;
        const bf16_t* WFI = (const bf16_t*)(wb + W_FI); const bf16_t* WFO = (const bf16_t*)(wb + W_FO);
        if (k == 100) {}
#ifndef NO_C0
        else if (k == 0) { if (l > 0) phase_wconv(a, lds, l, 0, 13312, obid(), (int)gridDim.x); phase_norm(a, l, 0, l == 0); }
        else if (k == 3 || k == 10) { phase_norm(a, l, k == 3 ? 1 : 2, false); }
#endif
#ifndef NO_G_SW
        else if (k == 1 || k == 11) { run_gemm(lds, HB, k == 1 ? WFI : WFI + (size_t)5632 * 1024, 2 * DFF, ((PROBE_MASK & 128) && rep == 0) ? 512 : DM, pg8::EpiSwiglu{ACT}); }
#endif
#ifndef NO_G_RES
        else if (k == 2 || k == 9 || k == 12) {
            const bf16_t* A = k == 9 ? HB : ACT; const bf16_t* Bt = k == 9 ? (const bf16_t*)(wb + W_OUT) : (k == 2 ? WFO : WFO + (size_t)1024 * DFF);
            const int K = k == 9 ? DM : DFF;
            run_gemm(lds, A, Bt, DM, K, pg8::EpiResid{a.in[0], a.in[1], a.ws, a.out, l, k});
        }
#endif
#ifndef NO_G_BF
        else if (k == 4) { run_gemm(lds, HB, (const bf16_t*)(wb + W_IN), INW, DM, pg8::EpiBf16P{PROJ, INW}); }
#endif
#ifndef NO_PREP
        else if (k == 5) { phase_prep(a, l, (PROBE_MASK & 2048) && rep == 0); }
#endif
#ifndef NO_MIX
        else if (k == 6) { phase_mixer(a, lds, l, rep); }
#endif
#ifndef NO_C0
        else if (k == 7) { phase_hgcomb(a, l); }
#endif
#ifndef NO_G_BR
        else if (k == 8) {
            const bf16_t* WBR = (const bf16_t*)(wb + W_BR);
            for (int kk = 0; kk < 3; ++kk) {
                const bf16_t* A = (const bf16_t*)(a.ws + (kk == 0 ? WS_OATT : (kk == 1 ? WS_OHG : WS_OWIN)));
                run_gemm(lds, A, WBR + (size_t)kk * 1024 * 512, DM, 512, pg8::EpiBranch{PROJ + C_GA + 1024 * kk, M32, HB, kk});
            }
        }
#endif
        }
    }
}

#ifndef MK_PER_PHASE
#define MK_PER_PHASE 0
#endif
extern "C" void kernel_launch(void* const* d_in, const int* in_sizes, int n_in, void* d_out, int out_size, void* d_ws, size_t ws_size, hipStream_t stream) {
    static int grid = 0;
    if (!grid) {
        if (n_in != 22 || ws_size < WS_END) { fprintf(stderr, "kernel_launch: unexpected n_in %d or ws_size %zu < %zu\n", n_in, ws_size, (size_t)WS_END); grid = -1; return; }
        int dev = 0, cus = 0, per_cu = 0;
        (void)hipGetDevice(&dev); (void)hipDeviceGetAttribute(&cus, hipDeviceAttributeMultiprocessorCount, dev);
        if (hipFuncSetAttribute((const void*)mk_fwd, hipFuncAttributeMaxDynamicSharedMemorySize, LDS_BYTES) != hipSuccess) { fprintf(stderr, "kernel_launch: hipFuncSetAttribute failed\n"); grid = -1; return; }
        (void)hipOccupancyMaxActiveBlocksPerMultiprocessor(&per_cu, mk_fwd, 512, LDS_BYTES);
        if (per_cu < 1) per_cu = 1;
        grid = cus * per_cu; if (grid > 256) grid = 256;
    }
    if (grid < 0) return;
    (void)hipMemsetAsync((char*)d_ws + WS_CTL, 0, CTL_BYTES, stream);
    Args a{};
    for (int i = 0; i < 22; ++i) a.in[i] = (const float*)d_in[i];
    a.out = (float*)d_out; a.ws = (unsigned char*)d_ws;
#if MK_PER_PHASE
    for (int ph = 0; ph < NPH; ++ph) { a.ph_lo = ph; a.ph_hi = ph + 1; hipLaunchKernelGGL(mk_fwd, dim3(grid), dim3(512), LDS_BYTES, stream, a); }
#else
    a.ph_lo = 0; a.ph_hi = NPH;
    void* args[] = {&a};
    hipError_t e = hipLaunchCooperativeKernel((void*)mk_fwd, dim3(grid), dim3(512), args, LDS_BYTES, stream);
    if (e != hipSuccess) fprintf(stderr, "cooperative launch failed: %s (grid %d)\n", hipGetErrorString(e), grid);
#endif
}
```
